# Optimizing an MI355X kernel written in HIP

```python
import math
import jax, jax.numpy as jnp
from jax import lax
import numpy as np

D_MODEL = 1024
BATCH = 16
SEQ = 2048
DEPTH = 2

N_EVEN = (DEPTH + 1) // 2
N_ODD = DEPTH // 2

MIX_WIDTH = 1024
A_GROUPS = 4
A_GROUP_DIM = 128
A_WIDTH = A_GROUPS * A_GROUP_DIM
CHUNK = 128
SGU_LN_EPS = 1e-5
B_HEADS = 8
B_HEAD_DIM = 64
B_WIDTH = B_HEADS * B_HEAD_DIM
DECAY_LORA = 64
ICLR_LORA = 64
GATE_LORA = 128
B_IN = 3 * B_WIDTH + DECAY_LORA + ICLR_LORA + GATE_LORA
RWKV_GN_EPS = 64e-5
IN0 = 2 * A_WIDTH + B_IN
C_HEADS = 8
C_KV_HEADS = 2
C_GROUP = C_HEADS // C_KV_HEADS
C_HEAD_DIM = 64
C_WIDTH = C_HEADS * C_HEAD_DIM
KV_WIDTH = C_KV_HEADS * C_HEAD_DIM
N_BRANCH = 3
CMP_LEN = 32
CMP_STRIDE = 16
CMP_HIDDEN = 256
SLC_BLK = 64
SEL_TOPK = 8
WIN = 512
QBLK = 128
ROT_DIM = C_HEAD_DIM // 4
ROPE_THETA = 500000.0
D_WIDTH = 512
CONV_W = 3
IN1 = C_WIDTH + 6 * KV_WIDTH + C_HEADS * N_BRANCH + 3 * D_WIDTH
FFN_DIM = 2816
N_EXPERTS = 8
TOP_K = 2
EXPERT_DIM = 1408
MOE_BLK = 256
NORM_EPS = 1e-6
NEG_INF = -1e30
FORCE_BONUS = 1e6

kernel_name = "hybrid_gmlp_rwkv7_nsa_shortconv_moe"


def _split(p, sizes):
    offs = [int(o) for o in np.cumsum(sizes)[:-1]]
    return jnp.split(p, offs, axis=-1)


def _rms_norm(x, g):
    xf = x.astype(jnp.float32)
    y = xf * lax.rsqrt(jnp.mean(xf * xf, axis=-1, keepdims=True) + NORM_EPS)
    return (y * g.astype(jnp.float32)).astype(x.dtype)


def _masked_softmax(s, mask):
    s = jnp.where(mask, s, NEG_INF)
    m = jnp.max(s, axis=-1, keepdims=True)
    p = jnp.where(mask, jnp.exp(s - m), 0.0)
    return p / jnp.maximum(jnp.sum(p, axis=-1, keepdims=True), 1e-30)


def _rope_partial(x, cos, sin):
    half = ROT_DIM // 2
    c = cos[None, :, None, :].astype(x.dtype)
    s = sin[None, :, None, :].astype(x.dtype)
    x1 = x[..., :half]
    x2 = x[..., half:ROT_DIM]
    return jnp.concatenate([x1 * c - x2 * s, x1 * s + x2 * c, x[..., ROT_DIM:]], axis=-1)


def _chunked_sgu(u, v, ln_g, ln_b, w_s, b_s):
    bsz, t, _ = v.shape
    vf = v.reshape(bsz, t, A_GROUPS, A_GROUP_DIM).astype(jnp.float32)
    mu = jnp.mean(vf, axis=-1, keepdims=True)
    var = jnp.mean(jnp.square(vf - mu), axis=-1, keepdims=True)
    vn = ((vf - mu) * lax.rsqrt(var + SGU_LN_EPS)).reshape(bsz, t, A_WIDTH)
    vn = (vn * ln_g + ln_b).astype(v.dtype)
    vc = vn.reshape(bsz, t // CHUNK, CHUNK, A_GROUPS, A_GROUP_DIM)
    causal = jnp.tril(jnp.ones((CHUNK, CHUNK), dtype=bool))
    wm = jnp.where(causal[None], w_s, 0.0).astype(v.dtype)
    mixed = jnp.einsum('gts,bcsgd->bctgd', wm, vc) + b_s.T[:, :, None]
    return u * mixed.reshape(bsz, t, A_WIDTH)


def _rwkv7_scan(r, w, k, v, kk, a):
    bsz, _, h, n = r.shape

    def step(S, inp):
        r_t, w_t, k_t, v_t, kk_t, a_t = inp
        sa = jnp.einsum('bhij,bhj->bhi', S, kk_t)
        S = (S * w_t[:, :, None, :]
             - sa[..., None] * (kk_t * a_t)[:, :, None, :]
             + v_t[..., None] * k_t[:, :, None, :])
        return S, jnp.einsum('bhij,bhj->bhi', S, r_t)

    xs = tuple(jnp.moveaxis(z, 1, 0) for z in (r, w, k, v, kk, a))
    S0 = jnp.zeros((bsz, h, n, n), jnp.float32)
    _, ys = lax.scan(step, S0, xs)
    return jnp.moveaxis(ys, 0, 1)


def _rwkv7_time_mix(pb, mu, w0, w2, a0, a2, g2, k_k, k_a, r_k, gn_g, gn_b):
    bsz, t, _ = pb.shape
    prev = jnp.pad(pb, ((0, 0), (1, 0), (0, 0)))[:, :-1]
    pb = pb + (prev - pb) * mu
    r, k, v, wl, al, gl = _split(pb, [B_WIDTH, B_WIDTH, B_WIDTH, DECAY_LORA, ICLR_LORA, GATE_LORA])
    w = -jax.nn.softplus(-(w0 + jnp.tanh(wl) @ w2)) - 0.5
    decay = jnp.exp(-jnp.exp(w.astype(jnp.float32)))
    a = jax.nn.sigmoid(a0 + al @ a2)
    g = jax.nn.sigmoid(gl) @ g2

    def heads(z):
        return z.reshape(bsz, t, B_HEADS, B_HEAD_DIM).astype(jnp.float32)

    kk = heads(k * k_k)
    kk = kk / jnp.maximum(jnp.sqrt(jnp.sum(kk * kk, axis=-1, keepdims=True)), 1e-12)
    k = k * (1.0 + (a - 1.0) * k_a)
    rh, kh, vh, ah, wh = heads(r), heads(k), heads(v), heads(a), heads(decay)
    y = _rwkv7_scan(rh, wh, kh, vh, kk, ah)
    ym = jnp.mean(y, axis=-1, keepdims=True)
    yv = jnp.mean(jnp.square(y - ym), axis=-1, keepdims=True)
    y = ((y - ym) * lax.rsqrt(yv + RWKV_GN_EPS)).reshape(bsz, t, B_WIDTH)
    y = y * gn_g.astype(jnp.float32) + gn_b.astype(jnp.float32)
    bonus = jnp.sum(rh * kh * r_k.astype(jnp.float32), axis=-1, keepdims=True) * vh
    y = (y + bonus.reshape(bsz, t, B_WIDTH)) * g.astype(jnp.float32)
    return y.astype(pb.dtype)


def _nsa(q, kc, vc, ks, vs, kw, vw, gl, pos_k, pos_v, ck1, ck2, cv1, cv2, cos, sin):
    bsz, t, _ = q.shape
    f32 = jnp.float32
    scale = C_HEAD_DIM ** -0.5
    q = q.reshape(bsz, t, C_HEADS, C_HEAD_DIM)
    kc, vc, ks, vs, kw, vw = (z.reshape(bsz, t, C_KV_HEADS, C_HEAD_DIM) for z in (kc, vc, ks, vs, kw, vw))

    n_cmp = (t - CMP_LEN) // CMP_STRIDE + 1
    idx = np.arange(n_cmp)[:, None] * CMP_STRIDE + np.arange(CMP_LEN)[None, :]

    def compress(z, pos, w1, w2):
        zb = z[:, idx] + pos[None, None, :, None, :]
        zb = zb.transpose(0, 3, 1, 2, 4).reshape(bsz, C_KV_HEADS, n_cmp, CMP_LEN * C_HEAD_DIM)
        return jax.nn.gelu(zb @ w1) @ w2

    k_cmp = compress(kc, pos_k, ck1, ck2)
    v_cmp = compress(vc, pos_v, cv1, cv2).astype(f32)
    cmp_end = jnp.arange(n_cmp) * CMP_STRIDE + CMP_LEN - 1
    n_slc = t // SLC_BLK
    ci = jnp.arange(n_cmp)[:, None] * CMP_STRIDE
    sj = jnp.arange(n_slc)[None, :] * SLC_BLK
    overlap = ((ci < sj + SLC_BLK) & (ci + CMP_LEN > sj)).astype(f32)
    n_sel = min(SEL_TOPK, n_slc)

    q_rot = _rope_partial(q, cos, sin)
    ks = _rope_partial(ks, cos, sin)
    kw = _rope_partial(kw, cos, sin)
    n_qb = t // QBLK

    def to_qblocks(z):
        return z.reshape(bsz, n_qb, QBLK, C_KV_HEADS, C_GROUP, z.shape[-1]).transpose(1, 0, 3, 4, 2, 5)

    qr_b = to_qblocks(q_rot)
    qn_b = to_qblocks(q)
    g_b = to_qblocks(jax.nn.sigmoid(gl.reshape(bsz, t, C_HEADS, N_BRANCH)))
    ks_blk = ks.reshape(bsz, n_slc, SLC_BLK, C_KV_HEADS, C_HEAD_DIM).transpose(0, 3, 1, 2, 4)
    vs_blk = vs.reshape(bsz, n_slc, SLC_BLK, C_KV_HEADS, C_HEAD_DIM).transpose(0, 3, 1, 2, 4)
    pad = ((0, 0), (0, 0), (WIN, 0), (0, 0))
    kw_pad = jnp.pad(kw.transpose(0, 2, 1, 3), pad)
    vw_pad = jnp.pad(vw.transpose(0, 2, 1, 3), pad)
    b_ix = jnp.arange(bsz)[:, None, None, None]
    h_ix = jnp.arange(C_KV_HEADS)[None, :, None, None]
    jb = jnp.arange(n_slc)

    def body(args):
        qr, qn, gt, blk = args
        s0 = blk * QBLK
        t_pos = s0 + jnp.arange(QBLK)
        sc = jnp.einsum('bhgqd,bhnd->bhgqn', qn, k_cmp).astype(f32) * scale
        pc = _masked_softmax(sc, cmp_end[None, :] <= t_pos[:, None])
        o_c = jnp.einsum('bhgqn,bhnd->bhgqd', pc, v_cmp)
        imp = jnp.einsum('bhgqn,nj->bhqj', pc, overlap)
        cur = t_pos // SLC_BLK
        forced = (jb[None] == 0) | (jb[None] == cur[:, None]) | (jb[None] == cur[:, None] - 1)
        imp = jnp.where(jb[None] * SLC_BLK <= t_pos[:, None],
                        imp + jnp.where(forced, FORCE_BONUS, 0.0), NEG_INF)
        _, sel = lax.top_k(imp, n_sel)
        kg = ks_blk[b_ix, h_ix, sel]
        vg = vs_blk[b_ix, h_ix, sel]
        tok = sel[..., None] * SLC_BLK + jnp.arange(SLC_BLK)
        ms = (tok <= t_pos[:, None, None]).reshape(bsz, C_KV_HEADS, 1, QBLK, n_sel * SLC_BLK)
        ss = jnp.einsum('bhgqd,bhqnld->bhgqnl', qr, kg).astype(f32)
        ps = _masked_softmax(ss.reshape(bsz, C_KV_HEADS, C_GROUP, QBLK, n_sel * SLC_BLK) * scale, ms)
        o_s = jnp.einsum('bhgqm,bhqmd->bhgqd', ps,
                         vg.reshape(bsz, C_KV_HEADS, QBLK, n_sel * SLC_BLK, C_HEAD_DIM).astype(f32))
        kwb = lax.dynamic_slice_in_dim(kw_pad, s0, QBLK + WIN, axis=2)
        vwb = lax.dynamic_slice_in_dim(vw_pad, s0, QBLK + WIN, axis=2)
        key_pos = s0 - WIN + jnp.arange(QBLK + WIN)
        diff = t_pos[:, None] - key_pos[None, :]
        mw = (diff >= 0) & (diff < WIN) & (key_pos[None, :] >= 0)
        sw = jnp.einsum('bhgqd,bhkd->bhgqk', qr, kwb).astype(f32) * scale
        pw = _masked_softmax(sw, mw)
        o_w = jnp.einsum('bhgqk,bhkd->bhgqd', pw, vwb.astype(f32))
        gt = gt.astype(f32)
        return (gt[..., 0:1] * o_c + gt[..., 1:2] * o_s + gt[..., 2:3] * o_w).astype(qr.dtype)

    out = lax.map(body, (qr_b, qn_b, g_b, jnp.arange(n_qb)))
    return out.transpose(1, 0, 4, 2, 3, 5).reshape(bsz, t, C_WIDTH)


def _short_conv(bg, cg, hd, conv_w):
    z = cg * hd
    y = lax.conv_general_dilated(z, conv_w[:, None, :].astype(z.dtype), window_strides=(1,),
                                 padding=[(CONV_W - 1, 0)],
                                 dimension_numbers=('NWC', 'WIO', 'NWC'),
                                 feature_group_count=D_WIDTH)
    return bg * y


def _swiglu(h, w_gate, w_up, w_down):
    return (jax.nn.silu(h @ w_gate) * (h @ w_up)) @ w_down


def _moe_swiglu(h, w_router, b_router, w_gate, w_up, w_down):
    bsz, t, d = h.shape
    n = bsz * t
    nk = n * TOP_K
    xf = h.reshape(n, d)
    logits = (xf @ w_router).astype(jnp.float32) + b_router.astype(jnp.float32)
    top_val, top_idx = lax.top_k(logits, TOP_K)
    gates = jax.nn.softmax(top_val, axis=-1)
    e_flat = top_idx.reshape(-1)
    tok_flat = jnp.repeat(jnp.arange(n, dtype=jnp.int32), TOP_K)
    g_flat = gates.reshape(-1)
    order = jnp.argsort(e_flat)
    e_sorted = e_flat[order]
    counts = jax.ops.segment_sum(jnp.ones_like(e_flat), e_flat, num_segments=N_EXPERTS)
    padded = ((counts + MOE_BLK - 1) // MOE_BLK) * MOE_BLK
    p_end = jnp.cumsum(padded)
    p_start = p_end - padded
    u_start = jnp.cumsum(counts) - counts
    dest = p_start[e_sorted] + jnp.arange(nk) - u_start[e_sorted]
    n_blk = (nk + MOE_BLK - 1) // MOE_BLK + N_EXPERTS
    p_rows = n_blk * MOE_BLK
    row_tok = jnp.zeros((p_rows,), jnp.int32).at[dest].set(tok_flat[order])
    row_w = jnp.zeros((p_rows,), jnp.float32).at[dest].set(g_flat[order])
    blk_e = jnp.minimum(jnp.searchsorted(p_end, jnp.arange(n_blk) * MOE_BLK, side='right'), N_EXPERTS - 1)
    xs = xf[row_tok].reshape(n_blk, MOE_BLK, d)

    def expert_block(args):
        xb, e = args
        return (jax.nn.silu(xb @ w_gate[e]) * (xb @ w_up[e])) @ w_down[e]

    yb = lax.map(expert_block, (xs, blk_e)).reshape(p_rows, d)
    out = jnp.zeros((n, d), h.dtype).at[row_tok].add(yb * row_w[:, None].astype(yb.dtype))
    return out.reshape(bsz, t, d)


def setup_inputs(seed: int = 0) -> dict:
    key = jax.random.key(seed)
    keys = iter(jax.random.split(key, 48))

    def nrm(shape, scale):
        return scale * jax.random.normal(next(keys), shape, jnp.float32)

    def gain(shape):
        return 1.0 + nrm(shape, 0.1)

    def unif(shape, lo, hi):
        return jax.random.uniform(next(keys), shape, jnp.float32, lo, hi)

    E, O, D = N_EVEN, N_ODD, D_MODEL
    return {
        "x": nrm((BATCH, SEQ, D), 1.0),
        "e_norm_mix": gain((E, D)),
        "e_w_in": nrm((E, D, IN0), D ** -0.5),
        "sgu_ln_g": gain((E, A_WIDTH)),
        "sgu_ln_b": nrm((E, A_WIDTH), 0.02),
        "sgu_w": nrm((E, A_GROUPS, CHUNK, CHUNK), CHUNK ** -0.5),
        "sgu_b": gain((E, A_GROUPS, CHUNK)),
        "rwkv_mu": unif((E, B_IN), 0.0, 1.0),
        "rwkv_w0": unif((E, B_WIDTH), -2.5, 0.5),
        "rwkv_w2": nrm((E, DECAY_LORA, B_WIDTH), 0.1 * DECAY_LORA ** -0.5),
        "rwkv_a0": nrm((E, B_WIDTH), 0.5),
        "rwkv_a2": nrm((E, ICLR_LORA, B_WIDTH), 0.5 * ICLR_LORA ** -0.5),
        "rwkv_g2": nrm((E, GATE_LORA, B_WIDTH), GATE_LORA ** -0.5),
        "rwkv_k_k": 0.85 + nrm((E, B_WIDTH), 0.1),
        "rwkv_k_a": gain((E, B_WIDTH)),
        "rwkv_r_k": nrm((E, B_HEADS, B_HEAD_DIM), 0.1),
        "rwkv_gn_g": gain((E, B_WIDTH)),
        "rwkv_gn_b": nrm((E, B_WIDTH), 0.02),
        "e_w_out": nrm((E, MIX_WIDTH, D), MIX_WIDTH ** -0.5),
        "e_norm_ffn": gain((E, D)),
        "ffn_w_gate": nrm((E, D, FFN_DIM), D ** -0.5),
        "ffn_w_up": nrm((E, D, FFN_DIM), D ** -0.5),
        "ffn_w_down": nrm((E, FFN_DIM, D), FFN_DIM ** -0.5),
        "o_norm_mix": gain((O, D)),
        "o_w_in": nrm((O, D, IN1), D ** -0.5),
        "nsa_cmp_pos_k": nrm((O, CMP_LEN, C_HEAD_DIM), 0.1),
        "nsa_cmp_pos_v": nrm((O, CMP_LEN, C_HEAD_DIM), 0.1),
        "nsa_cmp_k_w1": nrm((O, CMP_LEN * C_HEAD_DIM, CMP_HIDDEN), (CMP_LEN * C_HEAD_DIM) ** -0.5),
        "nsa_cmp_k_w2": nrm((O, CMP_HIDDEN, C_HEAD_DIM), CMP_HIDDEN ** -0.5),
        "nsa_cmp_v_w1": nrm((O, CMP_LEN * C_HEAD_DIM, CMP_HIDDEN), (CMP_LEN * C_HEAD_DIM) ** -0.5),
        "nsa_cmp_v_w2": nrm((O, CMP_HIDDEN, C_HEAD_DIM), CMP_HIDDEN ** -0.5),
        "conv_w": nrm((O, CONV_W, D_WIDTH), CONV_W ** -0.5),
        "o_w_out": nrm((O, MIX_WIDTH, D), MIX_WIDTH ** -0.5),
        "o_norm_ffn": gain((O, D)),
        "moe_router": nrm((O, D, N_EXPERTS), D ** -0.5),
        "moe_router_b": nrm((O, N_EXPERTS), 0.01),
        "moe_w_gate": nrm((O, N_EXPERTS, D, EXPERT_DIM), D ** -0.5),
        "moe_w_up": nrm((O, N_EXPERTS, D, EXPERT_DIM), D ** -0.5),
        "moe_w_down": nrm((O, N_EXPERTS, EXPERT_DIM, D), EXPERT_DIM ** -0.5),
        "final_norm": gain((D,)),
    }


def reference(x, e_norm_mix, e_w_in, sgu_ln_g, sgu_ln_b, sgu_w, sgu_b, rwkv_mu, rwkv_w0, rwkv_w2,
              rwkv_a0, rwkv_a2, rwkv_g2, rwkv_k_k, rwkv_k_a, rwkv_r_k, rwkv_gn_g, rwkv_gn_b, e_w_out,
              e_norm_ffn, ffn_w_gate, ffn_w_up, ffn_w_down, o_norm_mix, o_w_in, nsa_cmp_pos_k,
              nsa_cmp_pos_v, nsa_cmp_k_w1, nsa_cmp_k_w2, nsa_cmp_v_w1, nsa_cmp_v_w2, conv_w, o_w_out,
              o_norm_ffn, moe_router, moe_router_b, moe_w_gate, moe_w_up, moe_w_down, final_norm):
    t = x.shape[1]
    pos = jnp.arange(t, dtype=jnp.float32)
    inv_freq = ROPE_THETA ** (-jnp.arange(0, ROT_DIM, 2, dtype=jnp.float32) / ROT_DIM)
    ang = pos[:, None] * inv_freq[None, :]
    cos, sin = jnp.cos(ang), jnp.sin(ang)

    h = x
    for layer in range(DEPTH):
        i = layer // 2
        if layer % 2 == 0:
            hn = _rms_norm(h, e_norm_mix[i])
            p = hn @ e_w_in[i]
            pu, pv, pb = _split(p, [A_WIDTH, A_WIDTH, B_IN])
            ya = _chunked_sgu(jax.nn.gelu(pu), jax.nn.gelu(pv), sgu_ln_g[i], sgu_ln_b[i], sgu_w[i], sgu_b[i])
            yb = _rwkv7_time_mix(pb, rwkv_mu[i], rwkv_w0[i], rwkv_w2[i], rwkv_a0[i], rwkv_a2[i],
                                 rwkv_g2[i], rwkv_k_k[i], rwkv_k_a[i], rwkv_r_k[i],
                                 rwkv_gn_g[i], rwkv_gn_b[i])
            h = h + jnp.concatenate([ya.astype(h.dtype), yb.astype(h.dtype)], axis=-1) @ e_w_out[i]
            hn = _rms_norm(h, e_norm_ffn[i])
            h = h + _swiglu(hn, ffn_w_gate[i], ffn_w_up[i], ffn_w_down[i])
        else:
            hn = _rms_norm(h, o_norm_mix[i])
            p = hn @ o_w_in[i]
            q, kc, vc, ks, vs, kw, vw, gl, bg, cg, hd = _split(
                p, [C_WIDTH] + [KV_WIDTH] * 6 + [C_HEADS * N_BRANCH] + [D_WIDTH] * 3)
            yc = _nsa(q, kc, vc, ks, vs, kw, vw, gl, nsa_cmp_pos_k[i], nsa_cmp_pos_v[i],
                      nsa_cmp_k_w1[i], nsa_cmp_k_w2[i], nsa_cmp_v_w1[i], nsa_cmp_v_w2[i], cos, sin)
            yd = _short_conv(bg, cg, hd, conv_w[i])
            h = h + jnp.concatenate([yc.astype(h.dtype), yd.astype(h.dtype)], axis=-1) @ o_w_out[i]
            hn = _rms_norm(h, o_norm_ffn[i])
            h = h + _moe_swiglu(hn, moe_router[i], moe_router_b[i], moe_w_gate[i], moe_w_up[i], moe_w_down[i])
    return _rms_norm(h, final_norm)
```

```cpp
#include <hip/hip_runtime.h>
#include <cstdio>
#include <cstdint>

#define LAS __attribute__((address_space(3)))
typedef unsigned short bf16;
typedef float f32x4 __attribute__((ext_vector_type(4)));
typedef float f32x2 __attribute__((ext_vector_type(2)));
typedef unsigned u32x4 __attribute__((ext_vector_type(4)));
typedef unsigned u32x2 __attribute__((ext_vector_type(2)));
typedef short bf16x8 __attribute__((ext_vector_type(8)));

constexpr int D = 1024, BATCH = 16, SEQ = 2048, NTOK = BATCH * SEQ;
constexpr int IN0 = 2816, IN1 = 2840, IN1P = 3072, FFN = 2816, EXPD = 1408, NEXP = 8;
constexpr int MAXSLOT = NTOK * 2 + NEXP * 256;
constexpr int NWAVES = 8, NTHR = 512;
constexpr int LDS_BYTES = 163840;
constexpr int C_Q = 0, C_KC = 512, C_VC = 640, C_KS = 768, C_VS = 896, C_KW = 1024, C_VW = 1152, C_BG = 1280, C_CG = 1792, C_HD = 2304, C_GL = 2816;

constexpr size_t MiB = (size_t)1 << 20;
constexpr size_t WS_CTL = 0, CTL_ZERO_BYTES = 1 * MiB;
constexpr size_t WT_IN0 = 1 * MiB;
constexpr size_t WT_OUT0 = WT_IN0 + (size_t)IN0 * D * 2;
constexpr size_t WT_GU0 = WT_OUT0 + (size_t)D * D * 2;
constexpr size_t WT_DN0 = WT_GU0 + (size_t)2 * FFN * D * 2;
constexpr size_t WT_IN1 = WT_DN0 + (size_t)D * FFN * 2;
constexpr size_t WT_OUT1 = WT_IN1 + (size_t)IN1P * D * 2;
constexpr size_t WT_GU1 = WT_OUT1 + (size_t)D * D * 2;
constexpr size_t WT_DN1 = WT_GU1 + (size_t)NEXP * 2 * EXPD * D * 2;
constexpr size_t WT_CK1 = WT_DN1 + (size_t)NEXP * D * EXPD * 2;
constexpr size_t WT_CV1 = WT_CK1 + (size_t)256 * 2048 * 2;
constexpr size_t WT_CK2 = WT_CV1 + (size_t)256 * 2048 * 2;
constexpr size_t WT_CV2 = WT_CK2 + (size_t)64 * 256 * 2;
constexpr size_t WT_SGU = WT_CV2 + (size_t)64 * 256 * 2;
constexpr size_t WT_W2 = WT_SGU + (size_t)4 * 128 * 128 * 2;
constexpr size_t WT_A2 = WT_W2 + (size_t)512 * 64 * 2;
constexpr size_t WT_G2 = WT_A2 + (size_t)512 * 64 * 2;
constexpr size_t W_END = WT_G2 + (size_t)512 * 128 * 2;
static_assert(W_END <= 104 * MiB, "weights region");
constexpr size_t M_RS = 104 * MiB;
constexpr size_t M_RSTD0 = M_RS + 2 * MiB;
constexpr size_t M_ROPE = M_RSTD0 + 128 * 1024;
constexpr size_t M_C1 = M_ROPE + 128 * 1024;
constexpr size_t M_WR = M_C1 + 4 * 1024;
constexpr size_t M_KCMP = M_WR + 32 * 1024;
constexpr size_t M_VCMP = M_KCMP + 512 * 1024;
constexpr size_t M_HID = M_VCMP + 512 * 1024;
constexpr size_t M_TOPE = M_HID + 4 * MiB;
constexpr size_t M_TOPG = M_TOPE + 256 * 1024;
constexpr size_t M_RSTD3 = M_TOPG + 256 * 1024;
constexpr size_t M_BLKCNT = M_RSTD3 + 128 * 1024;
constexpr size_t M_SLOTOF = M_BLKCNT + 32 * 1024;
constexpr size_t M_SRSTD = M_SLOTOF + 256 * 1024;
constexpr size_t M_SGATE = M_SRSTD + 272 * 1024;
constexpr size_t M_EXPINF = M_SGATE + 272 * 1024;
constexpr size_t M_SLOTTOK = M_EXPINF + 4096;
static_assert(M_SLOTTOK + 272 * 1024 <= 120 * MiB, "misc region");
constexpr size_t WS_XB = 120 * MiB;
constexpr size_t WS_YB = 184 * MiB;
constexpr size_t WS_PB = 248 * MiB;
constexpr size_t WS_QROT = 441 * MiB;
constexpr size_t WS_XS = 184 * MiB;
constexpr size_t WS_ACTM = 316 * MiB;
constexpr size_t WS_XQ = 420 * MiB;
constexpr size_t WS_XQ0 = 336 * MiB;
static_assert(WS_PB + (size_t)NTOK * FFN <= WS_XQ0 && WS_XQ0 + (size_t)NTOK * D <= WS_PB + (size_t)NTOK * IN1P * 2, "ws map int8");
constexpr int AP8 = 1536;
constexpr size_t WS_XQI = WS_YB;
constexpr float I8_XS = 127.0f / 6.0f, I8_XS1 = 127.0f / 7.0f, I8_WS = 127.0f / 0.14f;
constexpr float F8_XS = 4.0f, F8_WS = 32.0f, F8_HS = 4.0f;
constexpr size_t WS_END = 498 * MiB;
static_assert(WS_ACTM + (size_t)MAXSLOT * AP8 <= WS_XQ && WS_XQ + (size_t)NTOK * D <= WS_END, "ws map fp8");
static_assert(WS_PB + (size_t)(NTOK + 64) * IN1P * 2 <= WS_QROT && WS_QROT + (size_t)NTOK * 512 * 2 <= 473 * MiB, "ws map");
static_assert(WS_XS + (size_t)MAXSLOT * D * 2 <= WS_ACTM && WS_ACTM + (size_t)MAXSLOT * EXPD * 2 <= WS_END, "ws map moe");

__device__ __forceinline__ float bf2f(unsigned b) { return __uint_as_float(b << 16); }
__device__ __forceinline__ unsigned f2bf(float f) { unsigned u = __float_as_uint(f); return (u + 0x7fffu + ((u >> 16) & 1u)) >> 16; }
typedef __bf16 bf16x2_hw __attribute__((ext_vector_type(2)));
__device__ __forceinline__ unsigned pk2(float lo, float hi) { f32x2 v = {lo, hi}; bf16x2_hw b = __builtin_convertvector(v, bf16x2_hw); return __builtin_bit_cast(unsigned, b); }
__device__ __forceinline__ unsigned pk4_f8(float a, float b, float c, float d) { int w = __builtin_amdgcn_cvt_pk_fp8_f32(a, b, 0, false); w = __builtin_amdgcn_cvt_pk_fp8_f32(c, d, w, true); return (unsigned)w; }
__device__ __forceinline__ unsigned pk4_i8(float a, float b, float c, float d) {
    const float M = 12582912.0f;
    const unsigned ua = __float_as_uint(__builtin_amdgcn_fmed3f(a, -127.0f, 127.0f) + M), ub = __float_as_uint(__builtin_amdgcn_fmed3f(b, -127.0f, 127.0f) + M), uc = __float_as_uint(__builtin_amdgcn_fmed3f(c, -127.0f, 127.0f) + M), ud = __float_as_uint(__builtin_amdgcn_fmed3f(d, -127.0f, 127.0f) + M);
    return (ua & 0xffu) | ((ub & 0xffu) << 8) | ((uc & 0xffu) << 16) | (ud << 24);
}
__device__ __forceinline__ float rcpf_(float x) { return __builtin_amdgcn_rcpf(x); }
__device__ __forceinline__ float sigmoidf_(float x) { return rcpf_(1.0f + __expf(-x)); }
__device__ __forceinline__ float gelu_tanh(float x) { const float u = 1.5957691216057308f * (x + 0.044715f * x * x * x); return x * rcpf_(1.0f + __expf(-u)); }
__device__ __forceinline__ float silu_(float x) { return x * rcpf_(1.0f + __expf(-x)); }
template <int CTRL> __device__ __forceinline__ float dpp_f(float v) { return __builtin_bit_cast(float, __builtin_amdgcn_update_dpp(0, __builtin_bit_cast(int, v), CTRL, 0xF, 0xF, true)); }
__device__ __forceinline__ float red16(float v) { v += dpp_f<0xB1>(v); v += dpp_f<0x4E>(v); v += dpp_f<0x141>(v); v += dpp_f<0x140>(v); return v; }
__device__ __forceinline__ float wave_sum(float v) {
    v = red16(v);
    { auto r = __builtin_amdgcn_permlane16_swap(__float_as_uint(v), __float_as_uint(v), false, false); v = __uint_as_float(r[0]) + __uint_as_float(r[1]); }
    { auto r = __builtin_amdgcn_permlane32_swap(__float_as_uint(v), __float_as_uint(v), false, false); v = __uint_as_float(r[0]) + __uint_as_float(r[1]); }
    return v;
}
__device__ __forceinline__ float sum_rows4(float v) {
    { auto r = __builtin_amdgcn_permlane16_swap(__float_as_uint(v), __float_as_uint(v), false, false); v = __uint_as_float(r[0]) + __uint_as_float(r[1]); }
    { auto r = __builtin_amdgcn_permlane32_swap(__float_as_uint(v), __float_as_uint(v), false, false); v = __uint_as_float(r[0]) + __uint_as_float(r[1]); }
    return v;
}
__device__ __forceinline__ float wave_max(float v) {
#pragma unroll
    for (int o = 1; o < 64; o <<= 1) v = fmaxf(v, __shfl_xor(v, o));
    return v;
}
__device__ __forceinline__ int lane_now() { int l; asm volatile("v_mbcnt_lo_u32_b32 %0, -1, 0\n\tv_mbcnt_hi_u32_b32 %0, -1, %0" : "=v"(l)); return l; }
__device__ __forceinline__ int lane_after(float dep) { int l; asm volatile("v_mbcnt_lo_u32_b32 %0, -1, 0\n\tv_mbcnt_hi_u32_b32 %0, -1, %0" : "=&v"(l) : "v"(dep)); return l; }
__device__ __forceinline__ int tid_now(int wave) { return (wave << 6) | lane_now(); }
#define LDS_FENCE() asm volatile("s_waitcnt lgkmcnt(0)" ::: "memory")

struct Args { const float* in[40]; float* out; unsigned char* ws; int ph_lo, ph_hi, li, pad; };
struct Frame {
    unsigned char* lds; unsigned char* ws; const float* const* in; float* out;
    int tid, lane, wave, G, blk;
};
template <class T> __device__ __forceinline__ T* wsp(const Frame& F, size_t off) { return (T*)(F.ws + off); }

typedef int i32x4_ __attribute__((ext_vector_type(4)));
struct Unit { int pm, pn, idx; long aoff, boff; };
struct Gemm { const bf16* A; const bf16* Bt; int K; unsigned a_row, a_half, a_k, b_row, b_half, b_k; };
__device__ __forceinline__ Gemm std_gemm(const bf16* A, const bf16* Bt, int K) {
    Gemm g; g.A = A; g.Bt = Bt; g.K = K; g.a_row = K * 2; g.a_half = 128 * K * 2; g.a_k = 128; g.b_row = K * 2; g.b_half = 128 * K * 2; g.b_k = 128; return g;
}
constexpr int NXCD = 8, WGM = 8;
struct StdOrder {
    int nM, nN, nwg, G, c; long a_tile, b_tile;
    __device__ __forceinline__ void init(int nM_, int nN_, int G_, int c_, long a_tile_, long b_tile_) { nM = nM_; nN = nN_; nwg = nM * nN; G = G_; c = c_; a_tile = a_tile_; b_tile = b_tile_; }
    __device__ __forceinline__ bool tile(int i, int& pm, int& pn) const {
        const int L = i * G + c; if (L >= nwg) return false;
        int wgid = L; { const int q = nwg / NXCD, r = nwg % NXCD, xcd = wgid % NXCD, off = wgid / NXCD; wgid = (xcd < r ? xcd * (q + 1) : r * (q + 1) + (xcd - r) * q) + off; }
        const int nig = WGM * nN, gid = wgid / nig, fm = gid * WGM, gsz = (nM - fm) < WGM ? (nM - fm) : WGM;
        pm = fm + ((wgid % nig) % gsz); pn = (wgid % nig) / gsz; return true;
    }
    __device__ __forceinline__ bool next(int i, Unit& u) const { if (!tile(i, u.pm, u.pn)) return false; u.idx = i; u.aoff = u.pm * a_tile; u.boff = u.pn * b_tile; return true; }
};
struct MoeOrder {
    StdOrder so; const int* ei; long exp_bytes;
    __device__ __forceinline__ void init(const int* expinf, int nN, int G, int c, long a_tile, long b_tile, long exp_bytes_) {
        ei = expinf; so.init(__builtin_amdgcn_readfirstlane(expinf[8]), nN, G, c, a_tile, b_tile); exp_bytes = exp_bytes_;
    }
    __device__ __forceinline__ bool next(int i, Unit& u) const {
        if (!so.tile(i, u.pm, u.pn)) return false;
        u.idx = i;
        const int pm = u.pm; const int e = __builtin_amdgcn_readfirstlane((pm >= ei[1]) + (pm >= ei[2]) + (pm >= ei[3]) + (pm >= ei[4]) + (pm >= ei[5]) + (pm >= ei[6]) + (pm >= ei[7]));
        u.aoff = pm * so.a_tile; u.boff = e * exp_bytes + u.pn * so.b_tile; return true;
    }
};
struct CmpOrder {
    int G, c;
    __device__ __forceinline__ bool next(int i, Unit& u) const {
        const int L = i * G + c; if (L >= 32) return false;
        const int which = L >> 4, b = L & 15; u.pm = L; u.pn = 0; u.idx = i;
        u.aoff = ((long)b * SEQ * IN1P + (which ? C_VC : C_KC)) * 2; u.boff = (long)which * 256 * 2048 * 2; return true;
    }
};

typedef f32x4 Acc[2][2][4][2];

__device__ __forceinline__ float rstd_from_partials(const float* RS, int row) {
    const f32x4* p = (const f32x4*)(RS + (size_t)row * 16);
    const f32x4 a = p[0], b = p[1], c = p[2], d = p[3];
    const float s = ((a.x + a.y) + (a.z + a.w)) + ((b.x + b.y) + (b.z + b.w)) + ((c.x + c.y) + (c.z + c.w)) + ((d.x + d.y) + (d.z + d.w));
    return rsqrtf(s * (1.0f / D) + 1e-6f);
}

template <class Sched>
__device__ __forceinline__ LAS float* fill_rs_lds(unsigned char* lds, const Sched& S, const float* rs_partial, const float* direct, int tid, int off = 131072) {
    LAS float* t = (LAS float*)((LAS unsigned char*)lds + off);
    Unit u; const int wv = tid >> 6, ln = tid & 63;
    for (int i = wv; i < 14 && S.next(i, u); i += NWAVES) {
#pragma unroll
        for (int rr = 0; rr < 4; ++rr) { const int row = ln + 64 * rr; t[i * 256 + row] = direct ? direct[u.pm * 256 + row] : rstd_from_partials(rs_partial, u.pm * 256 + row); }
    }
    __syncthreads();
    return t;
}
template <bool IACC>
struct EpiBf16T {
    static constexpr bool PERM = true;
    bf16* out; int ldc; const float* rstd_direct; const float* rs_partial; int gelu_tiles; const LAS float* rs_lds; float mul;
    __device__ __forceinline__ void operator()(const Acc& acc, const Unit& u, int wr, int wc, int fr, int fq) const {
        const int col0 = u.pn * 256 + wc * 32 + 8 * fq; const bool gel = u.pn < gelu_tiles;
#pragma unroll
        for (int ai = 0; ai < 2; ++ai)
#pragma unroll
            for (int m = 0; m < 4; ++m) {
                const int row = u.pm * 256 + ai * 128 + wr * 64 + m * 16 + fr;
                const float rs = rs_lds ? rs_lds[u.idx * 256 + ai * 128 + wr * 64 + m * 16 + fr] : (rstd_direct ? rstd_direct[row] : rstd_from_partials(rs_partial, row));
#pragma unroll
                for (int bj = 0; bj < 2; ++bj) {
                    f32x4 v0, v1;
                    if constexpr (IACC) { const float rq = rs * mul; v0 = __builtin_convertvector(__builtin_bit_cast(i32x4_, acc[ai][bj][m][0]), f32x4) * rq; v1 = __builtin_convertvector(__builtin_bit_cast(i32x4_, acc[ai][bj][m][1]), f32x4) * rq; }
                    else { v0 = acc[ai][bj][m][0] * rs; v1 = acc[ai][bj][m][1] * rs; }
                    if (gel) {
#pragma unroll
                        for (int i = 0; i < 4; ++i) { v0[i] = gelu_tanh(v0[i]); v1[i] = gelu_tanh(v1[i]); }
                    }
                    u32x4 w; w.x = pk2(v0[0], v0[1]); w.y = pk2(v0[2], v0[3]); w.z = pk2(v1[0], v1[1]); w.w = pk2(v1[2], v1[3]);
                    *(u32x4*)(out + (size_t)row * ldc + col0 + bj * 128) = w;
                }
            }
    }
};
typedef EpiBf16T<false> EpiBf16;
struct EpiGU {
    static constexpr bool PERM = true;
    bf16* out; int ldc; const float* rstd_direct; const float* rs_partial; const LAS float* rs_lds;
    __device__ __forceinline__ void operator()(const Acc& acc, const Unit& u, int wr, int wc, int fr, int fq) const {
        const int col0 = (u.pn * 256 + wc * 32 + 8 * fq) >> 1;
#pragma unroll
        for (int ai = 0; ai < 2; ++ai)
#pragma unroll
            for (int m = 0; m < 4; ++m) {
                const int row = u.pm * 256 + ai * 128 + wr * 64 + m * 16 + fr;
                const float rs = rs_lds ? rs_lds[u.idx * 256 + ai * 128 + wr * 64 + m * 16 + fr] : (rstd_direct ? rstd_direct[row] : rstd_from_partials(rs_partial, row));
#pragma unroll
                for (int bj = 0; bj < 2; ++bj) {
                    const f32x4 g = acc[ai][bj][m][0] * rs, up = acc[ai][bj][m][1] * rs;
                    f32x2 e0 = (f32x2){g[0], g[1]} * (-1.4426950408889634f), e1 = (f32x2){g[2], g[3]} * (-1.4426950408889634f);
                    e0.x = __builtin_amdgcn_exp2f(e0.x); e0.y = __builtin_amdgcn_exp2f(e0.y); e1.x = __builtin_amdgcn_exp2f(e1.x); e1.y = __builtin_amdgcn_exp2f(e1.y);
                    e0 = e0 + 1.0f; e1 = e1 + 1.0f;
                    e0.x = __builtin_amdgcn_rcpf(e0.x); e0.y = __builtin_amdgcn_rcpf(e0.y); e1.x = __builtin_amdgcn_rcpf(e1.x); e1.y = __builtin_amdgcn_rcpf(e1.y);
                    const f32x2 o0 = ((f32x2){g[0], g[1]} * (f32x2){up[0], up[1]}) * e0, o1 = ((f32x2){g[2], g[3]} * (f32x2){up[2], up[3]}) * e1;
                    u32x2 w; w.x = pk2(o0.x, o0.y); w.y = pk2(o1.x, o1.y);
                    *(u32x2*)(out + (size_t)row * ldc + col0 + bj * 64) = w;
                }
            }
    }
};
struct EpiRes {
    static constexpr bool PERM = false;
    const float* base; float* H; bf16* XB; float* RS;
    __device__ __forceinline__ void operator()(const Acc& acc, const Unit& u, int wr, int wc, int fr, int fq) const {
        const int col0 = u.pn * 256 + wc * 32 + 4 * fq;
#pragma unroll
        for (int ai = 0; ai < 2; ++ai)
#pragma unroll
            for (int m = 0; m < 4; ++m) {
                const int row = u.pm * 256 + ai * 128 + wr * 64 + m * 16 + fr; float ss = 0.f;
#pragma unroll
                for (int bj = 0; bj < 2; ++bj)
#pragma unroll
                    for (int n = 0; n < 2; ++n) {
                        const size_t off = (size_t)row * D + col0 + bj * 128 + n * 16;
                        const f32x4 o = *(const f32x4*)(base + off) + acc[ai][bj][m][n];
                        *(f32x4*)(H + off) = o; u32x2 w; w.x = pk2(o[0], o[1]); w.y = pk2(o[2], o[3]); *(u32x2*)(XB + off) = w;
                        ss += (o[0] * o[0] + o[1] * o[1]) + (o[2] * o[2] + o[3] * o[3]);
                    }
                ss = sum_rows4(ss);
                if (fq == 0) RS[(size_t)row * 16 + u.pn * 4 + wc] = ss;
            }
    }
};
template <int PITCH, int PAD_PN, bool IACC = false>
struct EpiGU8 {
    static constexpr bool PERM = true;
    unsigned char* out; const LAS float* rs_lds; float mul;
    __device__ __forceinline__ void operator()(const Acc& acc, const Unit& u, int wr, int wc, int fr, int fq) const {
        const int col0 = u.pn * 128 + wc * 32 + 8 * fq;
#pragma unroll
        for (int ai = 0; ai < 2; ++ai)
#pragma unroll
            for (int m = 0; m < 4; ++m) {
                const int row = u.pm * 256 + ai * 128 + wr * 64 + m * 16 + fr;
                const float rs = rs_lds[u.idx * 256 + ai * 128 + wr * 64 + m * 16 + fr] * mul;
                u32x2 w;
#pragma unroll
                for (int bj = 0; bj < 2; ++bj) {
                    f32x4 g, up;
                    if constexpr (IACC) { const i32x4_ g_ = __builtin_bit_cast(i32x4_, acc[ai][bj][m][0]), u_ = __builtin_bit_cast(i32x4_, acc[ai][bj][m][1]); g = __builtin_convertvector(g_, f32x4) * rs; up = __builtin_convertvector(u_, f32x4) * rs; }
                    else { g = acc[ai][bj][m][0] * rs; up = acc[ai][bj][m][1] * rs; }
                    f32x2 e0 = (f32x2){g[0], g[1]} * (-1.4426950408889634f), e1 = (f32x2){g[2], g[3]} * (-1.4426950408889634f);
                    e0.x = __builtin_amdgcn_exp2f(e0.x); e0.y = __builtin_amdgcn_exp2f(e0.y); e1.x = __builtin_amdgcn_exp2f(e1.x); e1.y = __builtin_amdgcn_exp2f(e1.y);
                    e0 = e0 + 1.0f; e1 = e1 + 1.0f;
                    e0.x = __builtin_amdgcn_rcpf(e0.x); e0.y = __builtin_amdgcn_rcpf(e0.y); e1.x = __builtin_amdgcn_rcpf(e1.x); e1.y = __builtin_amdgcn_rcpf(e1.y);
                    const f32x2 o0 = ((f32x2){g[0], g[1]} * (f32x2){up[0], up[1]}) * e0 * F8_HS, o1 = ((f32x2){g[2], g[3]} * (f32x2){up[2], up[3]}) * e1 * F8_HS;
                    const unsigned pw = pk4_f8(o0.x, o0.y, o1.x, o1.y);
                    if (bj == 0) w.x = pw; else w.y = pw;
                }
                *(u32x2*)(out + (size_t)row * PITCH + col0) = w;
                if (PAD_PN >= 0 && u.pn == PAD_PN) *(u32x2*)(out + (size_t)row * PITCH + (PAD_PN + 1) * 128 + wc * 32 + 8 * fq) = (u32x2){0u, 0u};
            }
    }
};
template <bool WQ, bool SC, long XQOFF = 0>
struct EpiResBT {
    static constexpr bool PERM = true;
    bf16* XB; float* RS; float mul;
    __device__ __forceinline__ void operator()(const Acc& acc, const Unit& u, int wr, int wc, int fr, int fq) const {
        const int col0 = u.pn * 256 + wc * 32 + 8 * fq;
#pragma unroll
        for (int ai = 0; ai < 2; ++ai)
#pragma unroll
            for (int m = 0; m < 4; ++m) {
                const int row = u.pm * 256 + ai * 128 + wr * 64 + m * 16 + fr; float ss = 0.f;
#pragma unroll
                for (int bj = 0; bj < 2; ++bj) {
                    u32x4* p = (u32x4*)(XB + (size_t)row * D + col0 + bj * 128);
                    const u32x4 b = *p; f32x4 a0 = acc[ai][bj][m][0], a1 = acc[ai][bj][m][1];
                    if constexpr (SC) { a0 = a0 * mul; a1 = a1 * mul; }
                    const float o0 = bf2f(b.x & 0xffffu) + a0[0], o1 = bf2f(b.x >> 16) + a0[1], o2 = bf2f(b.y & 0xffffu) + a0[2], o3 = bf2f(b.y >> 16) + a0[3];
                    const float o4 = bf2f(b.z & 0xffffu) + a1[0], o5 = bf2f(b.z >> 16) + a1[1], o6 = bf2f(b.w & 0xffffu) + a1[2], o7 = bf2f(b.w >> 16) + a1[3];
                    u32x4 w; w.x = pk2(o0, o1); w.y = pk2(o2, o3); w.z = pk2(o4, o5); w.w = pk2(o6, o7); *p = w;
                    const float r0 = bf2f(w.x & 0xffffu), r1 = bf2f(w.x >> 16), r2 = bf2f(w.y & 0xffffu), r3 = bf2f(w.y >> 16), r4 = bf2f(w.z & 0xffffu), r5 = bf2f(w.z >> 16), r6 = bf2f(w.w & 0xffffu), r7 = bf2f(w.w >> 16);
                    ss += ((r0 * r0 + r1 * r1) + (r2 * r2 + r3 * r3)) + ((r4 * r4 + r5 * r5) + (r6 * r6 + r7 * r7));
                    if constexpr (WQ) { u32x2 q8; q8.x = pk4_i8(r0 * I8_XS, r1 * I8_XS, r2 * I8_XS, r3 * I8_XS); q8.y = pk4_i8(r4 * I8_XS, r5 * I8_XS, r6 * I8_XS, r7 * I8_XS); *(u32x2*)((unsigned char*)XB + XQOFF + (size_t)row * D + col0 + bj * 128) = q8; }
                }
                ss = sum_rows4(ss);
                if (fq == 0) RS[(size_t)row * 16 + u.pn * 4 + wc] = ss;
            }
    }
};
typedef EpiResBT<false, false> EpiResB;
struct EpiScale {
    static constexpr bool PERM = true;
    bf16* out; int ldc; const float* scale; const LAS float* sc_lds; float mul;
    __device__ __forceinline__ void operator()(const Acc& acc, const Unit& u, int wr, int wc, int fr, int fq) const {
        const int col0 = u.pn * 256 + wc * 32 + 8 * fq;
#pragma unroll
        for (int ai = 0; ai < 2; ++ai)
#pragma unroll
            for (int m = 0; m < 4; ++m) {
                const int row = u.pm * 256 + ai * 128 + wr * 64 + m * 16 + fr; const float rs = (sc_lds ? sc_lds[u.idx * 256 + ai * 128 + wr * 64 + m * 16 + fr] : scale[row]) * mul;
#pragma unroll
                for (int bj = 0; bj < 2; ++bj) {
                    const f32x4 v0 = acc[ai][bj][m][0] * rs, v1 = acc[ai][bj][m][1] * rs;
                    u32x4 w; w.x = pk2(v0[0], v0[1]); w.y = pk2(v0[2], v0[3]); w.z = pk2(v1[0], v1[1]); w.w = pk2(v1[2], v1[3]);
                    *(u32x4*)(out + (size_t)row * ldc + col0 + bj * 128) = w;
                }
            }
    }
};
struct EpiCmp1 {
    static constexpr bool PERM = true;
    bf16* out; const float* c1;
    __device__ __forceinline__ void operator()(const Acc& acc, const Unit& u, int wr, int wc, int fr, int fq) const {
        const int col0 = wc * 32 + 8 * fq; const float* cb = c1 + (u.pm >> 4) * 256;
#pragma unroll
        for (int bj = 0; bj < 2; ++bj) {
            const f32x4 b0 = *(const f32x4*)(cb + col0 + bj * 128), b1 = *(const f32x4*)(cb + col0 + bj * 128 + 4);
#pragma unroll
            for (int ai = 0; ai < 2; ++ai)
#pragma unroll
                for (int m = 0; m < 4; ++m) {
                    const int row = u.pm * 256 + ai * 128 + wr * 64 + m * 16 + fr;
                    f32x4 v0 = acc[ai][bj][m][0] + b0, v1 = acc[ai][bj][m][1] + b1;
#pragma unroll
                    for (int i = 0; i < 4; ++i) { v0[i] = gelu_tanh(v0[i]); v1[i] = gelu_tanh(v1[i]); }
                    u32x4 w; w.x = pk2(v0[0], v0[1]); w.y = pk2(v0[2], v0[3]); w.z = pk2(v1[0], v1[1]); w.w = pk2(v1[2], v1[3]);
                    *(u32x4*)(out + (size_t)row * 256 + col0 + bj * 128) = w;
                }
        }
    }
};

template <class Epi, class Sched>
__device__ __forceinline__ void gemm_naive(unsigned char* lds, const Gemm g, const Sched& S, const Epi& E) {
    const int tid = threadIdx.x, wid = tid >> 6, lane = tid & 63, wr = wid >> 2, wc = wid & 3, fr = lane & 15, fq = lane >> 4;
    float* As = (float*)lds;
    float* Bs = As + 16 * 260;
    Unit u;
    for (int it = 0; S.next(it, u); ++it) {
        Acc acc;
#pragma unroll
        for (int a = 0; a < 2; ++a)
#pragma unroll
            for (int b = 0; b < 2; ++b)
#pragma unroll
                for (int m = 0; m < 4; ++m)
#pragma unroll
                    for (int n = 0; n < 2; ++n) acc[a][b][m][n] = (f32x4){0.f, 0.f, 0.f, 0.f};
        const int r = tid >> 1, kc = (tid & 1) * 8;
        const unsigned char* ap = (const unsigned char*)g.A + u.aoff + (size_t)(r >> 7) * g.a_half + (size_t)(r & 127) * g.a_row + kc * 2;
        const unsigned char* bp = (const unsigned char*)g.Bt + u.boff + (size_t)(r >> 7) * g.b_half + (size_t)(r & 127) * g.b_row + kc * 2;
        for (int k0 = 0; k0 < g.K; k0 += 16) {
            const u32x4 va = *(const u32x4*)(ap + (size_t)(k0 >> 6) * g.a_k + (k0 & 63) * 2);
            const u32x4 vb = *(const u32x4*)(bp + (size_t)(k0 >> 6) * g.b_k + (k0 & 63) * 2);
            __syncthreads();
#pragma unroll
            for (int j = 0; j < 4; ++j) {
                As[(kc + 2 * j) * 260 + r] = bf2f(va[j] & 0xffffu); As[(kc + 2 * j + 1) * 260 + r] = bf2f(va[j] >> 16);
                Bs[(kc + 2 * j) * 260 + r] = bf2f(vb[j] & 0xffffu); Bs[(kc + 2 * j + 1) * 260 + r] = bf2f(vb[j] >> 16);
            }
            __syncthreads();
#pragma unroll 1
            for (int kk = 0; kk < 16; ++kk) {
                float a[2][4]; f32x4 b[2][2];
#pragma unroll
                for (int ai = 0; ai < 2; ++ai)
#pragma unroll
                    for (int m = 0; m < 4; ++m) a[ai][m] = As[kk * 260 + ai * 128 + wr * 64 + m * 16 + fr];
#pragma unroll
                for (int bj = 0; bj < 2; ++bj)
#pragma unroll
                    for (int n = 0; n < 2; ++n) b[bj][n] = *(const f32x4*)&Bs[kk * 260 + bj * 128 + wc * 32 + (Epi::PERM ? 8 * fq + 4 * n : 16 * n + 4 * fq)];
#pragma unroll
                for (int ai = 0; ai < 2; ++ai)
#pragma unroll
                    for (int bj = 0; bj < 2; ++bj)
#pragma unroll
                        for (int m = 0; m < 4; ++m)
#pragma unroll
                            for (int n = 0; n < 2; ++n) acc[ai][bj][m][n] += b[bj][n] * a[ai][m];
            }
        }
        E(acc, u, wr, wc, fr, fq);
    }
    __syncthreads();
}

namespace pg8 {
constexpr int BM = 256, BK = 64, HALF = 128, HTB = HALF * BK * 2, STAGE_BYTES = 8 * HTB;
__host__ __device__ __forceinline__ int lds_byte(int r, int c) { const int st = (r >> 4) * 2 + (c >> 5), rr = r & 15, cc = c & 31, ob = rr * 64 + cc * 2; return st * 1024 + (ob ^ (((ob >> 9) & 1) << 5)); }
__host__ __device__ __forceinline__ void stage_rc(int b, int& R, int& C) { const int st = b / 1024, sb = b % 1024, swz = sb ^ (((sb >> 9) & 1) << 5); R = (st >> 1) * 16 + swz / 64; C = (st & 1) * 32 + (swz % 64) / 2; }
typedef int i32x8_t __attribute__((ext_vector_type(8)));
typedef int i32x4_t __attribute__((ext_vector_type(4)));
__device__ __forceinline__ i32x8_t f8cat(bf16x8 lo, bf16x8 hi) { return __builtin_shufflevector(__builtin_bit_cast(i32x4_t, lo), __builtin_bit_cast(i32x4_t, hi), 0, 1, 2, 3, 4, 5, 6, 7); }
__device__ __forceinline__ bf16x8 f8lo(i32x8_t v) { return __builtin_bit_cast(bf16x8, (i32x4_t)__builtin_shufflevector(v, v, 0, 1, 2, 3)); }
__device__ __forceinline__ bf16x8 f8hi(i32x8_t v) { return __builtin_bit_cast(bf16x8, (i32x4_t)__builtin_shufflevector(v, v, 4, 5, 6, 7)); }
__host__ __device__ __forceinline__ int perm32(int rho) { const int n = rho >> 4, i = rho & 15; return 8 * (i >> 2) + 4 * n + (i & 3); }

template <class Epi, class Sched, bool ALIGN_EPI, bool GATHER = false, bool F8 = false, bool I8 = false>
__device__ __forceinline__ void gemm_phase(int wave_s, LAS unsigned char* lds, const Gemm g, const Sched& S, const Epi& E, const LAS int* rmap = nullptr) {
    int tid = tid_now(wave_s); asm volatile("" : "+v"(tid));
    const int wid = wave_s, lane = tid & 63, wr = wid >> 2, wc = wid & 3, fr = lane & 15, fq = lane >> 4;
    const int nt = g.K / BK;
    unsigned voffA[2], voffB[2];
#pragma unroll
    for (int i = 0; i < 2; ++i) { int R, C; stage_rc(tid * 16 + i * 8192, R, C); const int Rb = Epi::PERM ? ((R & ~31) + perm32(R & 31)) : R;
        voffA[i] = (unsigned)R * g.a_row + (unsigned)C * 2u; voffB[i] = (unsigned)Rb * g.b_row + (unsigned)C * 2u; }
    unsigned vc[2][2];
#define PG8_GLOAD(dst, ui_) do { _Pragma("unroll") for (int h_ = 0; h_ < 2; ++h_) _Pragma("unroll") for (int i_ = 0; i_ < 2; ++i_) dst[h_][i_] = ((unsigned)rmap[(ui_) * 256 + h_ * 128 + (int)(voffA[i_] >> (F8 ? 10 : 11))] << (F8 ? 10 : 11)) + (voffA[i_] & (F8 ? 1023u : 2047u)); } while (0)
    const size_t kA = g.a_k, kB = g.b_k, hA = g.a_half, hB = g.b_half;
    const unsigned ldsw = (unsigned)wid * 1024u;
    const int aoff = lds_byte(wr * 64 + fr, fq * 8), boff = lds_byte(wc * 32 + fr, fq * 8) + 4 * HTB;
#define PG8_SA(b, h) (((b) * 2 + (h)) * HTB)
#define PG8_SB(b, h) ((4 + (b) * 2 + (h)) * HTB)
#define PG8_STAGE(bufoff, gbase, voff) do { const char* gb_ = (const char*)(gbase); if constexpr (F8) asm volatile("" : "+s"(gb_)); _Pragma("unroll") for (int _i = 0; _i < 2; ++_i) \
        __builtin_amdgcn_global_load_lds((const unsigned*)(gb_ + (voff)[_i]), (LAS unsigned*)(lds + (bufoff) + ldsw + _i * 8192), 16, 0, 0); } while (0)
#define PG8_STAGE_G(bufoff, gbase, voff) do { const char* gb_ = (const char*)(gbase); asm volatile("" : "+s"(gb_)); _Pragma("unroll") for (int _i = 0; _i < 2; ++_i) \
        __builtin_amdgcn_global_load_lds((const unsigned*)(gb_ + (voff)[_i]), (LAS unsigned*)(lds + (bufoff) + ldsw + _i * 8192), 16, 0, 0); } while (0)
#define PG8_LDA(dst, b, h) do { _Pragma("unroll") for (int m = 0; m < 4; ++m) dst[m] = f8cat(*(const LAS bf16x8*)(lds + PG8_SA(b, h) + aoff + m * 2048), *(const LAS bf16x8*)(lds + PG8_SA(b, h) + aoff + m * 2048 + 1024)); } while (0)
#define PG8_LDB(dst, b, h) do { _Pragma("unroll") for (int n = 0; n < 2; ++n) dst[n] = f8cat(*(const LAS bf16x8*)(lds + ((b) * 2 + (h)) * HTB + boff + n * 2048), *(const LAS bf16x8*)(lds + ((b) * 2 + (h)) * HTB + boff + n * 2048 + 1024)); } while (0)
#define PG8_MMA(ai, bj, At, Bt) do { __builtin_amdgcn_s_setprio(1); _Pragma("unroll") for (int m = 0; m < 4; ++m) _Pragma("unroll") for (int n = 0; n < 2; ++n) { \
        if constexpr (F8 && I8) { i32x4_t c_ = __builtin_bit_cast(i32x4_t, acc[ai][bj][m][n]); \
            c_ = __builtin_amdgcn_mfma_i32_16x16x64_i8(__builtin_bit_cast(i32x4_t, f8lo(Bt[n])), __builtin_bit_cast(i32x4_t, f8lo(At[m])), c_, 0, 0, 0); \
            c_ = __builtin_amdgcn_mfma_i32_16x16x64_i8(__builtin_bit_cast(i32x4_t, f8hi(Bt[n])), __builtin_bit_cast(i32x4_t, f8hi(At[m])), c_, 0, 0, 0); acc[ai][bj][m][n] = __builtin_bit_cast(f32x4, c_); } \
        else if constexpr (F8) acc[ai][bj][m][n] = __builtin_amdgcn_mfma_scale_f32_16x16x128_f8f6f4(Bt[n], At[m], acc[ai][bj][m][n], 0, 0, 0, 0, 0, 0); \
        else { acc[ai][bj][m][n] = __builtin_amdgcn_mfma_f32_16x16x32_bf16(f8lo(Bt[n]), f8lo(At[m]), acc[ai][bj][m][n], 0, 0, 0); acc[ai][bj][m][n] = __builtin_amdgcn_mfma_f32_16x16x32_bf16(f8hi(Bt[n]), f8hi(At[m]), acc[ai][bj][m][n], 0, 0, 0); } } \
        __builtin_amdgcn_s_setprio(0); } while (0)
#define PG8_WAIT_V(n) asm volatile("s_waitcnt vmcnt(" #n ")" ::: "memory")
#define PG8_WAIT_L(n) asm volatile("s_waitcnt lgkmcnt(" #n ")" ::: "memory")
#define PG8_BAR __builtin_amdgcn_s_barrier()
#define PG8_SCHED __builtin_amdgcn_sched_barrier(0)
    Unit cur, nxt; int ui = 0;
    if (!S.next(0, cur)) return;
    Acc acc;
#pragma unroll
    for (int a = 0; a < 2; ++a)
#pragma unroll
        for (int b = 0; b < 2; ++b)
#pragma unroll
            for (int m = 0; m < 4; ++m)
#pragma unroll
                for (int n = 0; n < 2; ++n) acc[a][b][m][n] = (f32x4){0.f, 0.f, 0.f, 0.f};
    i32x8_t At[4], B0[2], B1[2];
    const char* cA = (const char*)g.A + (GATHER ? 0 : cur.aoff); const char* cB = (const char*)g.Bt + cur.boff;
    if constexpr (GATHER) { PG8_GLOAD(vc, 0); }
    PG8_STAGE(PG8_SB(0, 0), cB, voffB); PG8_STAGE(PG8_SB(0, 1), cB + hB, voffB);
    if constexpr (GATHER) { PG8_STAGE_G(PG8_SA(0, 0), cA, vc[0]); PG8_STAGE_G(PG8_SA(0, 1), cA, vc[1]); } else { PG8_STAGE(PG8_SA(0, 0), cA, voffA); PG8_STAGE(PG8_SA(0, 1), cA + hA, voffA); }
    if (wr == 1) PG8_BAR;
    PG8_WAIT_V(2); PG8_BAR;
    PG8_STAGE(PG8_SB(1, 0), cB + kB, voffB); if constexpr (GATHER) PG8_STAGE_G(PG8_SA(1, 0), cA + kA, vc[0]); else PG8_STAGE(PG8_SA(1, 0), cA + kA, voffA); PG8_STAGE(PG8_SB(1, 1), cB + hB + kB, voffB);
    PG8_WAIT_V(6); PG8_BAR;
    for (;;) {
        const bool has_next = S.next(ui + 1, nxt);
        const char* nA = (has_next && !GATHER) ? (const char*)g.A + nxt.aoff : cA; const char* nB = has_next ? (const char*)g.Bt + nxt.boff : cB;
        for (int t = 0; t < nt; t += 2) {
            const bool last = (t == nt - 2);
            const char* a1 = cA + (size_t)(t + 1) * kA;
            const char* a2 = last ? nA : cA + (size_t)(t + 2) * kA; const char* b2 = last ? nB : cB + (size_t)(t + 2) * kB;
            const char* a3 = a2 + kA; const char* b3 = b2 + kB;
            PG8_LDB(B0, 0, 0); PG8_LDB(B1, 0, 1); PG8_SCHED; PG8_LDA(At, 0, 0); if constexpr (GATHER) { PG8_STAGE_G(PG8_SA(1, 1), a1, vc[1]); if (last && has_next) PG8_GLOAD(vc, ui + 1); }     else PG8_STAGE(PG8_SA(1, 1), a1 + hA, voffA);
            PG8_WAIT_V(8); PG8_WAIT_L(0); PG8_BAR; PG8_MMA(0, 0, At, B0); PG8_MMA(0, 1, At, B1); PG8_BAR; PG8_SCHED;
            PG8_LDA(At, 0, 1); PG8_STAGE(PG8_SB(0, 0), b2, voffB); PG8_STAGE(PG8_SB(0, 1), b2 + hB, voffB); if constexpr (GATHER) PG8_STAGE_G(PG8_SA(0, 0), a2, vc[0]); else PG8_STAGE(PG8_SA(0, 0), a2, voffA);
            PG8_WAIT_V(8); PG8_WAIT_L(0); PG8_BAR; PG8_MMA(1, 0, At, B0); PG8_MMA(1, 1, At, B1); PG8_BAR; PG8_SCHED;
            PG8_LDB(B0, 1, 0); PG8_LDB(B1, 1, 1); PG8_SCHED; PG8_LDA(At, 1, 0); if constexpr (GATHER) PG8_STAGE_G(PG8_SA(0, 1), a2, vc[1]); else PG8_STAGE(PG8_SA(0, 1), a2 + hA, voffA);
            PG8_WAIT_V(8); PG8_WAIT_L(0); PG8_BAR; PG8_MMA(0, 0, At, B0); PG8_MMA(0, 1, At, B1); PG8_BAR; PG8_SCHED;
            PG8_LDA(At, 1, 1); PG8_STAGE(PG8_SB(1, 0), b3, voffB); PG8_STAGE(PG8_SB(1, 1), b3 + hB, voffB); if constexpr (GATHER) PG8_STAGE_G(PG8_SA(1, 0), a3, vc[0]); else PG8_STAGE(PG8_SA(1, 0), a3, voffA);
            PG8_WAIT_V(8); PG8_WAIT_L(0); PG8_BAR; PG8_MMA(1, 0, At, B0); PG8_MMA(1, 1, At, B1); PG8_BAR; PG8_SCHED;
        }
        if constexpr (ALIGN_EPI) { if (wr == 0) PG8_BAR; }
        { const int t2_ = lane_after(acc[1][1][3][1][3]); E(acc, cur, wr, wc, t2_ & 15, (t2_ >> 4) & 3); }
        if (!has_next) break;
#pragma unroll
        for (int a = 0; a < 2; ++a)
#pragma unroll
            for (int b = 0; b < 2; ++b)
#pragma unroll
                for (int m = 0; m < 4; ++m)
#pragma unroll
                    for (int n = 0; n < 2; ++n) acc[a][b][m][n] = (f32x4){0.f, 0.f, 0.f, 0.f};
        cur = nxt; cA = nA; cB = nB; ++ui;
        if constexpr (ALIGN_EPI) { if (wr == 1) PG8_BAR; }
    }
    PG8_WAIT_V(0);
    if constexpr (!ALIGN_EPI) { if (wr == 0) PG8_BAR; }
    PG8_BAR;
#undef PG8_GLOAD
#undef PG8_SA
#undef PG8_SB
#undef PG8_STAGE
#undef PG8_STAGE_G
#undef PG8_LDA
#undef PG8_LDB
#undef PG8_MMA
#undef PG8_WAIT_V
#undef PG8_WAIT_L
#undef PG8_BAR
#undef PG8_SCHED
}
}
#ifndef MFMA_MASK
#define MFMA_MASK 0xFFFFu
#endif
template <int PH, class Epi, class Sched>
__device__ __forceinline__ void gemm_run(const Frame& F, const Gemm g, const Sched& S, const Epi& E) {
    if constexpr (((MFMA_MASK >> PH) & 1u) != 0u) pg8::gemm_phase<Epi, Sched, true>(F.wave, (LAS unsigned char*)F.lds, g, S, E);
    else gemm_naive<Epi, Sched>(F.lds, g, S, E);
}

enum { MAP_ID = 0, MAP_GATE = 1, MAP_UP = 2, MAP_IN1 = 3, MAP_GATE8 = 4, MAP_UP8 = 5 };
__device__ __forceinline__ int map_row(int mapk, int n) {
    if (mapk == MAP_GATE) return 8 * (n >> 2) + (n & 3);
    if (mapk == MAP_UP) return 8 * (n >> 2) + 4 + (n & 3);
    if (mapk == MAP_GATE8 || mapk == MAP_UP8) return 256 * (n >> 7) + 128 * ((n >> 2) & 1) + 32 * ((n >> 5) & 3) + 8 * ((n >> 3) & 3) + (mapk == MAP_UP8 ? 4 : 0) + (n & 3);
    if (mapk == MAP_IN1) return n < 1280 ? n : (n < 1304 ? C_GL + (n - 1280) : n - 24);
    return n;
}
struct TrDesc { const float* W; bf16* WT; const float* gain; int K, N, mapk, k0, n0, ld8; };
__device__ __forceinline__ TrDesc tr_mk(const float* W, int K, int N, bf16* WT, const float* gain, int mapk, int item, int ld8 = 0) {
    TrDesc d; d.W = W; d.WT = WT; d.gain = gain; d.K = K; d.N = N; d.mapk = mapk; d.ld8 = ld8;
    const int nblk = (N + 63) >> 6, kb = item / nblk, nb = item - kb * nblk; d.k0 = 64 * kb; d.n0 = 64 * nb; return d;
}
__device__ __forceinline__ void tr_load(const TrDesc& d, f32x4 (&v)[16], int lane) {
    const int krow = lane >> 4, n = d.n0 + 4 * (lane & 15);
#pragma unroll
    for (int p = 0; p < 16; ++p) v[p] = n < d.N ? *(const f32x4*)(d.W + (size_t)(d.k0 + 4 * p + krow) * d.N + n) : (f32x4){0.f, 0.f, 0.f, 0.f};
}
__device__ __forceinline__ void tr_finish(const TrDesc& d, f32x4 (&v)[16], float* scr, int lane) {
    const int krow = lane >> 4, c4 = lane & 15;
    if (d.gain) {
#pragma unroll
        for (int p = 0; p < 16; ++p) v[p] = v[p] * d.gain[d.k0 + 4 * p + krow];
    }
#pragma unroll
    for (int p = 0; p < 16; ++p) { float* q = scr + (4 * p + krow) * 65 + 4 * c4; q[0] = v[p][0]; q[1] = v[p][1]; q[2] = v[p][2]; q[3] = v[p][3]; }
    LDS_FENCE();
    const int c = lane & 7;
#pragma unroll
    for (int j = 0; j < 8; ++j) {
        const int nl = (lane >> 3) + 8 * j, nn = d.n0 + nl;
        if (nn < d.N) {
            const float* sp = scr + (8 * c) * 65 + nl;
            if (d.ld8 < 0) {
                u32x2 o; o.x = pk4_i8(sp[0 * 65] * I8_WS, sp[1 * 65] * I8_WS, sp[2 * 65] * I8_WS, sp[3 * 65] * I8_WS); o.y = pk4_i8(sp[4 * 65] * I8_WS, sp[5 * 65] * I8_WS, sp[6 * 65] * I8_WS, sp[7 * 65] * I8_WS);
                *(u32x2*)((unsigned char*)d.WT + (size_t)map_row(d.mapk, nn) * (-d.ld8) + d.k0 + 8 * c) = o;
            } else if (d.ld8) {
                u32x2 o; o.x = pk4_f8(sp[0 * 65] * F8_WS, sp[1 * 65] * F8_WS, sp[2 * 65] * F8_WS, sp[3 * 65] * F8_WS); o.y = pk4_f8(sp[4 * 65] * F8_WS, sp[5 * 65] * F8_WS, sp[6 * 65] * F8_WS, sp[7 * 65] * F8_WS);
                *(u32x2*)((unsigned char*)d.WT + (size_t)map_row(d.mapk, nn) * d.ld8 + d.k0 + 8 * c) = o;
            } else {
                u32x4 o; o.x = pk2(sp[0 * 65], sp[1 * 65]); o.y = pk2(sp[2 * 65], sp[3 * 65]); o.z = pk2(sp[4 * 65], sp[5 * 65]); o.w = pk2(sp[6 * 65], sp[7 * 65]);
                *(u32x4*)(d.WT + (size_t)map_row(d.mapk, nn) * d.K + d.k0 + 8 * c) = o;
            }
        }
    }
    LDS_FENCE();
}
constexpr int I_IN0 = 16 * 44, I_SQ = 16 * 16, I_GU0 = 16 * 44, I_DN0 = 44 * 16, I_IN1 = 16 * 45, I_MG = 16 * 22, I_MD = 22 * 16, I_C1 = 32 * 4, I_C2 = 4 * 1, I_L64 = 8, I_L128 = 16;
constexpr int TR_NITEMS = I_IN0 + I_SQ + 2 * I_GU0 + I_DN0 + I_IN1 + I_SQ + 16 * I_MG + 8 * I_MD + 2 * I_C1 + 2 * I_C2 + 2 * I_L64 + I_L128;
__device__ __forceinline__ TrDesc tr_decode(const Frame& F, int it) {
    int r = it;
    if (r < I_IN0) return tr_mk(F.in[2], D, IN0, wsp<bf16>(F, WT_IN0), F.in[1], MAP_ID, r, -D); r -= I_IN0;
    if (r < I_SQ) return tr_mk(F.in[18], D, D, wsp<bf16>(F, WT_OUT0), nullptr, MAP_ID, r); r -= I_SQ;
    if (r < I_GU0) return tr_mk(F.in[20], D, FFN, wsp<bf16>(F, WT_GU0), F.in[19], MAP_GATE8, r, -D); r -= I_GU0;
    if (r < I_GU0) return tr_mk(F.in[21], D, FFN, wsp<bf16>(F, WT_GU0), F.in[19], MAP_UP8, r, -D); r -= I_GU0;
    if (r < I_DN0) return tr_mk(F.in[22], FFN, D, wsp<bf16>(F, WT_DN0), nullptr, MAP_ID, r, FFN); r -= I_DN0;
    if (r < I_IN1) return tr_mk(F.in[24], D, IN1, wsp<bf16>(F, WT_IN1), F.in[23], MAP_IN1, r, -D); r -= I_IN1;
    if (r < I_SQ) return tr_mk(F.in[32], D, D, wsp<bf16>(F, WT_OUT1), nullptr, MAP_ID, r); r -= I_SQ;
    if (r < 8 * I_MG) { const int e = r / I_MG; return tr_mk(F.in[36] + (size_t)e * D * EXPD, D, EXPD, (bf16*)(F.ws + WT_GU1 + (size_t)e * 2 * EXPD * D), F.in[33], MAP_GATE8, r - e * I_MG, -D); } r -= 8 * I_MG;
    if (r < 8 * I_MG) { const int e = r / I_MG; return tr_mk(F.in[37] + (size_t)e * D * EXPD, D, EXPD, (bf16*)(F.ws + WT_GU1 + (size_t)e * 2 * EXPD * D), F.in[33], MAP_UP8, r - e * I_MG, -D); } r -= 8 * I_MG;
    if (r < 8 * I_MD) { const int e = r / I_MD; return tr_mk(F.in[38] + (size_t)e * EXPD * D, EXPD, D, (bf16*)(F.ws + WT_DN1 + (size_t)e * D * AP8), nullptr, MAP_ID, r - e * I_MD, AP8); } r -= 8 * I_MD;
    if (r < I_C1) return tr_mk(F.in[27], 2048, 256, wsp<bf16>(F, WT_CK1), nullptr, MAP_ID, r); r -= I_C1;
    if (r < I_C1) return tr_mk(F.in[29], 2048, 256, wsp<bf16>(F, WT_CV1), nullptr, MAP_ID, r); r -= I_C1;
    if (r < I_C2) return tr_mk(F.in[28], 256, 64, wsp<bf16>(F, WT_CK2), nullptr, MAP_ID, r); r -= I_C2;
    if (r < I_C2) return tr_mk(F.in[30], 256, 64, wsp<bf16>(F, WT_CV2), nullptr, MAP_ID, r); r -= I_C2;
    if (r < I_L64) return tr_mk(F.in[9], 64, 512, wsp<bf16>(F, WT_W2), nullptr, MAP_ID, r); r -= I_L64;
    if (r < I_L64) return tr_mk(F.in[11], 64, 512, wsp<bf16>(F, WT_A2), nullptr, MAP_ID, r); r -= I_L64;
    return tr_mk(F.in[12], 128, 512, wsp<bf16>(F, WT_G2), nullptr, MAP_ID, r);
}
__device__ __forceinline__ void tr_range(const Frame& F, int lo, int hi, int gw, int NGW) {
    float* scr = (float*)(F.lds + F.wave * 16640);
    int lane_ = F.lane; asm volatile("" : "+v"(lane_));
    for (int it = lo + gw; it < hi; it += NGW) { TrDesc d = tr_decode(F, it); f32x4 v[16]; tr_load(d, v, lane_); tr_finish(d, v, scr, lane_); }
}
constexpr int CW_TRQ = 2048;
__device__ __forceinline__ void tr_queue(const Frame& F, int lo, int hi) {
    float* scr = (float*)(F.lds + F.wave * 16640);
    int lane_ = F.lane; asm volatile("" : "+v"(lane_));
    unsigned* head = (unsigned*)(F.ws + WS_CTL) + CW_TRQ;
    for (;;) {
        unsigned base = 0;
        if (lane_ == 0) base = __hip_atomic_fetch_add(head, 2u, __ATOMIC_RELAXED, __HIP_MEMORY_SCOPE_AGENT);
        base = __builtin_amdgcn_readfirstlane(base);
        const int it0 = lo + (int)base;
        if (it0 >= hi) break;
        { TrDesc d = tr_decode(F, it0); f32x4 v[16]; tr_load(d, v, lane_); tr_finish(d, v, scr, lane_); }
        if (it0 + 1 < hi) { TrDesc d = tr_decode(F, it0 + 1); f32x4 v[16]; tr_load(d, v, lane_); tr_finish(d, v, scr, lane_); }
    }
}
constexpr int TR_LORA0 = TR_NITEMS - (2 * I_L64 + I_L128);
__device__ __forceinline__ void p0_prologue(const Frame& F) {
    const int gw = F.blk * NWAVES + F.wave, NGW = F.G * NWAVES;
    tr_range(F, 0, I_IN0, gw, NGW);
    tr_range(F, TR_LORA0, TR_NITEMS, gw, NGW);
    {
        const float* x = F.in[0]; bf16* XB = wsp<bf16>(F, WS_XB); float* rstd0 = wsp<float>(F, M_RSTD0);
        for (int m = gw; m < NTOK; m += NGW) {
            const f32x4* xr = (const f32x4*)(x + (size_t)m * D) + F.lane; f32x4 v[4]; float s = 0.f;
#pragma unroll
            for (int j = 0; j < 4; ++j) { v[j] = xr[64 * j]; s += (v[j].x * v[j].x + v[j].y * v[j].y) + (v[j].z * v[j].z + v[j].w * v[j].w); }
            s = wave_sum(s);
            float amax = 0.f;
#pragma unroll
            for (int j = 0; j < 4; ++j) amax = fmaxf(fmaxf(amax, fmaxf(fabsf(v[j].x), fabsf(v[j].y))), fmaxf(fabsf(v[j].z), fabsf(v[j].w)));
            amax = fmaxf(wave_max(amax), 1e-20f);
            const float qs = 127.0f * rcpf_(amax);
            u32x2* o8 = (u32x2*)(XB + (size_t)m * D) + F.lane;
#pragma unroll
            for (int j = 0; j < 4; ++j) { u32x2 w; w.x = pk2(v[j].x, v[j].y); w.y = pk2(v[j].z, v[j].w); o8[64 * j] = w; }
            unsigned* q4 = (unsigned*)(F.ws + WS_XQI + (size_t)m * D) + F.lane;
#pragma unroll
            for (int j = 0; j < 4; ++j) q4[64 * j] = pk4_i8(v[j].x * qs, v[j].y * qs, v[j].z * qs, v[j].w * qs);
            if (F.lane == 0) rstd0[m] = rsqrtf(s * (1.0f / D) + 1e-6f) * amax * (1.0f / 127.0f);
        }
    }
    const int gt = F.blk * NTHR + F.tid, NGT = F.G * NTHR;
    {
        float* rope = wsp<float>(F, M_ROPE);
        for (int idx = gt; idx < SEQ * 8; idx += NGT) {
            const int t = idx >> 3, i = idx & 7;
            const float invf = (float)pow(500000.0, -(double)i / 8.0);
            const float ang = (float)t * invf;
            rope[t * 16 + i] = cosf(ang); rope[t * 16 + 8 + i] = sinf(ang);
        }
    }
    {
        float* c1 = wsp<float>(F, M_C1);
        for (int idx = gw; idx < 512; idx += NGW) {
            const int which = idx >> 8, n = idx & 255; const float* pos = F.in[25 + which]; const float* W1 = F.in[which ? 29 : 27];
            float sacc = 0.f;
#pragma unroll 8
            for (int k = F.lane; k < 2048; k += 64) sacc += pos[k] * W1[(size_t)k * 256 + n];
            sacc = wave_sum(sacc);
            if (F.lane == 0) c1[idx] = sacc;
        }
    }
    {
        float* wr = wsp<float>(F, M_WR);
        for (int idx = gt; idx < 8 * D; idx += NGT) { const int e = idx >> 10, k = idx & 1023; wr[idx] = F.in[33][k] * F.in[34][k * 8 + e]; }
    }
    {
        bf16* wm = wsp<bf16>(F, WT_SGU);
        for (int idx = gt; idx < 4 * 128 * 128; idx += NGT) { const int t = (idx >> 7) & 127, s = idx & 127; wm[idx] = (bf16)(s <= t ? f2bf(F.in[5][idx]) : 0u); }
    }
    {
        for (int idx = gt; idx < NEXP * D * 8; idx += NGT) *(u32x4*)(F.ws + WT_DN1 + (size_t)(idx >> 3) * AP8 + EXPD + 16 * (idx & 7)) = (u32x4){0u, 0u, 0u, 0u};
    }
    {
        u32x4* z = (u32x4*)(F.ws + WT_IN1 + (size_t)IN1 * D);
        for (int idx = gt; idx < (IN1P - IN1) * D / 16; idx += NGT) z[idx] = (u32x4){0u, 0u, 0u, 0u};
    }
}

constexpr int RW_R = 0, RW_K = 8192, RW_V = 16384, RW_LIN = 24576, RW_LINP = 264, RW_DEC = 41472, RW_KK = 49664, RW_KKA = 57856, RW_KP = 66048, RW_WR = 74240, RW_G = 82432, RW_YO = 90624, RW_SC = 98816, RW_DUMMY = 99328, RW_MU = 103424, RW_LW2 = 105216, RW_LA2 = 114432, RW_LG2 = 123648;
struct RwA { u32x4 cur[4], prev[4]; };
__device__ __forceinline__ void rwkv_loadA(RwA& A, const bf16* PB, int b, int h, int t0, int tid) {
#pragma unroll
    for (int i = 0; i < 4; ++i) {
        const int idx = tid + NTHR * i;
        if (idx < 32 * 56) {
            const int tl = idx / 56, ch = idx - tl * 56;
            const int pc = ch < 8 ? 64 * h + 8 * ch : (ch < 16 ? 512 + 64 * h + 8 * (ch - 8) : (ch < 24 ? 1024 + 64 * h + 8 * (ch - 16) : 1536 + 8 * (ch - 24)));
            const int t = t0 + tl; const bf16* p = PB + ((size_t)b * SEQ + t) * IN0 + 1024 + pc;
            A.cur[i] = *(const u32x4*)p;
            A.prev[i] = t > 0 ? *(const u32x4*)(p - IN0) : (u32x4){0u, 0u, 0u, 0u};
        }
    }
}
__device__ __forceinline__ void rwkv_item(const Frame& F, int b, int h) {
    LAS unsigned char* L = (LAS unsigned char*)F.lds;
    const bf16* PB = wsp<bf16>(F, WS_PB); bf16* Y = wsp<bf16>(F, WS_YB);
    const float* mu = F.in[7]; const float* w0 = F.in[8]; const float* a0 = F.in[10];
    const float* k_k = F.in[13]; const float* k_a = F.in[14]; const float* r_k = F.in[15]; const float* gn_g = F.in[16]; const float* gn_b = F.in[17];
    int tid = F.tid; asm volatile("" : "+v"(tid));
    const int lane = tid & 63, wave = F.wave;
    const int jq = lane & 15, rg = lane >> 4, tl16 = tid >> 4;
    const int hc4 = 64 * h + 4 * jq;
    const f32x4 w0v = *(const f32x4*)(w0 + hc4), a0v = *(const f32x4*)(a0 + hc4), kkv = *(const f32x4*)(k_k + hc4), kav = *(const f32x4*)(k_a + hc4), rkv = *(const f32x4*)(r_k + hc4), gngv = *(const f32x4*)(gn_g + hc4), gnbv = *(const f32x4*)(gn_b + hc4);
    const int mt = wave >> 2, ntl = wave & 3, fr = lane & 15, fq = lane >> 4;
    const int i0 = 8 * wave + rg, i1 = i0 + 4;
    f32x2 s0a = {0.f, 0.f}, s0b = {0.f, 0.f}, s1a = {0.f, 0.f}, s1b = {0.f, 0.f};
    {
        if (tid < 56 * 2) { const int ch = tid >> 1, hf = tid & 1;
            const int pc = ch < 8 ? 64 * h + 8 * ch : (ch < 16 ? 512 + 64 * h + 8 * (ch - 8) : (ch < 24 ? 1024 + 64 * h + 8 * (ch - 16) : 1536 + 8 * (ch - 24)));
            *(LAS f32x4*)(L + RW_MU + ch * 32 + hf * 16) = *(const f32x4*)(mu + pc + 4 * hf); }
        { const int row = tid >> 3, c8 = tid & 7;
          *(LAS u32x4*)(L + RW_LW2 + (row * 72 + c8 * 8) * 2) = *(const u32x4*)(wsp<bf16>(F, WT_W2) + (size_t)(64 * h + row) * 64 + c8 * 8);
          *(LAS u32x4*)(L + RW_LA2 + (row * 72 + c8 * 8) * 2) = *(const u32x4*)(wsp<bf16>(F, WT_A2) + (size_t)(64 * h + row) * 64 + c8 * 8); }
#pragma unroll
        for (int i = 0; i < 2; ++i) { const int id = tid + NTHR * i, row = id >> 4, c16 = id & 15;
          *(LAS u32x4*)(L + RW_LG2 + (row * 136 + c16 * 8) * 2) = *(const u32x4*)(wsp<bf16>(F, WT_G2) + (size_t)(64 * h + row) * 128 + c16 * 8); }
        __syncthreads();
    }
    RwA A; rwkv_loadA(A, PB, b, h, 0, tid);
    for (int t0 = 0; t0 < SEQ; t0 += 32) {
#pragma unroll
        for (int i = 0; i < 4; ++i) {
            const int idx = tid + NTHR * i;
            if (idx < 32 * 56) {
                const int tl = idx / 56, ch = idx - tl * 56;
                const int pc = ch < 8 ? 64 * h + 8 * ch : (ch < 16 ? 512 + 64 * h + 8 * (ch - 8) : (ch < 24 ? 1024 + 64 * h + 8 * (ch - 16) : 1536 + 8 * (ch - 24)));
                const f32x4 m0 = *(const LAS f32x4*)(L + RW_MU + ch * 32), m1 = *(const LAS f32x4*)(L + RW_MU + ch * 32 + 16);
                float xs[8];
#pragma unroll
                for (int j = 0; j < 4; ++j) {
                    const float c0 = bf2f(A.cur[i][j] & 0xffffu), c1 = bf2f(A.cur[i][j] >> 16), p0 = bf2f(A.prev[i][j] & 0xffffu), p1 = bf2f(A.prev[i][j] >> 16);
                    const float mA = j < 2 ? m0[2 * j] : m1[2 * j - 4], mB = j < 2 ? m0[2 * j + 1] : m1[2 * j - 3];
                    xs[2 * j] = c0 + (p0 - c0) * mA; xs[2 * j + 1] = c1 + (p1 - c1) * mB;
                }
                if (ch < 24) {
                    LAS float* dst = (LAS float*)(L + (ch < 8 ? RW_R : (ch < 16 ? RW_K : RW_V))) + tl * 64 + 8 * (ch & 7);
                    *(LAS f32x4*)dst = (f32x4){xs[0], xs[1], xs[2], xs[3]}; *(LAS f32x4*)(dst + 4) = (f32x4){xs[4], xs[5], xs[6], xs[7]};
                } else {
                    const int lc = ch - 24;
                    if (lc < 8) {
#pragma unroll
                        for (int j = 0; j < 8; ++j) xs[j] = 1.0f - 2.0f / (1.0f + __expf(2.0f * xs[j]));
                    } else if (lc >= 16) {
#pragma unroll
                        for (int j = 0; j < 8; ++j) xs[j] = sigmoidf_(xs[j]);
                    }
                    u32x4 w; w.x = pk2(xs[0], xs[1]); w.y = pk2(xs[2], xs[3]); w.z = pk2(xs[4], xs[5]); w.w = pk2(xs[6], xs[7]);
                    *(LAS u32x4*)(L + RW_LIN + (tl * RW_LINP + 8 * lc) * 2) = w;
                }
            }
        }
        __syncthreads();
        {
            const LAS unsigned char* arow = L + RW_LIN + ((16 * mt + fr) * RW_LINP + 8 * fq) * 2;
            f32x4 cw = {0.f, 0.f, 0.f, 0.f}, ca = {0.f, 0.f, 0.f, 0.f}, cg = {0.f, 0.f, 0.f, 0.f};
            const LAS unsigned char* bw = L + RW_LW2 + ((16 * ntl + fr) * 72 + 8 * fq) * 2;
            const LAS unsigned char* ba = L + RW_LA2 + ((16 * ntl + fr) * 72 + 8 * fq) * 2;
            const LAS unsigned char* bg = L + RW_LG2 + ((16 * ntl + fr) * 136 + 8 * fq) * 2;
#pragma unroll
            for (int ks = 0; ks < 2; ++ks) {
                cw = __builtin_amdgcn_mfma_f32_16x16x32_bf16(*(const LAS bf16x8*)(arow + 64 * ks), *(const LAS bf16x8*)(bw + 64 * ks), cw, 0, 0, 0);
                ca = __builtin_amdgcn_mfma_f32_16x16x32_bf16(*(const LAS bf16x8*)(arow + 128 + 64 * ks), *(const LAS bf16x8*)(ba + 64 * ks), ca, 0, 0, 0);
            }
#pragma unroll
            for (int ks = 0; ks < 4; ++ks) cg = __builtin_amdgcn_mfma_f32_16x16x32_bf16(*(const LAS bf16x8*)(arow + 256 + 64 * ks), *(const LAS bf16x8*)(bg + 64 * ks), cg, 0, 0, 0);
#pragma unroll
            for (int r = 0; r < 4; ++r) {
                const int o = (16 * mt + 4 * fq + r) * 64 + 16 * ntl + fr;
                ((LAS float*)(L + RW_DEC))[o] = cw[r]; ((LAS float*)(L + RW_KKA))[o] = ca[r]; ((LAS float*)(L + RW_G))[o] = cg[r];
            }
        }
        __syncthreads();
        {
            const int o4 = (tl16 * 64 + 4 * jq) * 4;
            const f32x4 lw = *(const LAS f32x4*)(L + RW_DEC + o4), la = *(const LAS f32x4*)(L + RW_KKA + o4), kr = *(const LAS f32x4*)(L + RW_K + o4), r = *(const LAS f32x4*)(L + RW_R + o4);
            f32x4 dec, a, kkr, kp;
#pragma unroll
            for (int i = 0; i < 4; ++i) {
                const float nx = -(w0v[i] + lw[i]);
                const float sp = fmaxf(nx, 0.f) + __logf(1.0f + __expf(-fabsf(nx)));
                dec[i] = __expf(-__expf(-sp - 0.5f));
                a[i] = sigmoidf_(a0v[i] + la[i]);
                kkr[i] = kr[i] * kkv[i]; kp[i] = kr[i] * (1.0f + (a[i] - 1.0f) * kav[i]);
            }
            const float n2 = red16((kkr[0] * kkr[0] + kkr[1] * kkr[1]) + (kkr[2] * kkr[2] + kkr[3] * kkr[3]));
            const float inv = 1.0f / fmaxf(sqrtf(n2), 1e-12f);
            const f32x4 kk = kkr * inv, kka = kk * a;
            const float c1 = red16((kka[0] * r[0] + kka[1] * r[1]) + (kka[2] * r[2] + kka[3] * r[3]));
            const float c2 = red16((kp[0] * r[0] + kp[1] * r[1]) + (kp[2] * r[2] + kp[3] * r[3]));
            const float c3 = red16((r[0] * kp[0] * rkv[0] + r[1] * kp[1] * rkv[1]) + (r[2] * kp[2] * rkv[2] + r[3] * kp[3] * rkv[3]));
            *(LAS f32x4*)(L + RW_DEC + o4) = dec; *(LAS f32x4*)(L + RW_KK + o4) = kk; *(LAS f32x4*)(L + RW_KKA + o4) = kka; *(LAS f32x4*)(L + RW_KP + o4) = kp; *(LAS f32x4*)(L + RW_WR + o4) = dec * r;
            if (jq == 0) { LAS float* sc = (LAS float*)(L + RW_SC) + tl16 * 4; sc[0] = c1; sc[1] = c2; sc[2] = c3; }
        }
        __syncthreads();
        if (t0 + 32 < SEQ) rwkv_loadA(A, PB, b, h, t0 + 32, tid);
        {
            const LAS unsigned char* p1 = L + RW_DEC + 16 * jq;
            const LAS unsigned char* p2 = L + RW_V + 4 * i0;
            const LAS unsigned char* p3 = L + RW_SC;
            LAS unsigned char* py = L + (jq == 0 ? RW_YO + 4 * i0 : RW_DUMMY + (tid >> 2) * 32 + (tid & 3) * 4);
            const int ystep = jq == 0 ? 512 : 0;
#define RW_LOAD(B, o) do { B##d = *(const LAS f32x4*)(p1 + (o) * 256); B##k = *(const LAS f32x4*)(p1 + 8192 + (o) * 256); B##a = *(const LAS f32x4*)(p1 + 16384 + (o) * 256); \
                B##p = *(const LAS f32x4*)(p1 + 24576 + (o) * 256); B##w = *(const LAS f32x4*)(p1 + 32768 + (o) * 256); \
                B##v0 = *(const LAS float*)(p2 + (o) * 256); B##v1 = *(const LAS float*)(p2 + 16 + (o) * 256); B##c = *(const LAS f32x2*)(p3 + (o) * 16); } while (0)
#define RW_STEP(B, yo) do { \
                const f32x2 kl = {B##k[0], B##k[1]}, kh = {B##k[2], B##k[3]}, wl = {B##w[0], B##w[1]}, wh = {B##w[2], B##w[3]}; \
                f32x2 ta = s0a * kl; ta = s0b * kh + ta; f32x2 tb = s1a * kl; tb = s1b * kh + tb; f32x2 ua = s0a * wl; ua = s0b * wh + ua; f32x2 ub = s1a * wl; ub = s1b * wh + ub; \
                const float sa0 = red16(ta.x + ta.y), sa1 = red16(tb.x + tb.y), yy0 = red16(ua.x + ua.y), yy1 = red16(ub.x + ub.y); \
                const f32x2 dl = {B##d[0], B##d[1]}, dh = {B##d[2], B##d[3]}, al = {B##a[0], B##a[1]}, ah = {B##a[2], B##a[3]}, pl = {B##p[0], B##p[1]}, ph = {B##p[2], B##p[3]}; \
                s0a = s0a * dl - al * sa0 + pl * B##v0; s0b = s0b * dh - ah * sa0 + ph * B##v0; s1a = s1a * dl - al * sa1 + pl * B##v1; s1b = s1b * dh - ah * sa1 + ph * B##v1; \
                *(LAS float*)(py + (yo)) = yy0 - sa0 * B##c.x + B##v0 * B##c.y; *(LAS float*)(py + (yo) + 16) = yy1 - sa1 * B##c.x + B##v1 * B##c.y; } while (0)
            f32x4 Ad, Ak, Aa, Ap, Aw, Bd, Bk, Ba, Bp, Bw; float Av0, Av1, Bv0, Bv1; f32x2 Ac, Bc;
            RW_LOAD(A, 0);
#pragma unroll 1
            for (int t = 0; t < 32; t += 2) {
                RW_LOAD(B, 1);
                RW_STEP(A, 0);
                py += ystep >> 1;
                if (t + 2 < 32) RW_LOAD(A, 2);
                RW_STEP(B, 0);
                py += ystep >> 1; p1 += 512; p2 += 512; p3 += 32;
            }
#undef RW_LOAD
#undef RW_STEP
        }
        __syncthreads();
        {
            const int o4 = (tl16 * 64 + 4 * jq) * 4;
            const f32x4 y = *(const LAS f32x4*)(L + RW_YO + o4), vv = *(const LAS f32x4*)(L + RW_V + o4), gg = *(const LAS f32x4*)(L + RW_G + o4);
            const float mean = red16((y[0] + y[1]) + (y[2] + y[3])) * (1.0f / 64.0f);
            const f32x4 dd = y - mean;
            const float var = red16((dd[0] * dd[0] + dd[1] * dd[1]) + (dd[2] * dd[2] + dd[3] * dd[3])) * (1.0f / 64.0f);
            const float rs = rsqrtf(var + 64e-5f), c3 = ((const LAS float*)(L + RW_SC))[tl16 * 4 + 2];
            const f32x4 ov = (dd * rs * gngv + gnbv + vv * c3) * gg;
            u32x2 w; w.x = pk2(ov[0], ov[1]); w.y = pk2(ov[2], ov[3]);
            *(u32x2*)(Y + ((size_t)b * SEQ + t0 + tl16) * D + 512 + hc4) = w;
        }
        __syncthreads();
    }
}
namespace rw2 {
constexpr int SETB = 33024, S_DEC = 0, S_KK = 4096, S_KKA = 8192, S_KP = 12288, S_WR = 16384, S_V = 20480, S_G = 24576, S_YO = 28672, S_SC = 32768;
constexpr int STG_R = 66048, STG_K = 70144, LINB = 74240, LINW = 2112, LINP = 264, MU = 82688, LW2 = 84480, LA2 = 93696, LG2 = 102912, DUMMY = 120320;
constexpr int NCH = SEQ / 16;
__device__ __forceinline__ float red8(float v) { v += dpp_f<0xB1>(v); v += dpp_f<0x4E>(v); v += dpp_f<0x141>(v); return v; }
struct RegA { u32x4 cur[4], prev[4]; };
__device__ __forceinline__ int piece_pc(int ch, int h) { return ch < 8 ? 64 * h + 8 * ch : (ch < 16 ? 512 + 64 * h + 8 * (ch - 8) : (ch < 24 ? 1024 + 64 * h + 8 * (ch - 16) : 1536 + 8 * (ch - 24))); }
__device__ __forceinline__ void loadA(RegA& A, const bf16* PB, int b, int h, int t0, int pw, int lane) {
#pragma unroll
    for (int i = 0; i < 4; ++i) {
        const int idx = lane + 64 * i;
        if (idx < 224) {
            const int tl = idx / 56, ch = idx - tl * 56; const int t = t0 + 4 * pw + tl;
            const bf16* p = PB + ((size_t)b * SEQ + t) * IN0 + 1024 + piece_pc(ch, h);
            A.cur[i] = *(const u32x4*)p;
            A.prev[i] = t > 0 ? *(const u32x4*)(p - IN0) : (u32x4){0u, 0u, 0u, 0u};
        }
    }
}
__device__ __forceinline__ void item(const Frame& F, int b, int h) {
    LAS unsigned char* L = (LAS unsigned char*)F.lds;
    const bf16* PB = wsp<bf16>(F, WS_PB); bf16* Y = wsp<bf16>(F, WS_YB);
    int tid = F.tid; asm volatile("" : "+v"(tid));
    const int lane = tid & 63, wave = F.wave;
    {
        const float* mu = F.in[7];
        if (tid < 112) { const int ch = tid >> 1, hf = tid & 1; *(LAS f32x4*)(L + MU + ch * 32 + hf * 16) = *(const f32x4*)(mu + piece_pc(ch, h) + 4 * hf); }
        { const int row = tid >> 3, c8 = tid & 7;
          *(LAS u32x4*)(L + LW2 + (row * 72 + c8 * 8) * 2) = *(const u32x4*)(wsp<bf16>(F, WT_W2) + (size_t)(64 * h + row) * 64 + c8 * 8);
          *(LAS u32x4*)(L + LA2 + (row * 72 + c8 * 8) * 2) = *(const u32x4*)(wsp<bf16>(F, WT_A2) + (size_t)(64 * h + row) * 64 + c8 * 8); }
#pragma unroll
        for (int i = 0; i < 2; ++i) { const int id = tid + NTHR * i, row = id >> 4, c16 = id & 15;
          *(LAS u32x4*)(L + LG2 + (row * 136 + c16 * 8) * 2) = *(const u32x4*)(wsp<bf16>(F, WT_G2) + (size_t)(64 * h + row) * 128 + c16 * 8); }
        __syncthreads();
    }
    if (wave < 4) {
        const int q8 = lane & 7, i0 = 16 * wave + (lane >> 3);
        f32x2 s0[4], s1[4];
#pragma unroll
        for (int j = 0; j < 4; ++j) { s0[j] = (f32x2){0.f, 0.f}; s1[j] = (f32x2){0.f, 0.f}; }
        const int yreal = q8 == 0;
        __syncthreads();
#define RW2_LOAD(B, o) do { \
            B##d0 = *(const LAS f32x4*)(p1 + S_DEC + (o) * 256); B##d1 = *(const LAS f32x4*)(p1 + S_DEC + 16 + (o) * 256); \
            B##k0 = *(const LAS f32x4*)(p1 + S_KK + (o) * 256);  B##k1 = *(const LAS f32x4*)(p1 + S_KK + 16 + (o) * 256); \
            B##a0 = *(const LAS f32x4*)(p1 + S_KKA + (o) * 256); B##a1 = *(const LAS f32x4*)(p1 + S_KKA + 16 + (o) * 256); \
            B##p0 = *(const LAS f32x4*)(p1 + S_KP + (o) * 256);  B##p1 = *(const LAS f32x4*)(p1 + S_KP + 16 + (o) * 256); \
            B##w0 = *(const LAS f32x4*)(p1 + S_WR + (o) * 256);  B##w1 = *(const LAS f32x4*)(p1 + S_WR + 16 + (o) * 256); \
            B##v0 = *(const LAS float*)(p2 + (o) * 256); B##v1 = *(const LAS float*)(p2 + 32 + (o) * 256); B##c = *(const LAS f32x2*)(p3 + (o) * 16); } while (0)
#define RW2_DOT(S, X0, X1) ({ f32x2 t_ = S[0] * (f32x2){X0[0], X0[1]}; t_ = S[1] * (f32x2){X0[2], X0[3]} + t_; t_ = S[2] * (f32x2){X1[0], X1[1]} + t_; t_ = S[3] * (f32x2){X1[2], X1[3]} + t_; t_.x + t_.y; })
#define RW2_UPD(S, SA, V, B) do { \
            S[0] = S[0] * (f32x2){B##d0[0], B##d0[1]} - (f32x2){B##a0[0], B##a0[1]} * SA + (f32x2){B##p0[0], B##p0[1]} * V; \
            S[1] = S[1] * (f32x2){B##d0[2], B##d0[3]} - (f32x2){B##a0[2], B##a0[3]} * SA + (f32x2){B##p0[2], B##p0[3]} * V; \
            S[2] = S[2] * (f32x2){B##d1[0], B##d1[1]} - (f32x2){B##a1[0], B##a1[1]} * SA + (f32x2){B##p1[0], B##p1[1]} * V; \
            S[3] = S[3] * (f32x2){B##d1[2], B##d1[3]} - (f32x2){B##a1[2], B##a1[3]} * SA + (f32x2){B##p1[2], B##p1[3]} * V; } while (0)
#define RW2_STEP(B, yo) do { \
            const float sa0 = red8(RW2_DOT(s0, B##k0, B##k1)), sa1 = red8(RW2_DOT(s1, B##k0, B##k1)), yy0 = red8(RW2_DOT(s0, B##w0, B##w1)), yy1 = red8(RW2_DOT(s1, B##w0, B##w1)); \
            RW2_UPD(s0, sa0, B##v0, B); RW2_UPD(s1, sa1, B##v1, B); \
            *(LAS float*)(py + (yo)) = yy0 - sa0 * B##c.x + B##v0 * B##c.y; *(LAS float*)(py + (yo) + 32) = yy1 - sa1 * B##c.x + B##v1 * B##c.y; } while (0)
#pragma unroll 1
        for (int c = 0; c < NCH; ++c) {
            const LAS unsigned char* sb = L + (c & 1) * SETB;
            const LAS unsigned char* p1 = sb + 32 * q8;
            const LAS unsigned char* p2 = sb + S_V + 4 * i0;
            const LAS unsigned char* p3 = sb + S_SC;
            LAS unsigned char* py = yreal ? (LAS unsigned char*)sb + S_YO + 4 * i0 : L + DUMMY + (tid >> 3) * 64 + (tid & 7) * 4;
            const int ystep = yreal ? 256 : 0;
            f32x4 Ad0, Ad1, Ak0, Ak1, Aa0, Aa1, Ap0, Ap1, Aw0, Aw1, Bd0, Bd1, Bk0, Bk1, Ba0, Ba1, Bp0, Bp1, Bw0, Bw1; float Av0, Av1, Bv0, Bv1; f32x2 Ac, Bc;
            RW2_LOAD(A, 0);
#pragma unroll 1
            for (int t = 0; t < 16; t += 2) {
                RW2_LOAD(B, 1);
                RW2_STEP(A, 0);
                py += ystep;
                if (t + 2 < 16) RW2_LOAD(A, 2);
                RW2_STEP(B, 0);
                py += ystep; p1 += 512; p2 += 512; p3 += 32;
            }
            asm volatile("s_waitcnt lgkmcnt(0)" ::: "memory");
            __syncthreads();
        }
#undef RW2_LOAD
#undef RW2_DOT
#undef RW2_UPD
#undef RW2_STEP
        __syncthreads();
    } else {
        const int pw = wave - 4, jq = lane & 15, tk = lane >> 4, tl = 4 * pw + tk;
        const int hc4 = 64 * h + 4 * jq;
        const f32x4 w0v = *(const f32x4*)(F.in[8] + hc4), a0v = *(const f32x4*)(F.in[10] + hc4), kkv = *(const f32x4*)(F.in[13] + hc4), kav = *(const f32x4*)(F.in[14] + hc4), rkv = *(const f32x4*)(F.in[15] + hc4),
                    gngv = *(const f32x4*)(F.in[16] + hc4), gnbv = *(const f32x4*)(F.in[17] + hc4);
        const int fr = lane & 15, fq = lane >> 4;
        LAS unsigned char* stR = L + STG_R + pw * 1024; LAS unsigned char* stK = L + STG_K + pw * 1024; LAS unsigned char* lin = L + LINB + pw * LINW;
        RegA A; loadA(A, PB, b, h, 0, pw, lane);
#define RW2_PREP(c_) do { \
            LAS unsigned char* sb = L + ((c_) & 1) * SETB; \
            _Pragma("unroll") for (int i = 0; i < 4; ++i) { \
                const int idx = lane + 64 * i; \
                if (idx < 224) { \
                    const int tl_ = idx / 56, ch = idx - tl_ * 56; \
                    const f32x4 m0 = *(const LAS f32x4*)(L + MU + ch * 32), m1 = *(const LAS f32x4*)(L + MU + ch * 32 + 16); \
                    float xs[8]; \
                    _Pragma("unroll") for (int j = 0; j < 4; ++j) { \
                        const float c0 = bf2f(A.cur[i][j] & 0xffffu), c1 = bf2f(A.cur[i][j] >> 16), p0 = bf2f(A.prev[i][j] & 0xffffu), p1 = bf2f(A.prev[i][j] >> 16); \
                        const float mA = j < 2 ? m0[2 * j] : m1[2 * j - 4], mB = j < 2 ? m0[2 * j + 1] : m1[2 * j - 3]; \
                        xs[2 * j] = c0 + (p0 - c0) * mA; xs[2 * j + 1] = c1 + (p1 - c1) * mB; } \
                    if (ch < 24) { \
                        LAS float* dst = ch < 8 ? (LAS float*)stR + tl_ * 64 + 8 * ch : (ch < 16 ? (LAS float*)stK + tl_ * 64 + 8 * (ch - 8) : (LAS float*)(sb + S_V) + (4 * pw + tl_) * 64 + 8 * (ch - 16)); \
                        *(LAS f32x4*)dst = (f32x4){xs[0], xs[1], xs[2], xs[3]}; *(LAS f32x4*)(dst + 4) = (f32x4){xs[4], xs[5], xs[6], xs[7]}; \
                    } else { \
                        const int lc = ch - 24; \
                        if (lc < 8) { _Pragma("unroll") for (int j = 0; j < 8; ++j) xs[j] = 1.0f - 2.0f * rcpf_(1.0f + __expf(2.0f * xs[j])); } \
                        else if (lc >= 16) { _Pragma("unroll") for (int j = 0; j < 8; ++j) xs[j] = sigmoidf_(xs[j]); } \
                        u32x4 w_; w_.x = pk2(xs[0], xs[1]); w_.y = pk2(xs[2], xs[3]); w_.z = pk2(xs[4], xs[5]); w_.w = pk2(xs[6], xs[7]); \
                        *(LAS u32x4*)(lin + (tl_ * LINP + 8 * lc) * 2) = w_; } } } \
            if ((c_) + 1 < NCH) loadA(A, PB, b, h, 16 * ((c_) + 1), pw, lane); \
            LDS_FENCE(); \
            { const LAS unsigned char* arow = lin + ((fr & 3) * LINP + 8 * fq) * 2; \
              _Pragma("unroll") for (int nt = 0; nt < 4; ++nt) { \
                const LAS unsigned char* bw = L + LW2 + ((16 * nt + fr) * 72 + 8 * fq) * 2; const LAS unsigned char* ba = L + LA2 + ((16 * nt + fr) * 72 + 8 * fq) * 2; const LAS unsigned char* bg = L + LG2 + ((16 * nt + fr) * 136 + 8 * fq) * 2; \
                f32x4 cw = {0.f, 0.f, 0.f, 0.f}, ca = {0.f, 0.f, 0.f, 0.f}, cg = {0.f, 0.f, 0.f, 0.f}; \
                _Pragma("unroll") for (int ks = 0; ks < 2; ++ks) { \
                    cw = __builtin_amdgcn_mfma_f32_16x16x32_bf16(*(const LAS bf16x8*)(arow + 64 * ks), *(const LAS bf16x8*)(bw + 64 * ks), cw, 0, 0, 0); \
                    ca = __builtin_amdgcn_mfma_f32_16x16x32_bf16(*(const LAS bf16x8*)(arow + 128 + 64 * ks), *(const LAS bf16x8*)(ba + 64 * ks), ca, 0, 0, 0); } \
                _Pragma("unroll") for (int ks = 0; ks < 4; ++ks) cg = __builtin_amdgcn_mfma_f32_16x16x32_bf16(*(const LAS bf16x8*)(arow + 256 + 64 * ks), *(const LAS bf16x8*)(bg + 64 * ks), cg, 0, 0, 0); \
                if (fq == 0) { _Pragma("unroll") for (int r = 0; r < 4; ++r) { const int o = ((4 * pw + r) * 64 + 16 * nt + fr) * 4; \
                    *(LAS float*)(sb + S_DEC + o) = cw[r]; *(LAS float*)(sb + S_KKA + o) = ca[r]; *(LAS float*)(sb + S_G + o) = cg[r]; } } } } \
            LDS_FENCE(); \
            { const int o4 = (tl * 64 + 4 * jq) * 4, st4 = (tk * 64 + 4 * jq) * 4; \
              const f32x4 lw = *(const LAS f32x4*)(sb + S_DEC + o4), la = *(const LAS f32x4*)(sb + S_KKA + o4), kr = *(const LAS f32x4*)(stK + st4), r = *(const LAS f32x4*)(stR + st4); \
              f32x4 dec, a, kkr, kp; \
              _Pragma("unroll") for (int i = 0; i < 4; ++i) { \
                  const float nx = -(w0v[i] + lw[i]); const float sp = fmaxf(nx, 0.f) + __logf(1.0f + __expf(-fabsf(nx))); \
                  dec[i] = __expf(-__expf(-sp - 0.5f)); a[i] = sigmoidf_(a0v[i] + la[i]); kkr[i] = kr[i] * kkv[i]; kp[i] = kr[i] * (1.0f + (a[i] - 1.0f) * kav[i]); } \
              const float n2 = red16((kkr[0] * kkr[0] + kkr[1] * kkr[1]) + (kkr[2] * kkr[2] + kkr[3] * kkr[3])); \
              const float inv = __builtin_amdgcn_rsqf(fmaxf(n2, 1e-24f)); const f32x4 kk = kkr * inv, kka = kk * a; \
              const float c1 = red16((kka[0] * r[0] + kka[1] * r[1]) + (kka[2] * r[2] + kka[3] * r[3])); \
              const float c2 = red16((kp[0] * r[0] + kp[1] * r[1]) + (kp[2] * r[2] + kp[3] * r[3])); \
              const float c3 = red16((r[0] * kp[0] * rkv[0] + r[1] * kp[1] * rkv[1]) + (r[2] * kp[2] * rkv[2] + r[3] * kp[3] * rkv[3])); \
              *(LAS f32x4*)(sb + S_DEC + o4) = dec; *(LAS f32x4*)(sb + S_KK + o4) = kk; *(LAS f32x4*)(sb + S_KKA + o4) = kka; *(LAS f32x4*)(sb + S_KP + o4) = kp; *(LAS f32x4*)(sb + S_WR + o4) = dec * r; \
              if (jq == 0) { LAS float* sc = (LAS float*)(sb + S_SC) + tl * 4; sc[0] = c1; sc[1] = c2; sc[2] = c3; } } \
            LDS_FENCE(); } while (0)
#define RW2_POST(c_) do { \
            const LAS unsigned char* sb = L + ((c_) & 1) * SETB; const int o4 = (tl * 64 + 4 * jq) * 4; \
            const f32x4 y = *(const LAS f32x4*)(sb + S_YO + o4), vv = *(const LAS f32x4*)(sb + S_V + o4), gg = *(const LAS f32x4*)(sb + S_G + o4); \
            const float mean = red16((y[0] + y[1]) + (y[2] + y[3])) * (1.0f / 64.0f); const f32x4 dd = y - mean; \
            const float var = red16((dd[0] * dd[0] + dd[1] * dd[1]) + (dd[2] * dd[2] + dd[3] * dd[3])) * (1.0f / 64.0f); \
            const float rs = rsqrtf(var + 64e-5f), c3 = ((const LAS float*)(sb + S_SC))[tl * 4 + 2]; \
            const f32x4 ov = (dd * rs * gngv + gnbv + vv * c3) * gg; \
            u32x2 w_; w_.x = pk2(ov[0], ov[1]); w_.y = pk2(ov[2], ov[3]); \
            *(u32x2*)(Y + ((size_t)b * SEQ + 16 * (c_) + tl) * D + 512 + hc4) = w_; \
            LDS_FENCE(); } while (0)
        RW2_PREP(0);
        __syncthreads();
#pragma unroll 1
        for (int c = 0; c < NCH; ++c) {
            if (c >= 1) RW2_POST(c - 1);
            if (c + 1 < NCH) RW2_PREP(c + 1);
            __syncthreads();
        }
        RW2_POST(NCH - 1);
        __syncthreads();
#undef RW2_PREP
#undef RW2_POST
    }
}
}
namespace rw3 {
constexpr int V_ = 0, G_ = 8192, LWC = 16384, XK = 24576, XQ = 29184, YK = 33792, YR = 38400, QH = 43008, KH = 47616, VB = 52224, WCC = 56832, YO = 57344, SC3 = 65536, MU = 65792, RA = 67456;
constexpr int R_ = RA, K_ = RA + 8192, LIN = RA + 16384, LINP = 264, LW_ = RA + 33280, LA_ = RA + 41472;
constexpr int NF = RA, A1B = RA + 2048, B1T = RA + 3072, B2T = RA + 4096, TTT = RA + 5120, A1H = RA + 6144, KHT = RA + 8192, PT = RA + 18432, ZT = RA + 34816, RHT = RA + 38912, BHT = RA + 43008;
constexpr int CST = RA + 49664;
constexpr int XP = 144;
typedef short s16x4 __attribute__((ext_vector_type(4)));
typedef short v4i16_t __attribute__((ext_vector_type(4)));
__device__ __forceinline__ s16x4 vtr(const LAS unsigned char* p) { return __builtin_bit_cast(s16x4, __builtin_amdgcn_ds_read_tr16_b64_v4i16((LAS v4i16_t*)p)); }
template <int Q> __device__ __forceinline__ float quad_bcast(float v) { return __builtin_bit_cast(float, __builtin_amdgcn_update_dpp(0, __builtin_bit_cast(int, v), Q * 0x55, 0xF, 0xF, true)); }
__device__ __forceinline__ float ldbf(const LAS unsigned char* p) { return bf2f(*(const LAS unsigned short*)p); }
struct RegT { u32x2 rc, kc, vc, rp, kp, vp, w, a, g; };
__device__ __forceinline__ void loadT(RegT& R, const bf16* PB, const bf16* LO, int b, int h, int t0, int tid) {
    const int t = t0 + (tid >> 4), c = 64 * h + 4 * (tid & 15);
    const bf16* p = PB + ((size_t)b * SEQ + t) * IN0 + 1024 + c;
    R.rc = *(const u32x2*)p; R.kc = *(const u32x2*)(p + 512); R.vc = *(const u32x2*)(p + 1024);
    if (t > 0) { R.rp = *(const u32x2*)(p - IN0); R.kp = *(const u32x2*)(p - IN0 + 512); R.vp = *(const u32x2*)(p - IN0 + 1024); }
    else { R.rp = (u32x2){0u, 0u}; R.kp = (u32x2){0u, 0u}; R.vp = (u32x2){0u, 0u}; }
    const bf16* q = LO + ((size_t)b * SEQ + t) * 1536 + c;
    R.w = *(const u32x2*)q; R.a = *(const u32x2*)(q + 512); R.g = *(const u32x2*)(q + 1024);
}
__device__ __forceinline__ f32x4 unpk4(u32x2 v) { return (f32x4){bf2f(v.x & 0xffffu), bf2f(v.x >> 16), bf2f(v.y & 0xffffu), bf2f(v.y >> 16)}; }
__device__ __forceinline__ void item(const Frame& F, int b, int h) {
    LAS unsigned char* L = (LAS unsigned char*)F.lds;
    const bf16* PB = wsp<bf16>(F, WS_PB); bf16* Y = wsp<bf16>(F, WS_YB);
    int tid = F.tid; asm volatile("" : "+v"(tid));
    const int wave = F.wave;
    const int hc4 = 64 * h + 4 * (tid & 15);
    if (tid < 7 * 16) {
        const int which = tid >> 4, c4 = (tid & 15) * 4; const int src = which == 0 ? 8 : (which == 1 ? 10 : (which == 2 ? 13 : (which == 3 ? 14 : (which == 4 ? 15 : (which == 5 ? 16 : 17)))));
        *(LAS f32x4*)(L + CST + which * 256 + c4 * 4) = *(const f32x4*)(F.in[src] + 64 * h + c4);
    }
    if (tid < 48) { const int arr = tid >> 4, c4 = (tid & 15) * 4; *(LAS f32x4*)(L + MU + arr * 256 + c4 * 4) = *(const f32x4*)(F.in[7] + arr * 512 + 64 * h + c4); }
    f32x4 ST[4];
#pragma unroll
    for (int m = 0; m < 4; ++m) ST[m] = (f32x4){0.f, 0.f, 0.f, 0.f};
    const bf16* LO = (const bf16*)F.out;
    RegT Tn; loadT(Tn, PB, LO, b, h, 0, tid);
    unsigned idpk[4];
    { const int fr0 = tid & 15, fq0 = (tid & 63) >> 4;
#pragma unroll
      for (int p = 0; p < 4; ++p) { const bool lo_on = fq0 >= 2 && (8 * (fq0 - 2) + 2 * p == fr0), hi_on = fq0 >= 2 && (8 * (fq0 - 2) + 2 * p + 1 == fr0); idpk[p] = (lo_on ? 0x3F80u : 0u) | (hi_on ? 0x3F800000u : 0u); } }
    __syncthreads();
#pragma unroll 1
    for (int t0 = 0; t0 < SEQ; t0 += 32) {
        int tidl = tid; asm volatile("" : "+v"(tidl));
        const int lane = tidl & 63, fr = lane & 15, fq = lane >> 4;
        const int jq = lane & 15, tl = tidl >> 4;
        const int ch2 = tidl >> 8, x = tidl & 255;
        const RegT Tc = Tn;
        if (t0 + 32 < SEQ) loadT(Tn, PB, LO, b, h, t0 + 32, tid);
        const int o4 = (tl * 64 + 4 * jq) * 4, tloc = tl & 15, cb = tl & 16;
        f32x4 kap, qv, kp, rr, lw, vv;
        {
            const f32x4 w0v = *(const LAS f32x4*)(L + CST + 16 * jq), a0v = *(const LAS f32x4*)(L + CST + 256 + 16 * jq), kkv = *(const LAS f32x4*)(L + CST + 512 + 16 * jq), kav = *(const LAS f32x4*)(L + CST + 768 + 16 * jq), rkv = *(const LAS f32x4*)(L + CST + 1024 + 16 * jq);
            const f32x4 lwv = unpk4(Tc.w), la = unpk4(Tc.a);
            const f32x4 mr = *(const LAS f32x4*)(L + MU + 16 * jq), mk = *(const LAS f32x4*)(L + MU + 256 + 16 * jq), mv = *(const LAS f32x4*)(L + MU + 512 + 16 * jq);
            const f32x4 rcur = unpk4(Tc.rc), kcur = unpk4(Tc.kc), vcur = unpk4(Tc.vc);
            rr = rcur + (unpk4(Tc.rp) - rcur) * mr; const f32x4 kr = kcur + (unpk4(Tc.kp) - kcur) * mk; vv = vcur + (unpk4(Tc.vp) - vcur) * mv;
            f32x4 a, kkr;
#pragma unroll
            for (int i = 0; i < 4; ++i) {
                const float nx = -(w0v[i] + lwv[i]);
                const float sp = fmaxf(nx, 0.f) + __logf(1.0f + __expf(-fabsf(nx)));
                lw[i] = -__expf(-sp - 0.5f) * 1.4426950408889634f;
                a[i] = sigmoidf_(a0v[i] + la[i]);
                kkr[i] = kr[i] * kkv[i]; kp[i] = kr[i] * (1.0f + (a[i] - 1.0f) * kav[i]);
            }
            const float n2 = red16((kkr[0] * kkr[0] + kkr[1] * kkr[1]) + (kkr[2] * kkr[2] + kkr[3] * kkr[3]));
            kap = kkr * __builtin_amdgcn_rsqf(fmaxf(n2, 1e-24f)); qv = kap * a;
            const float c3 = red16((rr[0] * kp[0] * rkv[0] + rr[1] * kp[1] * rkv[1]) + (rr[2] * kp[2] * rkv[2] + rr[3] * kp[3] * rkv[3]));
            if (jq == 0) *(LAS float*)(L + SC3 + (t0 & 32) * 4 + tl * 4) = c3;
            *(LAS f32x4*)(L + LWC + o4) = lw;
        }
        __syncthreads();
        {
            f32x4 cl = {0.f, 0.f, 0.f, 0.f}, CL = {0.f, 0.f, 0.f, 0.f};
#pragma unroll
            for (int u = 0; u < 16; ++u) { const f32x4 v = *(const LAS f32x4*)(L + LWC + ((cb + u) * 64 + 4 * jq) * 4); CL += v; if (u <= tloc) cl += v; }
            f32x4 cw, icw, cwm1, wcr;
#pragma unroll
            for (int i = 0; i < 4; ++i) { cw[i] = __builtin_amdgcn_exp2f(cl[i]); icw[i] = __builtin_amdgcn_exp2f(-cl[i]); cwm1[i] = __builtin_amdgcn_exp2f(cl[i] - lw[i]); wcr[i] = __builtin_amdgcn_exp2f(CL[i] - cl[i]); }
            const f32x4 kt = cwm1 * kap, qt = qv * icw, kkt = kp * icw, rt = cw * rr, qh = qv * wcr, kh = kp * wcr;
            const int ob = tl * XP + 8 * jq;
#define RW3_ST4(base, v) do { u32x2 w_; w_.x = pk2(v[0], v[1]); w_.y = pk2(v[2], v[3]); *(LAS u32x2*)(L + (base) + ob) = w_; } while (0)
            RW3_ST4(XK, kkt); RW3_ST4(XQ, qt); RW3_ST4(YK, kt); RW3_ST4(YR, rt); RW3_ST4(QH, qh); RW3_ST4(KH, kh); RW3_ST4(VB, vv);
#undef RW3_ST4
            if (tloc == 15) { f32x4 wc; for (int i = 0; i < 4; ++i) wc[i] = __builtin_amdgcn_exp2f(CL[i]); *(LAS f32x4*)(L + WCC + ((cb >> 4) * 64 + 4 * jq) * 4) = wc; }
        }
        __syncthreads();
        const int gc = wave >> 2, wq = wave & 3;
        {
            const int tile = wq;
            const LAS unsigned char* ar = L + (tile == 0 ? YK : ((tile & 1) ? XQ : XK)) + (16 * gc + fr) * XP + 16 * fq;
            const LAS unsigned char* br = L + (tile == 0 ? XK : ((tile >> 1) ? YR : YK)) + (16 * gc + fr) * XP + 16 * fq;
            f32x4 acc = {0.f, 0.f, 0.f, 0.f};
#pragma unroll
            for (int ks = 0; ks < 2; ++ks) acc = __builtin_amdgcn_mfma_f32_16x16x32_bf16(*(const LAS bf16x8*)(ar + 64 * ks), *(const LAS bf16x8*)(br + 64 * ks), acc, 0, 0, 0);
            if (tile == 0) {
#pragma unroll
                for (int r = 0; r < 4; ++r) if (!(fr < 4 * fq + r)) acc[r] = 0.f;
                u32x2 w_; w_.x = pk2(acc[0], acc[1]); w_.y = pk2(acc[2], acc[3]); *(LAS u32x2*)(L + A1B + gc * 512 + fr * 32 + 8 * fq) = w_;
            } else if (tile == 1) {
#pragma unroll
                for (int r = 0; r < 4; ++r) *(LAS float*)(L + NF + gc * 1024 + ((4 * fq + r) * 16 + fr) * 4) = (4 * fq + r < fr) ? acc[r] : 0.f;
            } else {
#pragma unroll
                for (int r = 0; r < 4; ++r) if (!(4 * fq + r <= fr)) acc[r] = 0.f;
                u32x2 w_; w_.x = pk2(acc[0], acc[1]); w_.y = pk2(acc[2], acc[3]); *(LAS u32x2*)(L + (tile == 2 ? B1T : B2T) + gc * 512 + fr * 32 + 8 * fq) = w_;
            }
        }
        LDS_FENCE();
        if (wq == 1 && lane < 16) {
            const int x = lane; const int ch2 = gc;
            const LAS unsigned char* N = L + NF + ch2 * 1024;
            float Tc[16];
#pragma unroll
            for (int sI = 15; sI >= 0; --sI) {
                float acc0 = (sI == x) ? 1.f : 0.f, acc1 = 0.f;
#pragma unroll
                for (int u4 = 0; u4 < 4; ++u4) {
                    if (4 * u4 + 3 > sI) {
                        const f32x4 nv = *(const LAS f32x4*)(N + (sI * 16 + 4 * u4) * 4);
#pragma unroll
                        for (int i = 0; i < 4; ++i) { const int u = 4 * u4 + i; if (u > sI) { if (u & 1) acc1 -= nv[i] * Tc[u]; else acc0 -= nv[i] * Tc[u]; } }
                    }
                }
                Tc[sI] = acc0 + acc1;
            }
            u32x4 w0_, w1_;
#pragma unroll
            for (int i = 0; i < 4; ++i) { w0_[i] = pk2(Tc[2 * i], Tc[2 * i + 1]); w1_[i] = pk2(Tc[8 + 2 * i], Tc[8 + 2 * i + 1]); }
            *(LAS u32x4*)(L + TTT + ch2 * 512 + x * 32) = w0_; *(LAS u32x4*)(L + TTT + ch2 * 512 + x * 32 + 16) = w1_;
        }
        __syncthreads();
        const bf16x8 zero8 = (bf16x8){0, 0, 0, 0, 0, 0, 0, 0};
        const int trow = 8 * (fq & 1) + ((lane & 15) >> 2), tcol = 8 * (lane & 3);
        {
            bf16x8 tf = *(const LAS bf16x8*)(L + TTT + gc * 512 + fr * 32 + 16 * (fq & 1)); if (fq >= 2) tf = zero8;
            const LAS unsigned char* kb = L + YK + (16 * gc + trow) * XP + 32 * wq + tcol;
            const s16x4 lo = vtr(kb), hh = vtr(kb + 4 * XP);
            bf16x8 bv = (bf16x8){lo[0], lo[1], lo[2], lo[3], hh[0], hh[1], hh[2], hh[3]}; if (fq >= 2) bv = zero8;
            const f32x4 kh = __builtin_amdgcn_mfma_f32_16x16x32_bf16(tf, bv, (f32x4){0.f, 0.f, 0.f, 0.f}, 0, 0, 0);
            u32x2 w_; w_.x = pk2(kh[0], kh[1]); w_.y = pk2(kh[2], kh[3]); *(LAS u32x2*)(L + KHT + gc * 3072 + (16 * wq + fr) * 48 + 8 * fq) = w_;
            if (wq == 0) {
                bf16x8 a1 = *(const LAS bf16x8*)(L + A1B + gc * 512 + fr * 32 + 16 * (fq & 1)); if (fq >= 2) a1 = zero8;
                const f32x4 ah = __builtin_amdgcn_mfma_f32_16x16x32_bf16(tf, a1, (f32x4){0.f, 0.f, 0.f, 0.f}, 0, 0, 0);
                u32x2 v_; v_.x = pk2(-ah[0], -ah[1]); v_.y = pk2(-ah[2], -ah[3]); *(LAS u32x2*)(L + A1H + gc * 512 + fr * 32 + 8 * fq) = v_;
            }
        }
        __syncthreads();
        {
            const bf16x8 idp = __builtin_bit_cast(bf16x8, (u32x4){idpk[0], idpk[1], idpk[2], idpk[3]});
            const bf16x8 idn = __builtin_bit_cast(bf16x8, (u32x4){idpk[0] ^ 0x80008000u, idpk[1] ^ 0x80008000u, idpk[2] ^ 0x80008000u, idpk[3] ^ 0x80008000u});
            const bf16x8 kf = *(const LAS bf16x8*)(L + KHT + gc * 3072 + (16 * wq + fr) * 48 + 16 * (fq & 1));
            const bf16x8 b2 = *(const LAS bf16x8*)(L + B2T + gc * 512 + fr * 32 + 16 * (fq & 1));
            const bf16x8 a1h = *(const LAS bf16x8*)(L + A1H + gc * 512 + fr * 32 + 16 * (fq & 1));
            const bf16x8 bhop = *(const LAS bf16x8*)(L + (fq >= 2 ? B1T : B2T) + gc * 512 + fr * 32 + 16 * (fq & 1));
            const LAS unsigned char* qb = L + QH + (16 * gc + trow) * XP + tcol;
            s16x4 qlo[4], qhi[4];
#pragma unroll
            for (int nt = 0; nt < 4; ++nt) { qlo[nt] = vtr(qb + 32 * nt); qhi[nt] = vtr(qb + 32 * nt + 4 * XP); }
            const LAS unsigned char* rb = L + YR + (16 * gc + trow) * XP + 32 * wq + tcol;
            const s16x4 rlo = vtr(rb), rhi = vtr(rb + 4 * XP);
            const LAS unsigned char* zb = L + (fq >= 2 ? KH : QH) + (16 * gc + trow) * XP + 32 * wq + tcol;
            const s16x4 zlo = vtr(zb), zhi = vtr(zb + 4 * XP);
            float wcv[4];
#pragma unroll
            for (int nt = 0; nt < 4; ++nt) wcv[nt] = *(const LAS float*)(L + WCC + (gc * 64 + 16 * nt + fr) * 4);
            const bf16x8 af = fq >= 2 ? zero8 : kf;
            f32x4 pacc[4];
#pragma unroll
            for (int nt = 0; nt < 4; ++nt) {
                bf16x8 bv = (bf16x8){qlo[nt][0], qlo[nt][1], qlo[nt][2], qlo[nt][3], qhi[nt][0], qhi[nt][1], qhi[nt][2], qhi[nt][3]}; if (fq >= 2) bv = zero8;
                pacc[nt] = __builtin_amdgcn_mfma_f32_16x16x32_bf16(af, bv, (f32x4){0.f, 0.f, 0.f, 0.f}, 0, 0, 0);
            }
            const bf16x8 rfrag = (bf16x8){rlo[0], rlo[1], rlo[2], rlo[3], rhi[0], rhi[1], rhi[2], rhi[3]};
            const f32x4 racc = __builtin_amdgcn_mfma_f32_16x16x32_bf16(fq >= 2 ? rfrag : kf, fq >= 2 ? idn : b2, (f32x4){0.f, 0.f, 0.f, 0.f}, 0, 0, 0);
            const bf16x8 zop = fq >= 2 ? idp : a1h;
            const bf16x8 zbv = (bf16x8){zlo[0], zlo[1], zlo[2], zlo[3], zhi[0], zhi[1], zhi[2], zhi[3]};
            const f32x4 zacc = __builtin_amdgcn_mfma_f32_16x16x32_bf16(zop, zbv, (f32x4){0.f, 0.f, 0.f, 0.f}, 0, 0, 0);
            f32x4 bacc = {0.f, 0.f, 0.f, 0.f};
            if (wq == 0) bacc = __builtin_amdgcn_mfma_f32_16x16x32_bf16(zop, bhop, (f32x4){0.f, 0.f, 0.f, 0.f}, 0, 0, 0);
#pragma unroll
            for (int nt = 0; nt < 4; ++nt) {
                float pv_[4];
#pragma unroll
                for (int r = 0; r < 4; ++r) pv_[r] = -pacc[nt][r];
                if (wq == nt) {
#pragma unroll
                    for (int r = 0; r < 4; ++r) if (fr == 4 * fq + r) pv_[r] += wcv[nt]; }
                u32x2 w_; w_.x = pk2(pv_[0], pv_[1]); w_.y = pk2(pv_[2], pv_[3]);
                *(LAS u32x2*)(L + PT + gc * 8192 + ((nt * 2 + (wq >> 1)) * 16 + fr) * 64 + fq * 16 + (wq & 1) * 8) = w_;
            }
            { u32x2 w_; w_.x = pk2(-racc[0], -racc[1]); w_.y = pk2(-racc[2], -racc[3]); *(LAS u32x2*)(L + RHT + gc * 2048 + ((wq >> 1) * 16 + fr) * 64 + fq * 16 + (wq & 1) * 8) = w_; }
            { u32x2 w_; w_.x = pk2(zacc[0], zacc[1]); w_.y = pk2(zacc[2], zacc[3]); *(LAS u32x2*)(L + ZT + gc * 2048 + (16 * wq + fr) * 32 + 8 * fq) = w_; }
            if (wq == 0) { u32x2 w_; w_.x = pk2(bacc[0], bacc[1]); w_.y = pk2(bacc[2], bacc[3]); *(LAS u32x2*)(L + BHT + gc * 512 + fr * 32 + 8 * fq) = w_; }
        }
        __syncthreads();
        if (wave < 4) {
            bf16x8 pf[2][4][2], zf[2][4], rf[2][2], bfv[2], vb[2];
#pragma unroll
            for (int gcc = 0; gcc < 2; ++gcc) {
#pragma unroll
                for (int m = 0; m < 4; ++m) {
#pragma unroll
                    for (int ks = 0; ks < 2; ++ks) pf[gcc][m][ks] = *(const LAS bf16x8*)(L + PT + gcc * 8192 + ((m * 2 + ks) * 16 + fr) * 64 + fq * 16);
                    zf[gcc][m] = *(const LAS bf16x8*)(L + ZT + gcc * 2048 + (16 * m + fr) * 32 + 16 * (fq & 1)); if (fq >= 2) zf[gcc][m] = zero8;
                }
#pragma unroll
                for (int ks = 0; ks < 2; ++ks) rf[gcc][ks] = *(const LAS bf16x8*)(L + RHT + gcc * 2048 + (ks * 16 + fr) * 64 + fq * 16);
                bfv[gcc] = *(const LAS bf16x8*)(L + BHT + gcc * 512 + fr * 32 + 16 * (fq & 1)); if (fq >= 2) bfv[gcc] = zero8;
                const LAS unsigned char* vbp = L + VB + (16 * gcc + trow) * XP + 32 * wave + tcol;
                const s16x4 lo = vtr(vbp), hh = vtr(vbp + 4 * XP);
                vb[gcc] = (bf16x8){lo[0], lo[1], lo[2], lo[3], hh[0], hh[1], hh[2], hh[3]}; if (fq >= 2) vb[gcc] = zero8;
            }
            f32x4 zacc[2][4], yacc[2];
#pragma unroll
            for (int gcc = 0; gcc < 2; ++gcc) {
#pragma unroll
                for (int m = 0; m < 4; ++m) zacc[gcc][m] = __builtin_amdgcn_mfma_f32_16x16x32_bf16(zf[gcc][m], vb[gcc], (f32x4){0.f, 0.f, 0.f, 0.f}, 0, 0, 0);
                yacc[gcc] = __builtin_amdgcn_mfma_f32_16x16x32_bf16(bfv[gcc], vb[gcc], (f32x4){0.f, 0.f, 0.f, 0.f}, 0, 0, 0);
            }
#pragma unroll
            for (int gcc = 0; gcc < 2; ++gcc) {
                bf16x8 sb[2];
#pragma unroll
                for (int ks = 0; ks < 2; ++ks) { u32x4 w_; w_.x = pk2(ST[2 * ks][0], ST[2 * ks][1]); w_.y = pk2(ST[2 * ks][2], ST[2 * ks][3]); w_.z = pk2(ST[2 * ks + 1][0], ST[2 * ks + 1][1]); w_.w = pk2(ST[2 * ks + 1][2], ST[2 * ks + 1][3]); sb[ks] = __builtin_bit_cast(bf16x8, w_); }
#pragma unroll
                for (int m = 0; m < 4; ++m) {
                    f32x4 acc = __builtin_amdgcn_mfma_f32_16x16x32_bf16(pf[gcc][m][0], sb[0], zacc[gcc][m], 0, 0, 0);
                    ST[m] = __builtin_amdgcn_mfma_f32_16x16x32_bf16(pf[gcc][m][1], sb[1], acc, 0, 0, 0);
                }
                f32x4 ya = __builtin_amdgcn_mfma_f32_16x16x32_bf16(rf[gcc][0], sb[0], yacc[gcc], 0, 0, 0);
                ya = __builtin_amdgcn_mfma_f32_16x16x32_bf16(rf[gcc][1], sb[1], ya, 0, 0, 0);
#pragma unroll
                for (int r = 0; r < 4; ++r) *(LAS float*)(L + YO + ((16 * gcc + 4 * fq + r) * 64 + 16 * wave + fr) * 4) = ya[r];
            }
        }
        __syncthreads();
        {
            const f32x4 y = *(const LAS f32x4*)(L + YO + o4), gg = unpk4(Tc.g);
            const f32x4 gngv = *(const LAS f32x4*)(L + CST + 1280 + 16 * jq), gnbv = *(const LAS f32x4*)(L + CST + 1536 + 16 * jq);
            const float mean = red16((y[0] + y[1]) + (y[2] + y[3])) * (1.0f / 64.0f);
            const f32x4 dd = y - mean;
            const float var = red16((dd[0] * dd[0] + dd[1] * dd[1]) + (dd[2] * dd[2] + dd[3] * dd[3])) * (1.0f / 64.0f);
            const float rs = rsqrtf(var + 64e-5f), c3 = *(const LAS float*)(L + SC3 + (t0 & 32) * 4 + tl * 4);
            const f32x4 ov = (dd * rs * gngv + gnbv + vv * c3) * gg;
            u32x2 w; w.x = pk2(ov[0], ov[1]); w.y = pk2(ov[2], ov[3]);
            *(u32x2*)(Y + ((size_t)b * SEQ + t0 + tl) * D + 512 + hc4) = w;
        }
    }
    __syncthreads();
}
}
__device__ __forceinline__ void sgu_item(const Frame& F, int b, int c, int g) {
    float* VN = (float*)F.lds;
    const bf16* PB = wsp<bf16>(F, WS_PB); bf16* Y = wsp<bf16>(F, WS_YB);
    const float* ln_g = F.in[3]; const float* ln_b = F.in[4]; const float* w = F.in[5]; const float* bs = F.in[6];
    const int tid = F.tid, lane = F.lane, wave = F.wave; const size_t row0 = (size_t)b * SEQ + c * 128;
    for (int sI = wave; sI < 128; sI += NWAVES) {
        const bf16* pr = PB + (row0 + sI) * IN0 + 512 + 128 * g;
        const float v0 = bf2f(pr[lane]), v1 = bf2f(pr[lane + 64]);
        const float mean = wave_sum(v0 + v1) * (1.0f / 128.0f); const float d0 = v0 - mean, d1 = v1 - mean;
        const float var = wave_sum(d0 * d0 + d1 * d1) * (1.0f / 128.0f); const float rs = rsqrtf(var + 1e-5f);
        VN[sI * 132 + lane] = d0 * rs * ln_g[128 * g + lane] + ln_b[128 * g + lane];
        VN[sI * 132 + lane + 64] = d1 * rs * ln_g[128 * g + lane + 64] + ln_b[128 * g + lane + 64];
    }
    __syncthreads();
    const int t = tid >> 2, dq = tid & 3;
    f32x4 acc[8];
#pragma unroll
    for (int i = 0; i < 8; ++i) acc[i] = (f32x4){0.f, 0.f, 0.f, 0.f};
    const float* wrow = w + ((size_t)g * 128 + t) * 128;
    for (int sI = 0; sI <= t; ++sI) {
        const float ww = wrow[sI]; const f32x4* vr = (const f32x4*)&VN[sI * 132 + 32 * dq];
#pragma unroll
        for (int i = 0; i < 8; ++i) acc[i] += vr[i] * ww;
    }
    const float bias = bs[g * 128 + t];
    const bf16* ur = PB + (row0 + t) * IN0 + 128 * g + 32 * dq; bf16* yr = Y + (row0 + t) * D + 128 * g + 32 * dq;
#pragma unroll
    for (int i = 0; i < 8; ++i) {
        const u32x2 uu = *(const u32x2*)(ur + 4 * i);
        const float o0 = (acc[i][0] + bias) * bf2f(uu.x & 0xffffu), o1 = (acc[i][1] + bias) * bf2f(uu.x >> 16), o2 = (acc[i][2] + bias) * bf2f(uu.y & 0xffffu), o3 = (acc[i][3] + bias) * bf2f(uu.y >> 16);
        u32x2 wv; wv.x = pk2(o0, o1); wv.y = pk2(o2, o3); *(u32x2*)(yr + 4 * i) = wv;
    }
    __syncthreads();
}
__device__ __forceinline__ void p_lora(const Frame& F) {
    LAS unsigned char* L = (LAS unsigned char*)F.lds;
    constexpr int LINP = 264;
    const bf16* PB = wsp<bf16>(F, WS_PB); bf16* LO = (bf16*)F.out; const float* mu = F.in[7];
    int tid = F.tid; asm volatile("" : "+v"(tid));
    const int lane = tid & 63, wave = F.wave, fr = lane & 15, fq = lane >> 4;
    for (int it = F.blk; it < NTOK / 32; it += F.G) {
        const size_t tok0 = (size_t)it * 32; const int t0 = (int)(tok0 & (SEQ - 1));
#pragma unroll
        for (int i = 0; i < 2; ++i) {
            const int idx = tid + NTHR * i, tl = idx >> 5, lc = idx & 31, pc = 1536 + 8 * lc;
            const bf16* p = PB + (tok0 + tl) * IN0 + 1024 + pc;
            const u32x4 cur = *(const u32x4*)p; const u32x4 prev = (t0 + tl) > 0 ? *(const u32x4*)(p - IN0) : (u32x4){0u, 0u, 0u, 0u};
            const f32x4 m0 = *(const f32x4*)(mu + pc), m1 = *(const f32x4*)(mu + pc + 4);
            float xs[8];
#pragma unroll
            for (int j = 0; j < 4; ++j) {
                const float c0 = bf2f(cur[j] & 0xffffu), c1 = bf2f(cur[j] >> 16), p0 = bf2f(prev[j] & 0xffffu), p1 = bf2f(prev[j] >> 16);
                const float mA = j < 2 ? m0[2 * j] : m1[2 * j - 4], mB = j < 2 ? m0[2 * j + 1] : m1[2 * j - 3];
                xs[2 * j] = c0 + (p0 - c0) * mA; xs[2 * j + 1] = c1 + (p1 - c1) * mB;
            }
            if (lc < 8) {
#pragma unroll
                for (int j = 0; j < 8; ++j) xs[j] = 1.0f - 2.0f * rcpf_(1.0f + __expf(2.0f * xs[j]));
            } else if (lc >= 16) {
#pragma unroll
                for (int j = 0; j < 8; ++j) xs[j] = sigmoidf_(xs[j]);
            }
            u32x4 w; w.x = pk2(xs[0], xs[1]); w.y = pk2(xs[2], xs[3]); w.z = pk2(xs[4], xs[5]); w.w = pk2(xs[6], xs[7]);
            *(LAS u32x4*)(L + (tl * LINP + 8 * lc) * 2) = w;
        }
        __syncthreads();
#pragma unroll
        for (int lr = 0; lr < 3; ++lr) {
            const int KS = lr == 2 ? 4 : 2, wk = lr == 2 ? 128 : 64, lcol = lr == 0 ? 0 : (lr == 1 ? 64 : 128);
            const bf16* wt = wsp<bf16>(F, lr == 0 ? WT_W2 : (lr == 1 ? WT_A2 : WT_G2));
            bf16x8 af[4][4];
#pragma unroll
            for (int nt = 0; nt < 4; ++nt)
#pragma unroll
                for (int ks = 0; ks < 4; ++ks) if (ks < KS) af[nt][ks] = *(const bf16x8*)(wt + (size_t)(64 * wave + 16 * nt + fr) * wk + 32 * ks + 8 * fq);
#pragma unroll
            for (int nt = 0; nt < 4; ++nt) {
                const int n0 = 64 * wave + 16 * nt;
                f32x4 acc0 = {0.f, 0.f, 0.f, 0.f}, acc1 = {0.f, 0.f, 0.f, 0.f};
#pragma unroll
                for (int ks = 0; ks < 4; ++ks) if (ks < KS) {
                    acc0 = __builtin_amdgcn_mfma_f32_16x16x32_bf16(af[nt][ks], *(const LAS bf16x8*)(L + (fr * LINP + lcol + 32 * ks + 8 * fq) * 2), acc0, 0, 0, 0);
                    acc1 = __builtin_amdgcn_mfma_f32_16x16x32_bf16(af[nt][ks], *(const LAS bf16x8*)(L + ((16 + fr) * LINP + lcol + 32 * ks + 8 * fq) * 2), acc1, 0, 0, 0);
                }
                u32x2 w0, w1; w0.x = pk2(acc0[0], acc0[1]); w0.y = pk2(acc0[2], acc0[3]); w1.x = pk2(acc1[0], acc1[1]); w1.y = pk2(acc1[2], acc1[3]);
                *(u32x2*)(LO + (tok0 + fr) * 1536 + lr * 512 + n0 + 4 * fq) = w0;
                *(u32x2*)(LO + (tok0 + 16 + fr) * 1536 + lr * 512 + n0 + 4 * fq) = w1;
            }
        }
        __syncthreads();
    }
}
__device__ __forceinline__ void sgu_item_mfma(const Frame& F, int b, int c, int g) {
    LAS unsigned char* L = (LAS unsigned char*)F.lds;
    constexpr int VNT = 0, VP = 272, OUTB = 34816, OP = 132;
    const bf16* PB = wsp<bf16>(F, WS_PB); bf16* Y = wsp<bf16>(F, WS_YB);
    const float* ln_g = F.in[3]; const float* ln_b = F.in[4]; const float* bs = F.in[6];
    int tid = F.tid; asm volatile("" : "+v"(tid));
    const int lane = tid & 63, wave = F.wave, fr = lane & 15, fq = lane >> 4; const size_t row0 = (size_t)b * SEQ + c * 128;
    {
        const int sI = tid >> 2, dq = tid & 3;
        const bf16* pr = PB + (row0 + sI) * IN0 + 512 + 128 * g + 32 * dq;
        u32x4 raw[4];
#pragma unroll
        for (int i = 0; i < 4; ++i) raw[i] = *(const u32x4*)(pr + 8 * i);
        float v[32]; float sum = 0.f;
#pragma unroll
        for (int i = 0; i < 4; ++i)
#pragma unroll
            for (int j = 0; j < 4; ++j) { v[8 * i + 2 * j] = bf2f(raw[i][j] & 0xffffu); v[8 * i + 2 * j + 1] = bf2f(raw[i][j] >> 16); sum += v[8 * i + 2 * j] + v[8 * i + 2 * j + 1]; }
        sum += dpp_f<0xB1>(sum); sum += dpp_f<0x4E>(sum);
        const float mean = sum * (1.0f / 128.0f); float sq = 0.f;
#pragma unroll
        for (int i = 0; i < 32; ++i) { v[i] -= mean; sq += v[i] * v[i]; }
        sq += dpp_f<0xB1>(sq); sq += dpp_f<0x4E>(sq);
        const float rs = rsqrtf(sq * (1.0f / 128.0f) + 1e-5f);
        const float* lgp = ln_g + 128 * g + 32 * dq; const float* lbp = ln_b + 128 * g + 32 * dq;
#pragma unroll
        for (int i4 = 0; i4 < 8; ++i4) {
            const f32x4 gg = *(const f32x4*)(lgp + 4 * i4), bb = *(const f32x4*)(lbp + 4 * i4);
#pragma unroll
            for (int i = 0; i < 4; ++i) *(LAS unsigned short*)(L + VNT + (32 * dq + 4 * i4 + i) * VP + 2 * sI) = (unsigned short)f2bf(v[4 * i4 + i] * rs * gg[i] + bb[i]);
        }
    }
    __syncthreads();
    {
        const bf16* wm = wsp<bf16>(F, WT_SGU) + ((size_t)g * 128 + 16 * wave + fr) * 128 + 8 * fq;
        f32x4 acc[8];
#pragma unroll
        for (int n = 0; n < 8; ++n) acc[n] = (f32x4){0.f, 0.f, 0.f, 0.f};
        const int nks = (wave >> 1) + 1;
        for (int ks = 0; ks < nks; ++ks) {
            const bf16x8 af = *(const bf16x8*)(wm + 32 * ks);
#pragma unroll
            for (int n = 0; n < 8; ++n) acc[n] = __builtin_amdgcn_mfma_f32_16x16x32_bf16(af, *(const LAS bf16x8*)(L + VNT + (16 * n + fr) * VP + (32 * ks + 8 * fq) * 2), acc[n], 0, 0, 0);
        }
#pragma unroll
        for (int n = 0; n < 8; ++n)
#pragma unroll
            for (int r = 0; r < 4; ++r) *(LAS float*)(L + OUTB + ((16 * wave + 4 * fq + r) * OP + 16 * n + fr) * 4) = acc[n][r];
    }
    __syncthreads();
    {
        const int t = tid >> 2, dq = tid & 3; const float bias = bs[g * 128 + t];
        const bf16* ur = PB + (row0 + t) * IN0 + 128 * g + 32 * dq; bf16* yr = Y + (row0 + t) * D + 128 * g + 32 * dq;
#pragma unroll
        for (int i = 0; i < 4; ++i) {
            const u32x4 uu = *(const u32x4*)(ur + 8 * i);
            const f32x4 a0 = *(const LAS f32x4*)(L + OUTB + (t * OP + 32 * dq + 8 * i) * 4), a1 = *(const LAS f32x4*)(L + OUTB + (t * OP + 32 * dq + 8 * i + 4) * 4);
            u32x4 wv;
            wv.x = pk2((a0[0] + bias) * bf2f(uu.x & 0xffffu), (a0[1] + bias) * bf2f(uu.x >> 16)); wv.y = pk2((a0[2] + bias) * bf2f(uu.y & 0xffffu), (a0[3] + bias) * bf2f(uu.y >> 16));
            wv.z = pk2((a1[0] + bias) * bf2f(uu.z & 0xffffu), (a1[1] + bias) * bf2f(uu.z >> 16)); wv.w = pk2((a1[2] + bias) * bf2f(uu.w & 0xffffu), (a1[3] + bias) * bf2f(uu.w >> 16));
            *(u32x4*)(yr + 8 * i) = wv;
        }
    }
    __syncthreads();
}
__device__ __forceinline__ void p_mix0(const Frame& F) {
    if (F.G >= 256) {
#ifdef RW2_SCAN
        if (F.blk < 128) rw2::item(F, F.blk >> 3, F.blk & 7);
#else
        if (F.blk < 128) rw3::item(F, F.blk >> 3, F.blk & 7);
#endif
        else {
            const int nb = F.G - 128, c = F.blk - 128;
            for (int s = c; s < 1024; s += nb) sgu_item_mfma(F, s >> 6, (s >> 2) & 15, s & 3);
        }
        tr_queue(F, I_IN0, TR_LORA0);
    } else {
        for (int it = F.blk; it < 128 + 1024; it += F.G) {
            if (it < 128) rwkv_item(F, it >> 3, it & 7);
            else { const int s = it - 128; sgu_item(F, s >> 6, (s >> 2) & 15, s & 3); }
        }
        tr_range(F, I_IN0, TR_LORA0, F.blk * NWAVES + F.wave, F.G * NWAVES);
    }
}

__device__ __forceinline__ void p_nsa_prep(const Frame& F) {
    bf16* PB = wsp<bf16>(F, WS_PB); bf16* QR = wsp<bf16>(F, WS_QROT); bf16* Y = wsp<bf16>(F, WS_YB); const float* rope = wsp<float>(F, M_ROPE);
    const bool split = F.G >= 64;
    const int ncmp = split ? 32 : 0;
    const int gt = (F.blk - ncmp) * NTHR + F.tid, NGT = (F.G - ncmp) * NTHR;
    if (!split || F.blk >= 32) {
    for (int idx = gt; idx < NTOK * 12; idx += NGT) {
        const int row = idx / 12, j = idx - row * 12, t = row & (SEQ - 1);
        const f32x4* cs = (const f32x4*)(rope + t * 16); const f32x4 c0 = cs[0], c1 = cs[1], s0 = cs[2], s1 = cs[3];
        const bf16* src; bf16* dst;
        if (j < 8) { src = PB + (size_t)row * IN1P + C_Q + 64 * j; dst = QR + (size_t)row * 512 + 64 * j; }
        else if (j < 10) { src = PB + (size_t)row * IN1P + C_KS + 64 * (j - 8); dst = PB + (size_t)row * IN1P + C_KS + 64 * (j - 8); }
        else { src = PB + (size_t)row * IN1P + C_KW + 64 * (j - 10); dst = PB + (size_t)row * IN1P + C_KW + 64 * (j - 10); }
        const u32x4 a = *(const u32x4*)src, bq = *(const u32x4*)(src + 8);
        float x1[8], x2[8], o1[8], o2[8];
#pragma unroll
        for (int i = 0; i < 4; ++i) { x1[2 * i] = bf2f(a[i] & 0xffffu); x1[2 * i + 1] = bf2f(a[i] >> 16); x2[2 * i] = bf2f(bq[i] & 0xffffu); x2[2 * i + 1] = bf2f(bq[i] >> 16); }
#pragma unroll
        for (int i = 0; i < 8; ++i) { const float c = i < 4 ? c0[i & 3] : c1[i & 3], s = i < 4 ? s0[i & 3] : s1[i & 3]; o1[i] = x1[i] * c - x2[i] * s; o2[i] = x1[i] * s + x2[i] * c; }
        u32x4 w1, w2_;
#pragma unroll
        for (int i = 0; i < 4; ++i) { w1[i] = pk2(o1[2 * i], o1[2 * i + 1]); w2_[i] = pk2(o2[2 * i], o2[2 * i + 1]); }
        *(u32x4*)dst = w1; *(u32x4*)(dst + 8) = w2_;
        if (j < 8) {
#pragma unroll
            for (int i = 2; i < 8; ++i) *(u32x4*)(dst + 8 * i) = *(const u32x4*)(src + 8 * i);
        }
    }
    const float* cw = F.in[31];
    for (int idx = gt; idx < NTOK * 64; idx += NGT) {
        const int row = idx >> 6, c0 = (idx & 63) * 8, t = row & (SEQ - 1);
        float y[8];
#pragma unroll
        for (int i = 0; i < 8; ++i) y[i] = 0.f;
#pragma unroll
        for (int wq = 0; wq < 3; ++wq) {
            const int tt = t - 2 + wq;
            if (tt >= 0) {
                const size_t ro = (size_t)(row - 2 + wq) * IN1P;
                const u32x4 cg = *(const u32x4*)(PB + ro + C_CG + c0), hd = *(const u32x4*)(PB + ro + C_HD + c0);
                const f32x4 w0 = *(const f32x4*)(cw + wq * 512 + c0), w1 = *(const f32x4*)(cw + wq * 512 + c0 + 4);
#pragma unroll
                for (int i = 0; i < 4; ++i) {
                    const float z0 = bf2f(cg[i] & 0xffffu) * bf2f(hd[i] & 0xffffu), z1 = bf2f(cg[i] >> 16) * bf2f(hd[i] >> 16);
                    y[2 * i] += z0 * (i < 2 ? w0[2 * i] : w1[2 * i - 4]); y[2 * i + 1] += z1 * (i < 2 ? w0[2 * i + 1] : w1[2 * i - 3]);
                }
            }
        }
        const u32x4 bg = *(const u32x4*)(PB + (size_t)row * IN1P + C_BG + c0);
        u32x4 o;
#pragma unroll
        for (int i = 0; i < 4; ++i) o[i] = pk2(y[2 * i] * bf2f(bg[i] & 0xffffu), y[2 * i + 1] * bf2f(bg[i] >> 16));
        *(u32x4*)(Y + (size_t)row * D + 512 + c0) = o;
    }
    }
    if (!split || F.blk < 32) {
        Gemm g; g.A = PB; g.Bt = wsp<bf16>(F, WT_CK1); g.K = 2048; g.a_row = 16 * IN1P * 2; g.a_half = 64 * 2; g.a_k = IN1P * 2; g.b_row = 2048 * 2; g.b_half = 128 * 2048 * 2; g.b_k = 128;
        CmpOrder S; S.G = split ? 32 : F.G; S.c = F.blk;
        EpiCmp1 E{wsp<bf16>(F, M_HID), wsp<float>(F, M_C1)};
        gemm_run<7, EpiCmp1, CmpOrder>(F, g, S, E);
        asm volatile("s_waitcnt vmcnt(0)" ::: "memory");
        __threadfence_block();
        __syncthreads();
        Unit u;
        for (int i = 0; S.next(i, u); ++i) {
            const int which = u.pm >> 4, wid = F.wave, fr = F.lane & 15, fq = F.lane >> 4;
            const bf16* hid = wsp<bf16>(F, M_HID) + ((size_t)u.pm * 256 + 32 * wid) * 256;
            const bf16* w2 = wsp<bf16>(F, which ? WT_CV2 : WT_CK2);
            bf16* out = wsp<bf16>(F, which ? M_VCMP : M_KCMP) + ((size_t)(u.pm & 15) * 256 + 32 * wid) * 64;
            f32x4 acc[2][4];
#pragma unroll
            for (int m = 0; m < 2; ++m)
#pragma unroll
                for (int n = 0; n < 4; ++n) acc[m][n] = (f32x4){0.f, 0.f, 0.f, 0.f};
#pragma unroll 2
            for (int ks = 0; ks < 8; ++ks) {
                bf16x8 af[2], bfr[4];
#pragma unroll
                for (int m = 0; m < 2; ++m) af[m] = *(const bf16x8*)(hid + (size_t)(16 * m + fr) * 256 + 32 * ks + 8 * fq);
#pragma unroll
                for (int n = 0; n < 4; ++n) bfr[n] = *(const bf16x8*)(w2 + (size_t)(16 * n + fr) * 256 + 32 * ks + 8 * fq);
#pragma unroll
                for (int m = 0; m < 2; ++m)
#pragma unroll
                    for (int n = 0; n < 4; ++n) acc[m][n] = __builtin_amdgcn_mfma_f32_16x16x32_bf16(af[m], bfr[n], acc[m][n], 0, 0, 0);
            }
#pragma unroll
            for (int m = 0; m < 2; ++m)
#pragma unroll
                for (int n = 0; n < 4; ++n)
#pragma unroll
                    for (int r = 0; r < 4; ++r) out[(size_t)(16 * m + 4 * fq + r) * 64 + 16 * n + fr] = (bf16)(((32 * wid + 16 * m + 4 * fq + r) & 127) == 127 ? 0u : f2bf(acc[m][n][r]));
        }
    }
}
__device__ __forceinline__ void p_cmp2(const Frame& F) {
    const bf16* HID = wsp<bf16>(F, M_HID); const int gt = F.blk * NTHR + F.tid, NGT = F.G * NTHR;
    for (int idx = gt; idx < 2 * 4096 * 64; idx += NGT) {
        const int which = idx >> 18, r = (idx >> 6) & 4095, d = idx & 63;
        const bf16* hr = HID + ((size_t)which * 4096 + r) * 256; const bf16* w = wsp<bf16>(F, which ? WT_CV2 : WT_CK2) + d * 256;
        float s = 0.f;
        for (int k = 0; k < 256; k += 8) {
            const u32x4 a = *(const u32x4*)(hr + k), bq = *(const u32x4*)(w + k);
#pragma unroll
            for (int i = 0; i < 4; ++i) s += bf2f(a[i] & 0xffffu) * bf2f(bq[i] & 0xffffu) + bf2f(a[i] >> 16) * bf2f(bq[i] >> 16);
        }
        wsp<bf16>(F, which ? M_VCMP : M_KCMP)[(size_t)r * 64 + d] = (bf16)f2bf(s);
    }
}
constexpr float NEGBIG = -1e30f;
__device__ __forceinline__ void score64(const bf16* krow, const float* q4, float* scdst, bool valid) {
    float dot[4] = {0.f, 0.f, 0.f, 0.f};
#pragma unroll 1
    for (int hf = 0; hf < 4; ++hf) {
        float kf[16];
#pragma unroll
        for (int i = 0; i < 2; ++i) { const u32x4 a = *(const u32x4*)(krow + 16 * hf + 8 * i);
#pragma unroll
            for (int j = 0; j < 4; ++j) { kf[8 * i + 2 * j] = bf2f(a[j] & 0xffffu); kf[8 * i + 2 * j + 1] = bf2f(a[j] >> 16); } }
#pragma unroll
        for (int g = 0; g < 4; ++g) {
#pragma unroll
            for (int d4 = 0; d4 < 4; ++d4) { const f32x4 qv = *(const f32x4*)&q4[g * 64 + 16 * hf + 4 * d4]; dot[g] += kf[4 * d4] * qv.x + kf[4 * d4 + 1] * qv.y + kf[4 * d4 + 2] * qv.z + kf[4 * d4 + 3] * qv.w; }
        }
    }
#pragma unroll
    for (int g = 0; g < 4; ++g) scdst[g * 512] = valid ? dot[g] * 0.125f : NEGBIG;
}
__device__ __forceinline__ void softmax_rows(float* sc, int nblk, int lane) {
#pragma unroll
    for (int g = 0; g < 4; ++g) {
        float m = NEGBIG;
        for (int r = 0; r < nblk; ++r) m = fmaxf(m, sc[g * 512 + 64 * r + lane]);
        m = wave_max(m);
        float sum = 0.f;
        for (int r = 0; r < nblk; ++r) { const float sv = sc[g * 512 + 64 * r + lane]; const float e = sv > -1e29f ? __expf(sv - m) : 0.f; sc[g * 512 + 64 * r + lane] = e; sum += e; }
        sum = wave_sum(sum);
        const float inv = 1.0f / fmaxf(sum, 1e-30f);
        for (int r = 0; r < nblk; ++r) sc[g * 512 + 64 * r + lane] *= inv;
    }
}
__device__ __forceinline__ void p_attn_naive(const Frame& F) {
    float* wl = (float*)F.lds + F.wave * 2688;
    float* qn = wl, *qr = wl + 256, *sc = wl + 512;
    const bf16* PB = wsp<bf16>(F, WS_PB); const bf16* QR = wsp<bf16>(F, WS_QROT); bf16* Y = wsp<bf16>(F, WS_YB);
    const bf16* KC = wsp<bf16>(F, M_KCMP); const bf16* VC = wsp<bf16>(F, M_VCMP);
    const int lane = F.lane; const int gw = F.blk * NWAVES + F.wave, NGW = F.G * NWAVES;
    for (int item = gw; item < NTOK * 2; item += NGW) {
        const int bh = item >> 11, t = item & (SEQ - 1), b = bh >> 1, hkv = bh & 1; const size_t row = (size_t)b * SEQ + t;
        LDS_FENCE();
#pragma unroll
        for (int g = 0; g < 4; ++g) { qn[g * 64 + lane] = bf2f(PB[row * IN1P + C_Q + (hkv * 4 + g) * 64 + lane]); qr[g * 64 + lane] = bf2f(QR[row * 512 + (hkv * 4 + g) * 64 + lane]); }
        LDS_FENCE();
        float oc[4], os[4], ow[4];
        const int nv = t >= 31 ? ((t - 31) >> 4) + 1 : 0;
#pragma unroll
        for (int r = 0; r < 2; ++r) { const int n = lane + 64 * r; score64(KC + ((size_t)bh * 128 + n) * 64, qn, sc + n, n < nv); }
        LDS_FENCE();
        softmax_rows(sc, 2, lane);
        LDS_FENCE();
#pragma unroll
        for (int g = 0; g < 4; ++g) oc[g] = 0.f;
        for (int n = 0; n < nv; ++n) { const float v = bf2f(VC[((size_t)bh * 128 + n) * 64 + lane]);
#pragma unroll
            for (int g = 0; g < 4; ++g) oc[g] += sc[g * 512 + n] * v; }
        const int cur = t >> 6;
        float val = -3e38f;
        if (lane < 32) {
            float imp = 0.f;
#pragma unroll
            for (int dn = -1; dn <= 3; ++dn) { const int n = 4 * lane + dn; if (n >= 0 && n <= 126) imp += (sc[n] + sc[512 + n]) + (sc[1024 + n] + sc[1536 + n]); }
            const bool forced = lane == 0 || lane == cur || lane == cur - 1;
            val = (lane * 64 <= t) ? imp + (forced ? 1e6f : 0.f) : NEGBIG;
        }
        unsigned selmask = 0u;
        for (int it = 0; it < 8; ++it) {
            float best = val; int bj = lane;
#pragma unroll
            for (int o = 32; o >= 1; o >>= 1) { const float ov = __shfl_xor(best, o); const int oj = __shfl_xor(bj, o); if (ov > best || (ov == best && oj < bj)) { best = ov; bj = oj; } }
            if (best > -1e29f) selmask |= 1u << bj;
            if (lane == bj) val = -3e38f;
        }
        LDS_FENCE();
        int nsl = 0;
        for (unsigned mm = selmask; mm; mm &= mm - 1) { const int j = __ffs(mm) - 1; const int key = j * 64 + lane;
            score64(PB + ((size_t)b * SEQ + key) * IN1P + C_KS + hkv * 64, qr, sc + nsl * 64 + lane, key <= t); ++nsl; }
        LDS_FENCE();
        softmax_rows(sc, nsl, lane);
        LDS_FENCE();
#pragma unroll
        for (int g = 0; g < 4; ++g) os[g] = 0.f;
        { int sl = 0;
          for (unsigned mm = selmask; mm; mm &= mm - 1) { const int j = __ffs(mm) - 1;
              for (int kk = 0; kk < 64; ++kk) { const int key = j * 64 + kk; if (key > t) break;
                  const float v = bf2f(PB[((size_t)b * SEQ + key) * IN1P + C_VS + hkv * 64 + lane]);
#pragma unroll
                  for (int g = 0; g < 4; ++g) os[g] += sc[g * 512 + sl * 64 + kk] * v; }
              ++sl; } }
        LDS_FENCE();
#pragma unroll 1
        for (int kb = 0; kb < 8; ++kb) { const int key = t - 511 + 64 * kb + lane; const int keyc = key < 0 ? 0 : key;
            score64(PB + ((size_t)b * SEQ + keyc) * IN1P + C_KW + hkv * 64, qr, sc + kb * 64 + lane, key >= 0); }
        LDS_FENCE();
        softmax_rows(sc, 8, lane);
        LDS_FENCE();
#pragma unroll
        for (int g = 0; g < 4; ++g) ow[g] = 0.f;
        for (int p = (t >= 511 ? 0 : 511 - t); p < 512; ++p) { const int key = t - 511 + p;
            const float v = bf2f(PB[((size_t)b * SEQ + key) * IN1P + C_VW + hkv * 64 + lane]);
#pragma unroll
            for (int g = 0; g < 4; ++g) ow[g] += sc[g * 512 + p] * v; }
#pragma unroll
        for (int g = 0; g < 4; ++g) {
            const bf16* gl = PB + row * IN1P + C_GL + (hkv * 4 + g) * 3;
            const float o = sigmoidf_(bf2f(gl[0])) * oc[g] + sigmoidf_(bf2f(gl[1])) * os[g] + sigmoidf_(bf2f(gl[2])) * ow[g];
            Y[row * D + (hkv * 4 + g) * 64 + lane] = (bf16)f2bf(o);
        }
    }
}

namespace nsa {
typedef float f32x16 __attribute__((ext_vector_type(16)));
typedef short s16x4 __attribute__((ext_vector_type(4)));
typedef short v4i16_t __attribute__((ext_vector_type(4)));
typedef __bf16 bf16x2_t __attribute__((ext_vector_type(2)));
typedef LAS const char* lds_cptr;
constexpr int L_KV = 0, L_OV = 32768, L_IMP = 40960, L_WSF = 73728, L_SEL = 77824;
constexpr float C2 = 0.125f * 1.4426950408889634f, NEG = -1e30f;
__device__ __forceinline__ int crow(int r, int hi) { return (r & 3) + 8 * (r >> 2) + 4 * hi; }
__device__ __forceinline__ float max3f(float a_, float b_, float c_) { float r_; asm("v_max3_f32 %0, %1, %2, %3" : "=v"(r_) : "v"(a_), "v"(b_), "v"(c_)); return r_; }
__device__ __forceinline__ unsigned cvtpk(float lo, float hi) { f32x2 v = {lo, hi}; bf16x2_t b = __builtin_convertvector(v, bf16x2_t); return __builtin_bit_cast(unsigned, b); }
__device__ __forceinline__ s16x4 vtr(lds_cptr p) { return __builtin_bit_cast(s16x4, __builtin_amdgcn_ds_read_tr16_b64_v4i16((LAS v4i16_t*)p)); }
__device__ __forceinline__ void qkt(f32x16& p0, f32x16& p1, lds_cptr Kslot, const bf16x8* q, int r32, int hi) {
    lds_cptr kb = Kslot + hi * 1024 + r32 * 16;
    p0 = f32x16{}; p1 = f32x16{};
#pragma unroll
    for (int d0 = 0; d0 < 4; ++d0) {
        const bf16x8 b0 = *(const LAS bf16x8*)(kb + d0 * 2048), b1 = *(const LAS bf16x8*)(kb + d0 * 2048 + 512);
        p0 = __builtin_amdgcn_mfma_f32_32x32x16_bf16(b0, q[d0], p0, 0, 0, 0);
        p1 = __builtin_amdgcn_mfma_f32_32x32x16_bf16(b1, q[d0], p1, 0, 0, 0);
    }
}
__device__ __forceinline__ void pv32(f32x16& o, lds_cptr vp, const bf16x8* pa) {
#pragma unroll
    for (int ks = 0; ks < 4; ++ks) {
        const s16x4 lo = vtr(vp + ks * 1024), hh = vtr(vp + ks * 1024 + 512);
        const bf16x8 bv = (bf16x8){lo[0], lo[1], lo[2], lo[3], hh[0], hh[1], hh[2], hh[3]};
        o = __builtin_amdgcn_mfma_f32_32x32x16_bf16(pa[ks], bv, o, 0, 0, 0);
    }
}

struct Item { int b, hkv, bh, qb; };

template <int KIND>
__device__ __forceinline__ void branch(const Frame& F, const Item& it, LAS char* L, const bf16x8* q, const bf16* kbase, const bf16* vbase, int pitch, int blk0, int nsteps,
                                       float gate, unsigned selm, unsigned (&otp)[16]) {
    int tid = F.tid; asm volatile("" : "+v"(tid));
    const int lane = tid & 63, wid = F.wave, g = wid >> 1, qh = wid & 1;
    int r32 = lane & 31, hi = lane >> 5; asm volatile("" : "+v"(r32), "+v"(hi));
    const int ql = 32 * qh + r32, tq = it.qb * 64 + ql;
    LAS float* wsf = (LAS float*)(L + L_WSF) + wid * 128;
    float m2 = -1e20f, l = 0.f; f32x16 o0 = f32x16{}, o1 = f32x16{}, oe = f32x16{};
    const int nv = KIND == 0 ? (tq >= 31 ? ((tq - 31) >> 4) + 1 : 0) : 0;
    const size_t koff = (size_t)(tid & 63) * pitch + (tid >> 6) * 8, voff = (size_t)(16 * (wid & 3) + (lane >> 2)) * pitch + (wid >> 2) * 32 + (lane & 3) * 8;
    const int vlane = ((lane >> 4) & 1) * 32 + (lane & 3) * 8 + (4 * hi + ((lane & 15) >> 2)) * 64;
#define NSA_LOAD(KR, VR, blk_) do { KR = *(const u32x4*)(kbase + (size_t)(blk_) * 64 * pitch + koff); VR = *(const u32x4*)(vbase + (size_t)(blk_) * 64 * pitch + voff); } while (0)
#define NSA_STEP(KR, VR, s_) do { \
        const int blk = blk0 + (s_); LAS char* buf = L + L_KV + ((s_) & 1) * 16384; \
        *(LAS u32x4*)(buf + (tid >> 6) * 1024 + (tid & 63) * 16) = KR; *(LAS u32x4*)(buf + 8192 + wid * 1024 + lane * 16) = VR; \
        __syncthreads(); \
        if ((s_) + 1 < nsteps) NSA_LOAD(KR, VR, blk + 1); \
        const bool mine = KIND == 1 ? ((selm >> blk) & 1u) != 0u : true; \
        if (KIND != 1 || __any(mine)) { \
        f32x16 p0, p1; qkt(p0, p1, (lds_cptr)buf, q, r32, hi); \
        if (KIND == 0) { \
            const int kb0 = blk * 64 + 4 * hi; \
            _Pragma("unroll") for (int r = 0; r < 16; ++r) { const int key = kb0 + (r & 3) + 8 * (r >> 2); if (key >= nv) p0[r] = NEG; if (key + 32 >= nv) p1[r] = NEG; } \
        } else { \
            if (blk == it.qb) { _Pragma("unroll") for (int r = 0; r < 16; ++r) { const int kl = 4 * hi + (r & 3) + 8 * (r >> 2); if (kl > ql) p0[r] = NEG; if (kl + 32 > ql) p1[r] = NEG; } } \
            if (KIND == 2 && blk + 8 == it.qb) { _Pragma("unroll") for (int r = 0; r < 16; ++r) { const int kl = 4 * hi + (r & 3) + 8 * (r >> 2); if (kl <= ql) p0[r] = NEG; if (kl + 32 <= ql) p1[r] = NEG; } } \
        } \
        float rm = max3f(p0[0], p1[0], p0[1]); \
        _Pragma("unroll") for (int r = 1; r < 15; ++r) rm = max3f(rm, p1[r], p0[r + 1]); \
        rm = fmaxf(rm, p1[15]); \
        if (KIND == 1) rm = mine ? rm : NEG; \
        { auto rr_ = __builtin_amdgcn_permlane32_swap(__float_as_uint(rm), __float_as_uint(rm), false, false); rm = fmaxf(__uint_as_float(rr_[0]), __uint_as_float(rr_[1])); } \
        const float rm2 = rm * C2; \
        if (__any(rm2 > m2 + 8.0f)) { \
            const float mn = fmaxf(m2, rm2); const float alpha = __builtin_amdgcn_exp2f(m2 - mn); l *= alpha; m2 = mn; \
            LDS_FENCE(); \
            if (hi == 0) wsf[r32] = alpha; \
            LDS_FENCE(); \
            _Pragma("unroll") for (int r = 0; r < 16; ++r) { const float a_ = wsf[crow(r, hi)]; o0[r] *= a_; o1[r] *= a_; if (KIND == 0) oe[r] *= a_; } \
            LDS_FENCE(); \
        } \
        const float meff = (KIND == 1 && !mine) ? 1e30f : m2; \
        f32x2 sum2 = {0.f, 0.f}; \
        _Pragma("unroll") for (int r = 0; r < 16; r += 2) { \
            f32x2 a2 = (f32x2){p0[r], p0[r + 1]} * C2 - meff, b2 = (f32x2){p1[r], p1[r + 1]} * C2 - meff; \
            a2.x = __builtin_amdgcn_exp2f(a2.x); a2.y = __builtin_amdgcn_exp2f(a2.y); b2.x = __builtin_amdgcn_exp2f(b2.x); b2.y = __builtin_amdgcn_exp2f(b2.y); \
            p0[r] = a2.x; p0[r + 1] = a2.y; p1[r] = b2.x; p1[r + 1] = b2.y; sum2 += a2 + b2; } \
        l += sum2.x + sum2.y; \
        bf16x8 pa[4]; \
        _Pragma("unroll") for (int ks = 0; ks < 2; ++ks) { \
            u32x4 w0, w1; \
            _Pragma("unroll") for (int i = 0; i < 4; ++i) { w0[i] = cvtpk(p0[8 * ks + 2 * i], p0[8 * ks + 2 * i + 1]); w1[i] = cvtpk(p1[8 * ks + 2 * i], p1[8 * ks + 2 * i + 1]); } \
            pa[ks] = __builtin_bit_cast(bf16x8, w0); pa[2 + ks] = __builtin_bit_cast(bf16x8, w1); \
        } \
        lds_cptr vp = (lds_cptr)buf + 8192 + vlane; \
        pv32(o0, vp, pa); pv32(o1, vp + 4096, pa); \
        if (KIND == 0) pv32(oe, (lds_cptr)L + L_OV + blk * 4096 + vlane, pa); \
        } } while (0)
    u32x4 kA, vA;
    NSA_LOAD(kA, vA, blk0);
#pragma unroll 1
    for (int s = 0; s < nsteps; ++s) { NSA_STEP(kA, vA, s); }
#undef NSA_LOAD
#undef NSA_STEP
    float lt; { auto rr_ = __builtin_amdgcn_permlane32_swap(__float_as_uint(l), __float_as_uint(l), false, false); lt = __uint_as_float(rr_[0]) + __uint_as_float(rr_[1]); }
    const float inv = lt > 0.f ? 1.0f / lt : 0.f;
    LDS_FENCE();
    if (hi == 0) { wsf[r32] = gate * inv; wsf[32 + r32] = inv; }
    LDS_FENCE();
#pragma unroll
    for (int r = 0; r < 16; ++r) {
        const float a = wsf[crow(r, hi)]; otp[r] = cvtpk(bf2f(otp[r] & 0xffffu) + o0[r] * a, bf2f(otp[r] >> 16) + o1[r] * a);
        if (KIND == 0) ((LAS float*)(L + L_IMP))[(g * 64 + 32 * qh + crow(r, hi)) * 32 + r32] = oe[r] * wsf[32 + crow(r, hi)];
    }
    LDS_FENCE();
    __syncthreads();
}

__device__ __forceinline__ void attn_item(const Frame& F, const Item& it, LAS char* L) {
    const int tid = F.tid, lane = F.lane, wid = F.wave, g = wid >> 1, qh = wid & 1;
    int r32 = lane & 31, hi = lane >> 5; asm volatile("" : "+v"(r32), "+v"(hi));
    const bf16* PB = wsp<bf16>(F, WS_PB); const bf16* QR = wsp<bf16>(F, WS_QROT); bf16* Y = wsp<bf16>(F, WS_YB);
    const int head = it.hkv * 4 + g; const size_t rowq = (size_t)it.b * SEQ + it.qb * 64 + 32 * qh + r32;
    bf16x8 qn[4];
#pragma unroll
    for (int d0 = 0; d0 < 4; ++d0) qn[d0] = *(const bf16x8*)(PB + rowq * IN1P + C_Q + head * 64 + hi * 8 + d0 * 16);
    const bf16* glp = PB + rowq * IN1P + C_GL + head * 3;
    const float g0 = sigmoidf_(bf2f(glp[0])), g1 = sigmoidf_(bf2f(glp[1])), g2 = sigmoidf_(bf2f(glp[2]));
    unsigned otp[16];
#pragma unroll
    for (int r = 0; r < 16; ++r) otp[r] = 0u;
    branch<0>(F, it, L, qn, wsp<bf16>(F, M_KCMP) + (size_t)it.bh * 128 * 64, wsp<bf16>(F, M_VCMP) + (size_t)it.bh * 128 * 64, 64, 0, 2, g0, 0u, otp);
    {
        const int ql = tid >> 3, part = tid & 7;
        const LAS float* imp = (const LAS float*)(L + L_IMP) + ql * 32 + 4 * part;
        const f32x4 a = *(const LAS f32x4*)imp, b2 = *(const LAS f32x4*)(imp + 2048), c = *(const LAS f32x4*)(imp + 4096), d = *(const LAS f32x4*)(imp + 6144);
        float v[4];
#pragma unroll
        for (int i = 0; i < 4; ++i) { const int j = 4 * part + i; const bool forced = j == 0 || j == it.qb || j == it.qb - 1; v[i] = j <= it.qb ? ((a[i] + b2[i]) + (c[i] + d[i])) + (forced ? 1e6f : 0.f) : NEG; }
        unsigned mask = 0u;
#pragma unroll 1
        for (int k = 0; k < 8; ++k) {
            float best = v[0]; int bi = 4 * part;
#pragma unroll
            for (int i = 1; i < 4; ++i) if (v[i] > best) { best = v[i]; bi = 4 * part + i; }
#define NSA_MRG(CTRL) do { const float ov = __builtin_bit_cast(float, __builtin_amdgcn_update_dpp(0, __builtin_bit_cast(int, best), CTRL, 0xF, 0xF, true)); const int oj = __builtin_amdgcn_update_dpp(0, bi, CTRL, 0xF, 0xF, true); \
            if (ov > best || (ov == best && oj < bi)) { best = ov; bi = oj; } } while (0)
            NSA_MRG(0xB1); NSA_MRG(0x4E); NSA_MRG(0x141);
#undef NSA_MRG
            if (best > -1e29f) mask |= 1u << bi;
#pragma unroll
            for (int i = 0; i < 4; ++i) if (4 * part + i == bi) v[i] = -3e38f;
        }
        if (part == 0) ((LAS unsigned*)(L + L_SEL))[ql] = mask;
    }
    __syncthreads();
    const unsigned selm = ((const LAS unsigned*)(L + L_SEL))[32 * qh + r32];
    bf16x8 qr[4];
#pragma unroll
    for (int d0 = 0; d0 < 4; ++d0) qr[d0] = *(const bf16x8*)(QR + rowq * 512 + head * 64 + hi * 8 + d0 * 16);
    const bf16* rowb = PB + (size_t)it.b * SEQ * IN1P + it.hkv * 64;
    branch<1>(F, it, L, qr, rowb + C_KS, rowb + C_VS, IN1P, 0, it.qb + 1, g1, selm, otp);
    const int jlo = it.qb >= 8 ? it.qb - 8 : 0;
    branch<2>(F, it, L, qr, rowb + C_KW, rowb + C_VW, IN1P, jlo, it.qb - jlo + 1, g2, 0u, otp);
    bf16* yb = Y + ((size_t)it.b * SEQ + it.qb * 64 + 32 * qh) * D + head * 64 + r32;
#pragma unroll
    for (int r = 0; r < 16; ++r) { yb[(size_t)crow(r, hi) * D] = (bf16)(otp[r] & 0xffffu); yb[(size_t)crow(r, hi) * D + 32] = (bf16)(otp[r] >> 16); }
}
__device__ __forceinline__ void p_attn(const Frame& F) {
    LAS char* L = (LAS char*)F.lds;
    for (int idx = F.tid; idx < 4096; idx += NTHR) {
        const int bk = idx >> 11, nin = (idx >> 5) & 63, j = idx & 31, n = 64 * bk + nin;
        const bool ov = (n >= 4 * j - 1) && (n <= 4 * j + 3) && (n <= 126);
        *(LAS bf16*)(L + L_OV + bk * 4096 + nin * 64 + j * 2) = (bf16)(ov ? 0x3F80u : 0u);
    }
    __syncthreads();
    const int vcu = (F.G % 8 == 0) ? (F.blk % 8) * (F.G / 8) + F.blk / 8 : F.blk;
    for (int qi = vcu; qi < 256; qi += F.G) {
        const int bh = qi >> 3, sft = qi & 7;
#pragma unroll 1
        for (int k = 0; k < 4; ++k) {
            Item it; it.bh = bh; it.b = bh >> 1; it.hkv = bh & 1; it.qb = k == 0 ? sft : (k == 1 ? 15 - sft : (k == 2 ? 16 + sft : 31 - sft));
            attn_item(F, it, L);
        }
    }
}
}

__device__ __forceinline__ void p_route_a(const Frame& F) {
    LAS unsigned char* L = (LAS unsigned char*)F.lds;
    LAS int* hist = (LAS int*)(L + 32768);
    {
        const f32x4* src = (const f32x4*)wsp<float>(F, M_WR);
#pragma unroll
        for (int i = 0; i < 4; ++i) *(LAS f32x4*)(L + (F.tid + NTHR * i) * 16) = src[F.tid + NTHR * i];
        if (F.tid < 8) hist[F.tid] = 0;
    }
    __syncthreads();
    const bf16* XB = wsp<bf16>(F, WS_XB); const float* RS = wsp<float>(F, M_RS); const float* rb = F.in[35];
    int* TOPE = wsp<int>(F, M_TOPE); float* TOPG = wsp<float>(F, M_TOPG); float* RSTD3 = wsp<float>(F, M_RSTD3);
    const int chunk = (NTOK + F.G - 1) / F.G, cs = F.blk * chunk, ce = min(NTOK, cs + chunk); const int lane = F.lane;
    const int sub = lane >> 4, l16 = lane & 15;
    for (int tok0 = cs + 4 * F.wave; tok0 < ce; tok0 += 4 * NWAVES) {
        const int tok = tok0 + sub; const bool ok = tok < ce; const int tk = ok ? tok : cs;
        u32x4 xr[8];
#pragma unroll
        for (int r = 0; r < 8; ++r) xr[r] = *(const u32x4*)(XB + (size_t)tk * D + 128 * r + 8 * l16);
        const float rstd = rsqrtf(red16(RS[(size_t)tk * 16 + l16]) * (1.0f / D) + 1e-6f);
        float lg[8];
#pragma unroll
        for (int e = 0; e < 8; ++e) lg[e] = 0.f;
#pragma unroll
        for (int r = 0; r < 8; ++r) {
            const int k0 = 128 * r + 8 * l16;
            float x[8];
#pragma unroll
            for (int j = 0; j < 4; ++j) { x[2 * j] = bf2f(xr[r][j] & 0xffffu); x[2 * j + 1] = bf2f(xr[r][j] >> 16); }
#pragma unroll
            for (int e = 0; e < 8; ++e) {
                const f32x4 w0 = *(const LAS f32x4*)(L + (e * D + k0) * 4), w1 = *(const LAS f32x4*)(L + (e * D + k0 + 4) * 4);
                lg[e] += (x[0] * w0.x + x[1] * w0.y) + (x[2] * w0.z + x[3] * w0.w) + (x[4] * w1.x + x[5] * w1.y) + (x[6] * w1.z + x[7] * w1.w);
            }
        }
#pragma unroll
        for (int e = 0; e < 8; ++e) lg[e] = red16(lg[e]) * rstd + rb[e];
        if (ok) {
#pragma unroll
            for (int r = 0; r < 8; ++r) {
                u32x2 q8;
                q8.x = pk4_i8(bf2f(xr[r][0] & 0xffffu) * I8_XS1, bf2f(xr[r][0] >> 16) * I8_XS1, bf2f(xr[r][1] & 0xffffu) * I8_XS1, bf2f(xr[r][1] >> 16) * I8_XS1);
                q8.y = pk4_i8(bf2f(xr[r][2] & 0xffffu) * I8_XS1, bf2f(xr[r][2] >> 16) * I8_XS1, bf2f(xr[r][3] & 0xffffu) * I8_XS1, bf2f(xr[r][3] >> 16) * I8_XS1);
                *(u32x2*)(F.ws + WS_XQ + (size_t)tk * D + 128 * r + 8 * l16) = q8;
            }
        }
        float v1 = lg[0]; int e1 = 0;
#pragma unroll
        for (int e = 1; e < 8; ++e) if (lg[e] > v1) { v1 = lg[e]; e1 = e; }
        float v2 = -3e38f; int e2 = 0;
#pragma unroll
        for (int e = 0; e < 8; ++e) if (e != e1 && lg[e] > v2) { v2 = lg[e]; e2 = e; }
        if (l16 == 0 && ok) {
            const float g1 = rcpf_(1.0f + __expf(v2 - v1));
            TOPE[tok * 2] = e1; TOPE[tok * 2 + 1] = e2; TOPG[tok * 2] = g1; TOPG[tok * 2 + 1] = 1.0f - g1; RSTD3[tok] = rstd;
            atomicAdd((int*)&hist[e1], 1); atomicAdd((int*)&hist[e2], 1);
        }
    }
    __syncthreads();
    if (F.tid < 8) wsp<int>(F, M_BLKCNT)[F.blk * 8 + F.tid] = hist[F.tid];
    __syncthreads();
}
__device__ __forceinline__ void p_route_b(const Frame& F) {
    int* L = (int*)F.lds;
    const int* BC = wsp<int>(F, M_BLKCNT); const int* TOPE = wsp<int>(F, M_TOPE); int* SLOTOF = wsp<int>(F, M_SLOTOF);
    const int chunk = (NTOK + F.G - 1) / F.G, cs = F.blk * chunk, ce = min(NTOK, cs + chunk), np = (ce > cs ? (ce - cs) * 2 : 0);
    {
        const int e = F.tid & 7, part = F.tid >> 3; int tot = 0, pre = 0;
        for (int bb = part; bb < F.G; bb += 64) { const int c = BC[bb * 8 + e]; if (bb < F.blk) pre += c; tot += c; }
        L[4096 + F.tid] = tot; L[4096 + 512 + F.tid] = pre;
        __syncthreads();
        if (F.tid < 8) { int t2 = 0, p2 = 0; for (int q = 0; q < 64; ++q) { t2 += L[4096 + q * 8 + F.tid]; p2 += L[4096 + 512 + q * 8 + F.tid]; } L[F.tid] = t2; L[8 + F.tid] = p2; }
    }
    __syncthreads();
    if (F.tid == 0) { int ps = 0; for (int e = 0; e < 8; ++e) { L[16 + e] = ps; if (F.blk == 0) wsp<int>(F, M_EXPINF)[e] = ps >> 8; ps += ((L[e] + 255) >> 8) << 8; } if (F.blk == 0) wsp<int>(F, M_EXPINF)[8] = ps >> 8; }
    __syncthreads();
    for (int p = F.tid; p < np; p += NTHR) L[32 + 1024 + p] = TOPE[cs * 2 + p];
    __syncthreads();
    if (F.tid < 8) { int cnt = L[16 + F.tid] + L[8 + F.tid]; for (int p = 0; p < np; ++p) { if (L[32 + 1024 + p] == F.tid) { L[32 + p] = cnt; ++cnt; } } }
    __syncthreads();
    for (int p = F.tid; p < np; p += NTHR) SLOTOF[cs * 2 + p] = L[32 + p];

    int* STOK = wsp<int>(F, M_SLOTTOK);
    for (int p = F.tid; p < np; p += NTHR) {
        const int tok = cs + (p >> 1), slot = L[32 + p];
        STOK[slot] = tok; wsp<float>(F, M_SRSTD)[slot] = wsp<float>(F, M_RSTD3)[tok]; wsp<float>(F, M_SGATE)[slot] = wsp<float>(F, M_TOPG)[cs * 2 + p];
    }
    if (F.blk == 0) {
        for (int e = 0; e < 8; ++e) { const int s0 = L[16 + e] + L[e], s1 = L[16 + e] + (((L[e] + 255) >> 8) << 8); for (int sI = s0 + F.tid; sI < s1; sI += NTHR) STOK[sI] = 0; }
    }
    __syncthreads();
}
__device__ __forceinline__ void p_final(const Frame& F) {
    const bf16* YP = wsp<bf16>(F, WS_XS); const int* SLOTOF = wsp<int>(F, M_SLOTOF); const float* fn = F.in[39];
    const int gw = F.blk * NWAVES + F.wave, NGW = F.G * NWAVES, lane = F.lane;
    for (int tok = gw; tok < NTOK; tok += NGW) {
        const int s1 = SLOTOF[tok * 2], s2 = SLOTOF[tok * 2 + 1];
        f32x4 v[4]; float ss = 0.f;
#pragma unroll
        for (int j = 0; j < 4; ++j) {
            { const u32x2 hb = *((const u32x2*)(wsp<bf16>(F, WS_XB) + (size_t)tok * D) + lane + 64 * j); v[j] = (f32x4){bf2f(hb.x & 0xffffu), bf2f(hb.x >> 16), bf2f(hb.y & 0xffffu), bf2f(hb.y >> 16)}; }
            const u32x2 a = *((const u32x2*)(YP + (size_t)s1 * D) + lane + 64 * j), bq = *((const u32x2*)(YP + (size_t)s2 * D) + lane + 64 * j);
            v[j].x += bf2f(a.x & 0xffffu) + bf2f(bq.x & 0xffffu); v[j].y += bf2f(a.x >> 16) + bf2f(bq.x >> 16); v[j].z += bf2f(a.y & 0xffffu) + bf2f(bq.y & 0xffffu); v[j].w += bf2f(a.y >> 16) + bf2f(bq.y >> 16);
            ss += (v[j].x * v[j].x + v[j].y * v[j].y) + (v[j].z * v[j].z + v[j].w * v[j].w);
        }
        const float rstd = rsqrtf(wave_sum(ss) * (1.0f / D) + 1e-6f);
#pragma unroll
        for (int j = 0; j < 4; ++j) { const f32x4 g = *((const f32x4*)fn + lane + 64 * j); *((f32x4*)(F.out + (size_t)tok * D) + lane + 64 * j) = v[j] * rstd * g; }
    }
}

#define XB_TMO      128
#define XB_XCNT(j)  (256  + 64 * (j))
#define XB_XSUB(j)  (1280 + 64 * (j))
#define XB_XGEN(j)  (2304 + 64 * (j))
#define XB_TOP      3328
#define XB_TOPGEN   3392
#define XCD_BAR_WORDS 3456
#define XB_SPIN_CAP (1u << 18)
constexpr int CW_BAR = 4096;
constexpr int LDS_BARST = LDS_BYTES - 64;
__device__ __forceinline__ unsigned xb_ld(unsigned* p)              { return __hip_atomic_load(p, __ATOMIC_RELAXED, __HIP_MEMORY_SCOPE_AGENT); }
__device__ __forceinline__ unsigned xb_add(unsigned* p, unsigned v) { return __hip_atomic_fetch_add(p, v, __ATOMIC_RELAXED, __HIP_MEMORY_SCOPE_AGENT); }
__device__ __forceinline__ unsigned xb_xcc_id() { return (unsigned)__builtin_amdgcn_s_getreg((3 << 11) | 20) & 0xFu; }
#define XB_SPIN(cond, bar) do { unsigned _sp = 0; while (cond) { __builtin_amdgcn_s_sleep(1); \
    if ((++_sp & 255u) == 0u) { if (xb_ld(&(bar)[XB_TMO])) break; if (_sp > XB_SPIN_CAP) { atomicAdd(&(bar)[XB_TMO], 1u); break; } } } } while (0)
struct XcdBarrier { unsigned* bar; unsigned x; volatile LAS unsigned* st; int wave; };
__device__ __forceinline__ XcdBarrier xcd_barrier_post(unsigned* bar, volatile LAS unsigned* st, int wave) {
    XcdBarrier b; b.bar = bar; b.x = xb_xcc_id(); b.st = st; b.wave = wave;
    if (tid_now(wave) == 0) (void)xb_add(&bar[XB_XCNT(b.x)], 1u);
    return b;
}
__device__ __forceinline__ void xcd_barrier_complete(unsigned* bar, unsigned x, unsigned& nloc, unsigned& nx) {
    const unsigned G = gridDim.x * gridDim.y * gridDim.z;
    unsigned sum, cnt, mine, sp = 0u;
    for (;;) {
        sum = 0u; cnt = 0u; mine = 0u;
#pragma unroll
        for (unsigned j = 0; j < 16; ++j) { const unsigned c = xb_ld(&bar[XB_XCNT(j)]); sum += c; cnt += (c > 0u) ? 1u : 0u; mine = (j == x) ? c : mine; }
        if (sum == G) break;
        __builtin_amdgcn_s_sleep(1);
        if ((++sp & 255u) == 0u) { if (xb_ld(&bar[XB_TMO])) break; if (sp > XB_SPIN_CAP) { atomicAdd(&bar[XB_TMO], 1u); break; } }
    }
    nloc = mine > 0u ? mine : 1u; nx = cnt > 0u ? cnt : 1u;
}
__device__ __forceinline__ void xcd_barrier(const XcdBarrier& b) {
    asm volatile("s_waitcnt vmcnt(0)" ::: "memory");
    __syncthreads();
    if (tid_now(b.wave) == 0) {
        unsigned* bar = b.bar;
        __builtin_amdgcn_s_waitcnt(0);
        unsigned nloc = b.st[0], nx = b.st[1];
        if (nloc == 0u) { xcd_barrier_complete(bar, b.x, nloc, nx); b.st[0] = nloc; b.st[1] = nx; }
        const unsigned old = xb_add(&bar[XB_XSUB(b.x)], 1u);
        const unsigned gen = old / nloc;
        if (old + 1u == (gen + 1u) * nloc) {
            __builtin_amdgcn_fence(__ATOMIC_RELEASE, "agent");
            asm volatile("s_waitcnt vmcnt(0)" ::: "memory");
            const unsigned og = xb_add(&bar[XB_TOP], 1u);
            const unsigned tg = og / nx;
            if (og + 1u == (tg + 1u) * nx) xb_add(&bar[XB_TOPGEN], 1u);
            else XB_SPIN(xb_ld(&bar[XB_TOPGEN]) == tg, bar);
            __builtin_amdgcn_fence(__ATOMIC_ACQUIRE, "agent");
            xb_add(&bar[XB_XGEN(b.x)], 1u);
            asm volatile("s_waitcnt vmcnt(0)" ::: "memory");
        } else {
            XB_SPIN(xb_ld(&bar[XB_XGEN(b.x)]) == gen, bar);
            __builtin_amdgcn_fence(__ATOMIC_ACQUIRE, "agent");
            asm volatile("s_waitcnt vmcnt(0)" ::: "memory");
        }
    }
    __syncthreads();
}

constexpr int N_PHASES = 16;
#ifndef MK_ONE_LAUNCH
#define MK_ONE_LAUNCH 1
#endif
__global__ void __launch_bounds__(NTHR, 2) mk_fwd(Args args) {
    extern __shared__ __attribute__((aligned(16))) unsigned char lds[];
    Frame F; F.lds = lds; F.ws = args.ws; F.in = args.in; F.out = args.out;
    F.tid = threadIdx.x; F.lane = F.tid & 63; F.wave = __builtin_amdgcn_readfirstlane(F.tid >> 6); F.G = gridDim.x; F.blk = blockIdx.x;
    const int lo = args.ph_lo, hi = args.ph_hi;
    XcdBarrier bar; bar.bar = (unsigned*)(args.ws + WS_CTL) + CW_BAR + args.li * XCD_BAR_WORDS; bar.x = 0; bar.st = nullptr; bar.wave = F.wave;
    {
        if (F.tid < 16) ((LAS unsigned*)lds)[LDS_BARST / 4 + F.tid] = 0u;
        __syncthreads();
        bar = xcd_barrier_post((unsigned*)(args.ws + WS_CTL) + CW_BAR + args.li * XCD_BAR_WORDS, (volatile LAS unsigned*)((LAS unsigned char*)lds + LDS_BARST), F.wave);
    }
#ifndef REPEAT_MASK
#define REPEAT_MASK 0u
#endif
#define NREP(k) ((((REPEAT_MASK) >> (k)) & 1u) ? 2 : 1)
#define PH_ENTER() do { int t_ = tid_now(F.wave); asm volatile("" : "+v"(t_)); F.tid = t_; F.lane = t_ & 63; } while (0)
#define SEAM(k) do { if (IN(k) && IN((k) + 1)) xcd_barrier(bar); } while (0)
#if defined(SKIP_PH)
#define IN(k) ((k) != SKIP_PH && lo <= (k) && (k) < hi)
#elif defined(ONLY_PH)
#define IN(k) ((k) == ONLY_PH && lo <= (k) && (k) < hi)
#else
#define IN(k) (lo <= (k) && (k) < hi)
#endif
    PH_ENTER();
    for (int rep_ = 0; rep_ < NREP(0); ++rep_) if (IN(0)) p0_prologue(F);
    SEAM(0);
    PH_ENTER();
    for (int rep_ = 0; rep_ < NREP(1); ++rep_) if (IN(1)) {
        Gemm g = std_gemm((const bf16*)(F.ws + WS_XQI), (const bf16*)(F.ws + WT_IN0), D / 2); StdOrder S; S.init(NTOK / 256, IN0 / 256, F.G, F.blk, 256L * D, 256L * D);
        EpiBf16T<true> E{wsp<bf16>(F, WS_PB), IN0, wsp<float>(F, M_RSTD0), nullptr, 4, fill_rs_lds(F.lds, S, nullptr, wsp<float>(F, M_RSTD0), F.tid), 1.0f / I8_WS};
        pg8::gemm_phase<EpiBf16T<true>, StdOrder, true, false, true, true>(F.wave, (LAS unsigned char*)F.lds, g, S, E);
    }
    SEAM(1);
    PH_ENTER();
    for (int rep_ = 0; rep_ < NREP(2); ++rep_) if (IN(2)) { p_lora(F); xcd_barrier(bar); p_mix0(F); }
    SEAM(2);
    PH_ENTER();
    for (int rep_ = 0; rep_ < NREP(3); ++rep_) if (IN(3)) {
        Gemm g = std_gemm(wsp<bf16>(F, WS_YB), wsp<bf16>(F, WT_OUT0), D); StdOrder S; S.init(NTOK / 256, D / 256, F.G, F.blk, 256L * D * 2, 256L * D * 2);
        EpiResBT<true, false, (long)WS_XQ0 - (long)WS_XB> E{wsp<bf16>(F, WS_XB), wsp<float>(F, M_RS), 1.0f};
        gemm_run<3, EpiResBT<true, false, (long)WS_XQ0 - (long)WS_XB>, StdOrder>(F, g, S, E);
    }
    SEAM(3);
    PH_ENTER();
    for (int rep_ = 0; rep_ < NREP(4); ++rep_) if (IN(4)) {
        Gemm g = std_gemm((const bf16*)(F.ws + WS_XQ0), (const bf16*)(F.ws + WT_GU0), D / 2); StdOrder S; S.init(NTOK / 256, 2 * FFN / 256, F.G, F.blk, 256L * D, 256L * D);
        EpiGU8<FFN, -1, true> E{F.ws + WS_PB, fill_rs_lds(F.lds, S, wsp<float>(F, M_RS), nullptr, F.tid), 1.0f / (I8_XS * I8_WS)};
        pg8::gemm_phase<EpiGU8<FFN, -1, true>, StdOrder, true, false, true, true>(F.wave, (LAS unsigned char*)F.lds, g, S, E);
    }
    SEAM(4);
    PH_ENTER();
    for (int rep_ = 0; rep_ < NREP(5); ++rep_) if (IN(5)) {
        Gemm g = std_gemm((const bf16*)(F.ws + WS_PB), (const bf16*)(F.ws + WT_DN0), FFN / 2); StdOrder S; S.init(NTOK / 256, D / 256, F.G, F.blk, 256L * FFN, 256L * FFN);
        EpiResBT<true, true, (long)WS_XQI - (long)WS_XB> E{wsp<bf16>(F, WS_XB), wsp<float>(F, M_RS), 1.0f / (F8_HS * F8_WS)};
        pg8::gemm_phase<EpiResBT<true, true, (long)WS_XQI - (long)WS_XB>, StdOrder, true, false, true>(F.wave, (LAS unsigned char*)F.lds, g, S, E);
    }
    SEAM(5);
    PH_ENTER();
    for (int rep_ = 0; rep_ < NREP(6); ++rep_) if (IN(6)) {
        Gemm g = std_gemm((const bf16*)(F.ws + WS_XQI), (const bf16*)(F.ws + WT_IN1), D / 2); StdOrder S; S.init(NTOK / 256, IN1P / 256, F.G, F.blk, 256L * D, 256L * D);
        EpiBf16T<true> E{wsp<bf16>(F, WS_PB), IN1P, nullptr, wsp<float>(F, M_RS), 0, fill_rs_lds(F.lds, S, wsp<float>(F, M_RS), nullptr, F.tid), 1.0f / (I8_XS * I8_WS)};
        pg8::gemm_phase<EpiBf16T<true>, StdOrder, true, false, true, true>(F.wave, (LAS unsigned char*)F.lds, g, S, E);
    }
    SEAM(6);
    PH_ENTER();
    for (int rep_ = 0; rep_ < NREP(7); ++rep_) if (IN(7)) p_nsa_prep(F);
    SEAM(7);
    PH_ENTER();
    for (int rep_ = 0; rep_ < NREP(9); ++rep_) if (IN(9)) {
#ifdef ATTN_NAIVE
        p_attn_naive(F);
#else
        nsa::p_attn(F);
#endif
    }
    SEAM(9);
    PH_ENTER();
    for (int rep_ = 0; rep_ < NREP(10); ++rep_) if (IN(10)) {
        Gemm g = std_gemm(wsp<bf16>(F, WS_YB), wsp<bf16>(F, WT_OUT1), D); StdOrder S; S.init(NTOK / 256, D / 256, F.G, F.blk, 256L * D * 2, 256L * D * 2);
        EpiResB E{wsp<bf16>(F, WS_XB), wsp<float>(F, M_RS), 1.0f};
        gemm_run<10, EpiResB, StdOrder>(F, g, S, E);
    }
    SEAM(10);
    PH_ENTER();
    for (int rep_ = 0; rep_ < NREP(11); ++rep_) if (IN(11)) p_route_a(F);
    SEAM(11);
    PH_ENTER();
    for (int rep_ = 0; rep_ < NREP(12); ++rep_) if (IN(12)) p_route_b(F);
    SEAM(12);
    PH_ENTER();
    for (int rep_ = 0; rep_ < NREP(13); ++rep_) if (IN(13)) {
        Gemm g = std_gemm((const bf16*)(F.ws + WS_XQ), (const bf16*)(F.ws + WT_GU1), D / 2); MoeOrder S; S.init(wsp<int>(F, M_EXPINF), 2 * EXPD / 256, F.G, F.blk, 256L * D, 256L * D, 2L * EXPD * D);
        EpiGU8<AP8, EXPD / 128 - 1, true> E{F.ws + WS_ACTM, fill_rs_lds(F.lds, S, nullptr, wsp<float>(F, M_SRSTD), F.tid, 131072 + 14336), 1.0f / (I8_XS1 * I8_WS)};
        LAS int* rmap = (LAS int*)((LAS unsigned char*)F.lds + 131072);
        { Unit u; const int* STOK = wsp<int>(F, M_SLOTTOK);
          for (int i = F.wave; i < 14 && S.next(i, u); i += NWAVES) {
#pragma unroll
              for (int rr = 0; rr < 4; ++rr) rmap[i * 256 + F.lane + 64 * rr] = STOK[u.pm * 256 + F.lane + 64 * rr]; }
          __syncthreads(); }
        pg8::gemm_phase<EpiGU8<AP8, EXPD / 128 - 1, true>, MoeOrder, true, true, true, true>(F.wave, (LAS unsigned char*)F.lds, g, S, E, rmap);
    }
    SEAM(13);
    PH_ENTER();
    for (int rep_ = 0; rep_ < NREP(14); ++rep_) if (IN(14)) {
        Gemm g = std_gemm((const bf16*)(F.ws + WS_ACTM), (const bf16*)(F.ws + WT_DN1), AP8 / 2); MoeOrder S; S.init(wsp<int>(F, M_EXPINF), D / 256, F.G, F.blk, 256L * AP8, 256L * AP8, (long)D * AP8);
        EpiScale E{wsp<bf16>(F, WS_XS), D, wsp<float>(F, M_SGATE), fill_rs_lds(F.lds, S, nullptr, wsp<float>(F, M_SGATE), F.tid), 1.0f / (F8_HS * F8_WS)};
        pg8::gemm_phase<EpiScale, MoeOrder, true, false, true>(F.wave, (LAS unsigned char*)F.lds, g, S, E);
    }
    SEAM(14);
    PH_ENTER();
    for (int rep_ = 0; rep_ < NREP(15); ++rep_) if (IN(15)) p_final(F);
#undef IN
}

extern "C" void kernel_launch(void* const* d_in, const int* in_sizes, int n_in, void* d_out, int out_size, void* d_ws, size_t ws_size, hipStream_t stream) {
    static int grid = 0;
    if (grid == 0) {
        if (n_in != 40 || out_size != NTOK * D || ws_size < WS_END) { fprintf(stderr, "kernel_launch: unexpected shapes (n_in %d out %d ws %zu)\n", n_in, out_size, ws_size); grid = -1; return; }
        int dev = 0, cus = 0, per_cu = 0;
        if (hipGetDevice(&dev) != hipSuccess || hipDeviceGetAttribute(&cus, hipDeviceAttributeMultiprocessorCount, dev) != hipSuccess) { grid = -1; return; }
        if (hipFuncSetAttribute((const void*)mk_fwd, hipFuncAttributeMaxDynamicSharedMemorySize, LDS_BYTES) != hipSuccess) { fprintf(stderr, "kernel_launch: hipFuncSetAttribute failed\n"); grid = -1; return; }
        if (hipOccupancyMaxActiveBlocksPerMultiprocessor(&per_cu, (const void*)mk_fwd, NTHR, LDS_BYTES) != hipSuccess || per_cu < 1) per_cu = 1;
        (void)hipGetLastError();
        grid = cus;
        if (grid > 1024) grid = 1024;
    }
    if (grid < 0) return;
    (void)hipMemsetAsync((char*)d_ws + WS_CTL, 0, CTL_ZERO_BYTES, stream);
    Args a{};
    for (int i = 0; i < 40; ++i) a.in[i] = (const float*)d_in[i];
    a.out = (float*)d_out; a.ws = (unsigned char*)d_ws;
#if defined(PROBE_PH)
    { const int cuts[5] = {0, PROBE_PH, PROBE_PH + 1, PROBE_PH + 1, N_PHASES}; const int los[4] = {0, PROBE_PH, PROBE_PH, PROBE_PH + 1};
      for (int li = 0; li < 4; ++li) { a.ph_lo = los[li]; a.ph_hi = (li == 0) ? PROBE_PH : (li == 3 ? N_PHASES : PROBE_PH + 1); a.li = li; (void)cuts; if (a.ph_hi > a.ph_lo) hipLaunchKernelGGL(mk_fwd, dim3(grid), dim3(NTHR), LDS_BYTES, stream, a); } }
#elif MK_ONE_LAUNCH
    a.ph_lo = 0; a.ph_hi = N_PHASES;
    hipLaunchKernelGGL(mk_fwd, dim3(grid), dim3(NTHR), LDS_BYTES, stream, a);
#else
    for (int ph = 0; ph < N_PHASES; ++ph) {
        a.ph_lo = ph; a.ph_hi = ph + 1;
        hipLaunchKernelGGL(mk_fwd, dim3(grid), dim3(NTHR), LDS_BYTES, stream, a);
    }
#endif
}
```

```cpp
#include <hip/hip_runtime.h>
#include <cstdio>
#include <cstdint>

#define LAS __attribute__((address_space(3)))
typedef unsigned short bf16;
typedef float f32x4 __attribute__((ext_vector_type(4)));
typedef float f32x2 __attribute__((ext_vector_type(2)));
typedef unsigned u32x4 __attribute__((ext_vector_type(4)));
typedef unsigned u32x2 __attribute__((ext_vector_type(2)));
typedef short bf16x8 __attribute__((ext_vector_type(8)));

constexpr int D = 1024, BATCH = 16, SEQ = 2048, NTOK = BATCH * SEQ;
constexpr int IN0 = 2816, IN1 = 2840, IN1P = 3072, FFN = 2816, EXPD = 1408, NEXP = 8;
constexpr int MAXSLOT = NTOK * 2 + NEXP * 256;
constexpr int NWAVES = 8, NTHR = 512;
constexpr int LDS_BYTES = 163840;
constexpr int C_Q = 0, C_KC = 512, C_VC = 640, C_KS = 768, C_VS = 896, C_KW = 1024, C_VW = 1152, C_BG = 1280, C_CG = 1792, C_HD = 2304, C_GL = 2816;

constexpr size_t MiB = (size_t)1 << 20;
constexpr size_t WS_CTL = 0, CTL_ZERO_BYTES = 1 * MiB;
constexpr size_t WT_IN0 = 1 * MiB;
constexpr size_t WT_OUT0 = WT_IN0 + (size_t)IN0 * D * 2;
constexpr size_t WT_GU0 = WT_OUT0 + (size_t)D * D * 2;
constexpr size_t WT_DN0 = WT_GU0 + (size_t)2 * FFN * D * 2;
constexpr size_t WT_IN1 = WT_DN0 + (size_t)D * FFN * 2;
constexpr size_t WT_OUT1 = WT_IN1 + (size_t)IN1P * D * 2;
constexpr size_t WT_GU1 = WT_OUT1 + (size_t)D * D * 2;
constexpr size_t WT_DN1 = WT_GU1 + (size_t)NEXP * 2 * EXPD * D * 2;
constexpr size_t WT_CK1 = WT_DN1 + (size_t)NEXP * D * EXPD * 2;
constexpr size_t WT_CV1 = WT_CK1 + (size_t)256 * 2048 * 2;
constexpr size_t WT_CK2 = WT_CV1 + (size_t)256 * 2048 * 2;
constexpr size_t WT_CV2 = WT_CK2 + (size_t)64 * 256 * 2;
constexpr size_t WT_SGU = WT_CV2 + (size_t)64 * 256 * 2;
constexpr size_t WT_W2 = WT_SGU + (size_t)4 * 128 * 128 * 2;
constexpr size_t WT_A2 = WT_W2 + (size_t)512 * 64 * 2;
constexpr size_t WT_G2 = WT_A2 + (size_t)512 * 64 * 2;
constexpr size_t W_END = WT_G2 + (size_t)512 * 128 * 2;
static_assert(W_END <= 104 * MiB, "weights region");
constexpr size_t M_RS = 104 * MiB;
constexpr size_t M_RSTD0 = M_RS + 2 * MiB;
constexpr size_t M_ROPE = M_RSTD0 + 128 * 1024;
constexpr size_t M_C1 = M_ROPE + 128 * 1024;
constexpr size_t M_WR = M_C1 + 4 * 1024;
constexpr size_t M_KCMP = M_WR + 32 * 1024;
constexpr size_t M_VCMP = M_KCMP + 512 * 1024;
constexpr size_t M_HID = M_VCMP + 512 * 1024;
constexpr size_t M_TOPE = M_HID + 4 * MiB;
constexpr size_t M_TOPG = M_TOPE + 256 * 1024;
constexpr size_t M_RSTD3 = M_TOPG + 256 * 1024;
constexpr size_t M_BLKCNT = M_RSTD3 + 128 * 1024;
constexpr size_t M_SLOTOF = M_BLKCNT + 32 * 1024;
constexpr size_t M_SRSTD = M_SLOTOF + 256 * 1024;
constexpr size_t M_SGATE = M_SRSTD + 272 * 1024;
constexpr size_t M_EXPINF = M_SGATE + 272 * 1024;
constexpr size_t M_SLOTTOK = M_EXPINF + 4096;
static_assert(M_SLOTTOK + 272 * 1024 <= 120 * MiB, "misc region");
constexpr size_t WS_XB = 120 * MiB;
constexpr size_t WS_YB = 184 * MiB;
constexpr size_t WS_PB = 248 * MiB;
constexpr size_t WS_QROT = 441 * MiB;
constexpr size_t WS_XS = 184 * MiB;
constexpr size_t WS_ACTM = 316 * MiB;
constexpr size_t WS_XQ = 420 * MiB;
constexpr size_t WS_XQ0 = 336 * MiB;
static_assert(WS_PB + (size_t)NTOK * FFN <= WS_XQ0 && WS_XQ0 + (size_t)NTOK * D <= WS_PB + (size_t)NTOK * IN1P * 2, "ws map int8");
constexpr int AP8 = 1536;
constexpr size_t WS_XQI = WS_YB;
constexpr float I8_XS = 127.0f / 6.0f, I8_XS1 = 127.0f / 7.0f, I8_WS = 127.0f / 0.14f;
constexpr float F8_XS = 4.0f, F8_WS = 32.0f, F8_HS = 4.0f;
constexpr size_t WS_END = 498 * MiB;
static_assert(WS_ACTM + (size_t)MAXSLOT * AP8 <= WS_XQ && WS_XQ + (size_t)NTOK * D <= WS_END, "ws map fp8");
static_assert(WS_PB + (size_t)(NTOK + 64) * IN1P * 2 <= WS_QROT && WS_QROT + (size_t)NTOK * 512 * 2 <= 473 * MiB, "ws map");
static_assert(WS_XS + (size_t)MAXSLOT * D * 2 <= WS_ACTM && WS_ACTM + (size_t)MAXSLOT * EXPD * 2 <= WS_END, "ws map moe");

__device__ __forceinline__ float bf2f(unsigned b) { return __uint_as_float(b << 16); }
__device__ __forceinline__ unsigned f2bf(float f) { unsigned u = __float_as_uint(f); return (u + 0x7fffu + ((u >> 16) & 1u)) >> 16; }
typedef __bf16 bf16x2_hw __attribute__((ext_vector_type(2)));
__device__ __forceinline__ unsigned pk2(float lo, float hi) { f32x2 v = {lo, hi}; bf16x2_hw b = __builtin_convertvector(v, bf16x2_hw); return __builtin_bit_cast(unsigned, b); }
__device__ __forceinline__ unsigned pk4_f8(float a, float b, float c, float d) { int w = __builtin_amdgcn_cvt_pk_fp8_f32(a, b, 0, false); w = __builtin_amdgcn_cvt_pk_fp8_f32(c, d, w, true); return (unsigned)w; }
__device__ __forceinline__ unsigned pk4_i8(float a, float b, float c, float d) {
    const float M = 12582912.0f;
    const unsigned ua = __float_as_uint(__builtin_amdgcn_fmed3f(a, -127.0f, 127.0f) + M), ub = __float_as_uint(__builtin_amdgcn_fmed3f(b, -127.0f, 127.0f) + M), uc = __float_as_uint(__builtin_amdgcn_fmed3f(c, -127.0f, 127.0f) + M), ud = __float_as_uint(__builtin_amdgcn_fmed3f(d, -127.0f, 127.0f) + M);
    return (ua & 0xffu) | ((ub & 0xffu) << 8) | ((uc & 0xffu) << 16) | (ud << 24);
}
__device__ __forceinline__ float rcpf_(float x) { return __builtin_amdgcn_rcpf(x); }
__device__ __forceinline__ float sigmoidf_(float x) { return rcpf_(1.0f + __expf(-x)); }
__device__ __forceinline__ float gelu_tanh(float x) { const float u = 1.5957691216057308f * (x + 0.044715f * x * x * x); return x * rcpf_(1.0f + __expf(-u)); }
__device__ __forceinline__ float silu_(float x) { return x * rcpf_(1.0f + __expf(-x)); }
template <int CTRL> __device__ __forceinline__ float dpp_f(float v) { return __builtin_bit_cast(float, __builtin_amdgcn_update_dpp(0, __builtin_bit_cast(int, v), CTRL, 0xF, 0xF, true)); }
__device__ __forceinline__ float red16(float v) { v += dpp_f<0xB1>(v); v += dpp_f<0x4E>(v); v += dpp_f<0x141>(v); v += dpp_f<0x140>(v); return v; }
__device__ __forceinline__ float wave_sum(float v) {
    v = red16(v);
    { auto r = __builtin_amdgcn_permlane16_swap(__float_as_uint(v), __float_as_uint(v), false, false); v = __uint_as_float(r[0]) + __uint_as_float(r[1]); }
    { auto r = __builtin_amdgcn_permlane32_swap(__float_as_uint(v), __float_as_uint(v), false, false); v = __uint_as_float(r[0]) + __uint_as_float(r[1]); }
    return v;
}
__device__ __forceinline__ float sum_rows4(float v) {
    { auto r = __builtin_amdgcn_permlane16_swap(__float_as_uint(v), __float_as_uint(v), false, false); v = __uint_as_float(r[0]) + __uint_as_float(r[1]); }
    { auto r = __builtin_amdgcn_permlane32_swap(__float_as_uint(v), __float_as_uint(v), false, false); v = __uint_as_float(r[0]) + __uint_as_float(r[1]); }
    return v;
}
__device__ __forceinline__ float wave_max(float v) {
#pragma unroll
    for (int o = 1; o < 64; o <<= 1) v = fmaxf(v, __shfl_xor(v, o));
    return v;
}
__device__ __forceinline__ int lane_now() { int l; asm volatile("v_mbcnt_lo_u32_b32 %0, -1, 0\n\tv_mbcnt_hi_u32_b32 %0, -1, %0" : "=v"(l)); return l; }
__device__ __forceinline__ int lane_after(float dep) { int l; asm volatile("v_mbcnt_lo_u32_b32 %0, -1, 0\n\tv_mbcnt_hi_u32_b32 %0, -1, %0" : "=&v"(l) : "v"(dep)); return l; }
__device__ __forceinline__ int tid_now(int wave) { return (wave << 6) | lane_now(); }
#define LDS_FENCE() asm volatile("s_waitcnt lgkmcnt(0)" ::: "memory")

struct Args { const float* in[40]; float* out; unsigned char* ws; int ph_lo, ph_hi, li, pad; };
struct Frame {
    unsigned char* lds; unsigned char* ws; const float* const* in; float* out;
    int tid, lane, wave, G, blk;
};
template <class T> __device__ __forceinline__ T* wsp(const Frame& F, size_t off) { return (T*)(F.ws + off); }

typedef int i32x4_ __attribute__((ext_vector_type(4)));
struct Unit { int pm, pn, idx; long aoff, boff; };
struct Gemm { const bf16* A; const bf16* Bt; int K; unsigned a_row, a_half, a_k, b_row, b_half, b_k; };
__device__ __forceinline__ Gemm std_gemm(const bf16* A, const bf16* Bt, int K) {
    Gemm g; g.A = A; g.Bt = Bt; g.K = K; g.a_row = K * 2; g.a_half = 128 * K * 2; g.a_k = 128; g.b_row = K * 2; g.b_half = 128 * K * 2; g.b_k = 128; return g;
}
constexpr int NXCD = 8, WGM = 8;
struct StdOrder {
    int nM, nN, nwg, G, c; long a_tile, b_tile;
    __device__ __forceinline__ void init(int nM_, int nN_, int G_, int c_, long a_tile_, long b_tile_) { nM = nM_; nN = nN_; nwg = nM * nN; G = G_; c = c_; a_tile = a_tile_; b_tile = b_tile_; }
    __device__ __forceinline__ bool tile(int i, int& pm, int& pn) const {
        const int L = i * G + c; if (L >= nwg) return false;
        int wgid = L; { const int q = nwg / NXCD, r = nwg % NXCD, xcd = wgid % NXCD, off = wgid / NXCD; wgid = (xcd < r ? xcd * (q + 1) : r * (q + 1) + (xcd - r) * q) + off; }
        const int nig = WGM * nN, gid = wgid / nig, fm = gid * WGM, gsz = (nM - fm) < WGM ? (nM - fm) : WGM;
        pm = fm + ((wgid % nig) % gsz); pn = (wgid % nig) / gsz; return true;
    }
    __device__ __forceinline__ bool next(int i, Unit& u) const { if (!tile(i, u.pm, u.pn)) return false; u.idx = i; u.aoff = u.pm * a_tile; u.boff = u.pn * b_tile; return true; }
};
struct MoeOrder {
    StdOrder so; const int* ei; long exp_bytes;
    __device__ __forceinline__ void init(const int* expinf, int nN, int G, int c, long a_tile, long b_tile, long exp_bytes_) {
        ei = expinf; so.init(__builtin_amdgcn_readfirstlane(expinf[8]), nN, G, c, a_tile, b_tile); exp_bytes = exp_bytes_;
    }
    __device__ __forceinline__ bool next(int i, Unit& u) const {
        if (!so.tile(i, u.pm, u.pn)) return false;
        u.idx = i;
        const int pm = u.pm; const int e = __builtin_amdgcn_readfirstlane((pm >= ei[1]) + (pm >= ei[2]) + (pm >= ei[3]) + (pm >= ei[4]) + (pm >= ei[5]) + (pm >= ei[6]) + (pm >= ei[7]));
        u.aoff = pm * so.a_tile; u.boff = e * exp_bytes + u.pn * so.b_tile; return true;
    }
};
struct CmpOrder {
    int G, c;
    __device__ __forceinline__ bool next(int i, Unit& u) const {
        const int L = i * G + c; if (L >= 32) return false;
        const int which = L >> 4, b = L & 15; u.pm = L; u.pn = 0; u.idx = i;
        u.aoff = ((long)b * SEQ * IN1P + (which ? C_VC : C_KC)) * 2; u.boff = (long)which * 256 * 2048 * 2; return true;
    }
};

typedef f32x4 Acc[2][2][4][2];

__device__ __forceinline__ float rstd_from_partials(const float* RS, int row) {
    const f32x4* p = (const f32x4*)(RS + (size_t)row * 16);
    const f32x4 a = p[0], b = p[1], c = p[2], d = p[3];
    const float s = ((a.x + a.y) + (a.z + a.w)) + ((b.x + b.y) + (b.z + b.w)) + ((c.x + c.y) + (c.z + c.w)) + ((d.x + d.y) + (d.z + d.w));
    return rsqrtf(s * (1.0f / D) + 1e-6f);
}

template <class Sched>
__device__ __forceinline__ LAS float* fill_rs_lds(unsigned char* lds, const Sched& S, const float* rs_partial, const float* direct, int tid, int off = 131072) {
    LAS float* t = (LAS float*)((LAS unsigned char*)lds + off);
    Unit u; const int wv = tid >> 6, ln = tid & 63;
    for (int i = wv; i < 14 && S.next(i, u); i += NWAVES) {
#pragma unroll
        for (int rr = 0; rr < 4; ++rr) { const int row = ln + 64 * rr; t[i * 256 + row] = direct ? direct[u.pm * 256 + row] : rstd_from_partials(rs_partial, u.pm * 256 + row); }
    }
    __syncthreads();
    return t;
}
template <bool IACC>
struct EpiBf16T {
    static constexpr bool PERM = true;
    bf16* out; int ldc; const float* rstd_direct; const float* rs_partial; int gelu_tiles; const LAS float* rs_lds; float mul;
    __device__ __forceinline__ void operator()(const Acc& acc, const Unit& u, int wr, int wc, int fr, int fq) const {
        const int col0 = u.pn * 256 + wc * 32 + 8 * fq; const bool gel = u.pn < gelu_tiles;
#pragma unroll
        for (int ai = 0; ai < 2; ++ai)
#pragma unroll
            for (int m = 0; m < 4; ++m) {
                const int row = u.pm * 256 + ai * 128 + wr * 64 + m * 16 + fr;
                const float rs = rs_lds ? rs_lds[u.idx * 256 + ai * 128 + wr * 64 + m * 16 + fr] : (rstd_direct ? rstd_direct[row] : rstd_from_partials(rs_partial, row));
#pragma unroll
                for (int bj = 0; bj < 2; ++bj) {
                    f32x4 v0, v1;
                    if constexpr (IACC) { const float rq = rs * mul; v0 = __builtin_convertvector(__builtin_bit_cast(i32x4_, acc[ai][bj][m][0]), f32x4) * rq; v1 = __builtin_convertvector(__builtin_bit_cast(i32x4_, acc[ai][bj][m][1]), f32x4) * rq; }
                    else { v0 = acc[ai][bj][m][0] * rs; v1 = acc[ai][bj][m][1] * rs; }
                    if (gel) {
#pragma unroll
                        for (int i = 0; i < 4; ++i) { v0[i] = gelu_tanh(v0[i]); v1[i] = gelu_tanh(v1[i]); }
                    }
                    u32x4 w; w.x = pk2(v0[0], v0[1]); w.y = pk2(v0[2], v0[3]); w.z = pk2(v1[0], v1[1]); w.w = pk2(v1[2], v1[3]);
                    *(u32x4*)(out + (size_t)row * ldc + col0 + bj * 128) = w;
                }
            }
    }
};
typedef EpiBf16T<false> EpiBf16;
struct EpiGU {
    static constexpr bool PERM = true;
    bf16* out; int ldc; const float* rstd_direct; const float* rs_partial; const LAS float* rs_lds;
    __device__ __forceinline__ void operator()(const Acc& acc, const Unit& u, int wr, int wc, int fr, int fq) const {
        const int col0 = (u.pn * 256 + wc * 32 + 8 * fq) >> 1;
#pragma unroll
        for (int ai = 0; ai < 2; ++ai)
#pragma unroll
            for (int m = 0; m < 4; ++m) {
                const int row = u.pm * 256 + ai * 128 + wr * 64 + m * 16 + fr;
                const float rs = rs_lds ? rs_lds[u.idx * 256 + ai * 128 + wr * 64 + m * 16 + fr] : (rstd_direct ? rstd_direct[row] : rstd_from_partials(rs_partial, row));
#pragma unroll
                for (int bj = 0; bj < 2; ++bj) {
                    const f32x4 g = acc[ai][bj][m][0] * rs, up = acc[ai][bj][m][1] * rs;
                    f32x2 e0 = (f32x2){g[0], g[1]} * (-1.4426950408889634f), e1 = (f32x2){g[2], g[3]} * (-1.4426950408889634f);
                    e0.x = __builtin_amdgcn_exp2f(e0.x); e0.y = __builtin_amdgcn_exp2f(e0.y); e1.x = __builtin_amdgcn_exp2f(e1.x); e1.y = __builtin_amdgcn_exp2f(e1.y);
                    e0 = e0 + 1.0f; e1 = e1 + 1.0f;
                    e0.x = __builtin_amdgcn_rcpf(e0.x); e0.y = __builtin_amdgcn_rcpf(e0.y); e1.x = __builtin_amdgcn_rcpf(e1.x); e1.y = __builtin_amdgcn_rcpf(e1.y);
                    const f32x2 o0 = ((f32x2){g[0], g[1]} * (f32x2){up[0], up[1]}) * e0, o1 = ((f32x2){g[2], g[3]} * (f32x2){up[2], up[3]}) * e1;
                    u32x2 w; w.x = pk2(o0.x, o0.y); w.y = pk2(o1.x, o1.y);
                    *(u32x2*)(out + (size_t)row * ldc + col0 + bj * 64) = w;
                }
            }
    }
};
struct EpiRes {
    static constexpr bool PERM = false;
    const float* base; float* H; bf16* XB; float* RS;
    __device__ __forceinline__ void operator()(const Acc& acc, const Unit& u, int wr, int wc, int fr, int fq) const {
        const int col0 = u.pn * 256 + wc * 32 + 4 * fq;
#pragma unroll
        for (int ai = 0; ai < 2; ++ai)
#pragma unroll
            for (int m = 0; m < 4; ++m) {
                const int row = u.pm * 256 + ai * 128 + wr * 64 + m * 16 + fr; float ss = 0.f;
#pragma unroll
                for (int bj = 0; bj < 2; ++bj)
#pragma unroll
                    for (int n = 0; n < 2; ++n) {
                        const size_t off = (size_t)row * D + col0 + bj * 128 + n * 16;
                        const f32x4 o = *(const f32x4*)(base + off) + acc[ai][bj][m][n];
                        *(f32x4*)(H + off) = o; u32x2 w; w.x = pk2(o[0], o[1]); w.y = pk2(o[2], o[3]); *(u32x2*)(XB + off) = w;
                        ss += (o[0] * o[0] + o[1] * o[1]) + (o[2] * o[2] + o[3] * o[3]);
                    }
                ss = sum_rows4(ss);
                if (fq == 0) RS[(size_t)row * 16 + u.pn * 4 + wc] = ss;
            }
    }
};
template <int PITCH, int PAD_PN, bool IACC = false>
struct EpiGU8 {
    static constexpr bool PERM = true;
    unsigned char* out; const LAS float* rs_lds; float mul;
    __device__ __forceinline__ void operator()(const Acc& acc, const Unit& u, int wr, int wc, int fr, int fq) const {
        const int col0 = u.pn * 128 + wc * 32 + 8 * fq;
#pragma unroll
        for (int ai = 0; ai < 2; ++ai)
#pragma unroll
            for (int m = 0; m < 4; ++m) {
                const int row = u.pm * 256 + ai * 128 + wr * 64 + m * 16 + fr;
                const float rs = rs_lds[u.idx * 256 + ai * 128 + wr * 64 + m * 16 + fr] * mul;
                u32x2 w;
#pragma unroll
                for (int bj = 0; bj < 2; ++bj) {
                    f32x4 g, up;
                    if constexpr (IACC) { const i32x4_ g_ = __builtin_bit_cast(i32x4_, acc[ai][bj][m][0]), u_ = __builtin_bit_cast(i32x4_, acc[ai][bj][m][1]); g = __builtin_convertvector(g_, f32x4) * rs; up = __builtin_convertvector(u_, f32x4) * rs; }
                    else { g = acc[ai][bj][m][0] * rs; up = acc[ai][bj][m][1] * rs; }
                    f32x2 e0 = (f32x2){g[0], g[1]} * (-1.4426950408889634f), e1 = (f32x2){g[2], g[3]} * (-1.4426950408889634f);
                    e0.x = __builtin_amdgcn_exp2f(e0.x); e0.y = __builtin_amdgcn_exp2f(e0.y); e1.x = __builtin_amdgcn_exp2f(e1.x); e1.y = __builtin_amdgcn_exp2f(e1.y);
                    e0 = e0 + 1.0f; e1 = e1 + 1.0f;
                    { const float r0_ = __builtin_amdgcn_rcpf(e0.x * e0.y), r1_ = __builtin_amdgcn_rcpf(e1.x * e1.y);
                      e0 = (f32x2){e0.y, e0.x} * r0_; e1 = (f32x2){e1.y, e1.x} * r1_; }
                    const f32x2 o0 = ((f32x2){g[0], g[1]} * (f32x2){up[0], up[1]}) * e0 * F8_HS, o1 = ((f32x2){g[2], g[3]} * (f32x2){up[2], up[3]}) * e1 * F8_HS;
                    const unsigned pw = pk4_f8(o0.x, o0.y, o1.x, o1.y);
                    if (bj == 0) w.x = pw; else w.y = pw;
                }
                *(u32x2*)(out + (size_t)row * PITCH + col0) = w;
                if (PAD_PN >= 0 && u.pn == PAD_PN) *(u32x2*)(out + (size_t)row * PITCH + (PAD_PN + 1) * 128 + wc * 32 + 8 * fq) = (u32x2){0u, 0u};
            }
    }
};
template <bool WQ, bool SC, long XQOFF = 0>
struct EpiResBT {
    static constexpr bool PERM = true;
    bf16* XB; float* RS; float mul;
    __device__ __forceinline__ void operator()(const Acc& acc, const Unit& u, int wr, int wc, int fr, int fq) const {
        const int col0 = u.pn * 256 + wc * 32 + 8 * fq;
#pragma unroll
        for (int ai = 0; ai < 2; ++ai)
#pragma unroll
            for (int m = 0; m < 4; ++m) {
                const int row = u.pm * 256 + ai * 128 + wr * 64 + m * 16 + fr; float ss = 0.f;
#pragma unroll
                for (int bj = 0; bj < 2; ++bj) {
                    u32x4* p = (u32x4*)(XB + (size_t)row * D + col0 + bj * 128);
                    const u32x4 b = *p; f32x4 a0 = acc[ai][bj][m][0], a1 = acc[ai][bj][m][1];
                    if constexpr (SC) { a0 = a0 * mul; a1 = a1 * mul; }
                    const float o0 = bf2f(b.x & 0xffffu) + a0[0], o1 = bf2f(b.x >> 16) + a0[1], o2 = bf2f(b.y & 0xffffu) + a0[2], o3 = bf2f(b.y >> 16) + a0[3];
                    const float o4 = bf2f(b.z & 0xffffu) + a1[0], o5 = bf2f(b.z >> 16) + a1[1], o6 = bf2f(b.w & 0xffffu) + a1[2], o7 = bf2f(b.w >> 16) + a1[3];
                    u32x4 w; w.x = pk2(o0, o1); w.y = pk2(o2, o3); w.z = pk2(o4, o5); w.w = pk2(o6, o7); *p = w;
                    const float r0 = bf2f(w.x & 0xffffu), r1 = bf2f(w.x >> 16), r2 = bf2f(w.y & 0xffffu), r3 = bf2f(w.y >> 16), r4 = bf2f(w.z & 0xffffu), r5 = bf2f(w.z >> 16), r6 = bf2f(w.w & 0xffffu), r7 = bf2f(w.w >> 16);
                    ss += ((r0 * r0 + r1 * r1) + (r2 * r2 + r3 * r3)) + ((r4 * r4 + r5 * r5) + (r6 * r6 + r7 * r7));
                    if constexpr (WQ) { u32x2 q8; q8.x = pk4_i8(r0 * I8_XS, r1 * I8_XS, r2 * I8_XS, r3 * I8_XS); q8.y = pk4_i8(r4 * I8_XS, r5 * I8_XS, r6 * I8_XS, r7 * I8_XS); *(u32x2*)((unsigned char*)XB + XQOFF + (size_t)row * D + col0 + bj * 128) = q8; }
                }
                ss = sum_rows4(ss);
                if (fq == 0) RS[(size_t)row * 16 + u.pn * 4 + wc] = ss;
            }
    }
};
typedef EpiResBT<false, false> EpiResB;
struct EpiScale {
    static constexpr bool PERM = true;
    bf16* out; int ldc; const float* scale; const LAS float* sc_lds; float mul;
    __device__ __forceinline__ void operator()(const Acc& acc, const Unit& u, int wr, int wc, int fr, int fq) const {
        const int col0 = u.pn * 256 + wc * 32 + 8 * fq;
#pragma unroll
        for (int ai = 0; ai < 2; ++ai)
#pragma unroll
            for (int m = 0; m < 4; ++m) {
                const int row = u.pm * 256 + ai * 128 + wr * 64 + m * 16 + fr; const float rs = (sc_lds ? sc_lds[u.idx * 256 + ai * 128 + wr * 64 + m * 16 + fr] : scale[row]) * mul;
#pragma unroll
                for (int bj = 0; bj < 2; ++bj) {
                    const f32x4 v0 = acc[ai][bj][m][0] * rs, v1 = acc[ai][bj][m][1] * rs;
                    u32x4 w; w.x = pk2(v0[0], v0[1]); w.y = pk2(v0[2], v0[3]); w.z = pk2(v1[0], v1[1]); w.w = pk2(v1[2], v1[3]);
                    *(u32x4*)(out + (size_t)row * ldc + col0 + bj * 128) = w;
                }
            }
    }
};
struct EpiCmp1 {
    static constexpr bool PERM = true;
    bf16* out; const float* c1;
    __device__ __forceinline__ void operator()(const Acc& acc, const Unit& u, int wr, int wc, int fr, int fq) const {
        const int col0 = wc * 32 + 8 * fq; const float* cb = c1 + (u.pm >> 4) * 256;
#pragma unroll
        for (int bj = 0; bj < 2; ++bj) {
            const f32x4 b0 = *(const f32x4*)(cb + col0 + bj * 128), b1 = *(const f32x4*)(cb + col0 + bj * 128 + 4);
#pragma unroll
            for (int ai = 0; ai < 2; ++ai)
#pragma unroll
                for (int m = 0; m < 4; ++m) {
                    const int row = u.pm * 256 + ai * 128 + wr * 64 + m * 16 + fr;
                    f32x4 v0 = acc[ai][bj][m][0] + b0, v1 = acc[ai][bj][m][1] + b1;
#pragma unroll
                    for (int i = 0; i < 4; ++i) { v0[i] = gelu_tanh(v0[i]); v1[i] = gelu_tanh(v1[i]); }
                    u32x4 w; w.x = pk2(v0[0], v0[1]); w.y = pk2(v0[2], v0[3]); w.z = pk2(v1[0], v1[1]); w.w = pk2(v1[2], v1[3]);
                    *(u32x4*)(out + (size_t)row * 256 + col0 + bj * 128) = w;
                }
        }
    }
};

template <class Epi, class Sched>
__device__ __forceinline__ void gemm_naive(unsigned char* lds, const Gemm g, const Sched& S, const Epi& E) {
    const int tid = threadIdx.x, wid = tid >> 6, lane = tid & 63, wr = wid >> 2, wc = wid & 3, fr = lane & 15, fq = lane >> 4;
    float* As = (float*)lds;
    float* Bs = As + 16 * 260;
    Unit u;
    for (int it = 0; S.next(it, u); ++it) {
        Acc acc;
#pragma unroll
        for (int a = 0; a < 2; ++a)
#pragma unroll
            for (int b = 0; b < 2; ++b)
#pragma unroll
                for (int m = 0; m < 4; ++m)
#pragma unroll
                    for (int n = 0; n < 2; ++n) acc[a][b][m][n] = (f32x4){0.f, 0.f, 0.f, 0.f};
        const int r = tid >> 1, kc = (tid & 1) * 8;
        const unsigned char* ap = (const unsigned char*)g.A + u.aoff + (size_t)(r >> 7) * g.a_half + (size_t)(r & 127) * g.a_row + kc * 2;
        const unsigned char* bp = (const unsigned char*)g.Bt + u.boff + (size_t)(r >> 7) * g.b_half + (size_t)(r & 127) * g.b_row + kc * 2;
        for (int k0 = 0; k0 < g.K; k0 += 16) {
            const u32x4 va = *(const u32x4*)(ap + (size_t)(k0 >> 6) * g.a_k + (k0 & 63) * 2);
            const u32x4 vb = *(const u32x4*)(bp + (size_t)(k0 >> 6) * g.b_k + (k0 & 63) * 2);
            __syncthreads();
#pragma unroll
            for (int j = 0; j < 4; ++j) {
                As[(kc + 2 * j) * 260 + r] = bf2f(va[j] & 0xffffu); As[(kc + 2 * j + 1) * 260 + r] = bf2f(va[j] >> 16);
                Bs[(kc + 2 * j) * 260 + r] = bf2f(vb[j] & 0xffffu); Bs[(kc + 2 * j + 1) * 260 + r] = bf2f(vb[j] >> 16);
            }
            __syncthreads();
#pragma unroll 1
            for (int kk = 0; kk < 16; ++kk) {
                float a[2][4]; f32x4 b[2][2];
#pragma unroll
                for (int ai = 0; ai < 2; ++ai)
#pragma unroll
                    for (int m = 0; m < 4; ++m) a[ai][m] = As[kk * 260 + ai * 128 + wr * 64 + m * 16 + fr];
#pragma unroll
                for (int bj = 0; bj < 2; ++bj)
#pragma unroll
                    for (int n = 0; n < 2; ++n) b[bj][n] = *(const f32x4*)&Bs[kk * 260 + bj * 128 + wc * 32 + (Epi::PERM ? 8 * fq + 4 * n : 16 * n + 4 * fq)];
#pragma unroll
                for (int ai = 0; ai < 2; ++ai)
#pragma unroll
                    for (int bj = 0; bj < 2; ++bj)
#pragma unroll
                        for (int m = 0; m < 4; ++m)
#pragma unroll
                            for (int n = 0; n < 2; ++n) acc[ai][bj][m][n] += b[bj][n] * a[ai][m];
            }
        }
        E(acc, u, wr, wc, fr, fq);
    }
    __syncthreads();
}

namespace pg8 {
constexpr int BM = 256, BK = 64, HALF = 128, HTB = HALF * BK * 2, STAGE_BYTES = 8 * HTB;
__host__ __device__ __forceinline__ int lds_byte(int r, int c) { const int st = (r >> 4) * 2 + (c >> 5), rr = r & 15, cc = c & 31, ob = rr * 64 + cc * 2; return st * 1024 + (ob ^ (((ob >> 9) & 1) << 5)); }
__host__ __device__ __forceinline__ void stage_rc(int b, int& R, int& C) { const int st = b / 1024, sb = b % 1024, swz = sb ^ (((sb >> 9) & 1) << 5); R = (st >> 1) * 16 + swz / 64; C = (st & 1) * 32 + (swz % 64) / 2; }
typedef int i32x8_t __attribute__((ext_vector_type(8)));
typedef int i32x4_t __attribute__((ext_vector_type(4)));
__device__ __forceinline__ i32x8_t f8cat(bf16x8 lo, bf16x8 hi) { return __builtin_shufflevector(__builtin_bit_cast(i32x4_t, lo), __builtin_bit_cast(i32x4_t, hi), 0, 1, 2, 3, 4, 5, 6, 7); }
__device__ __forceinline__ bf16x8 f8lo(i32x8_t v) { return __builtin_bit_cast(bf16x8, (i32x4_t)__builtin_shufflevector(v, v, 0, 1, 2, 3)); }
__device__ __forceinline__ bf16x8 f8hi(i32x8_t v) { return __builtin_bit_cast(bf16x8, (i32x4_t)__builtin_shufflevector(v, v, 4, 5, 6, 7)); }
__host__ __device__ __forceinline__ int perm32(int rho) { const int n = rho >> 4, i = rho & 15; return 8 * (i >> 2) + 4 * n + (i & 3); }

template <class Epi, class Sched, bool ALIGN_EPI, bool GATHER = false, bool F8 = false, bool I8 = false>
__device__ __forceinline__ void gemm_phase(int wave_s, LAS unsigned char* lds, const Gemm g, const Sched& S, const Epi& E, const LAS int* rmap = nullptr) {
    int tid = tid_now(wave_s); asm volatile("" : "+v"(tid));
    const int wid = wave_s, lane = tid & 63, wr = wid >> 2, wc = wid & 3, fr = lane & 15, fq = lane >> 4;
    const int nt = g.K / BK;
    unsigned voffA[2], voffB[2];
#pragma unroll
    for (int i = 0; i < 2; ++i) { int R, C; stage_rc(tid * 16 + i * 8192, R, C); const int Rb = Epi::PERM ? ((R & ~31) + perm32(R & 31)) : R;
        voffA[i] = (unsigned)R * g.a_row + (unsigned)C * 2u; voffB[i] = (unsigned)Rb * g.b_row + (unsigned)C * 2u; }
    unsigned vc[2][2];
#define PG8_GLOAD(dst, ui_) do { _Pragma("unroll") for (int h_ = 0; h_ < 2; ++h_) _Pragma("unroll") for (int i_ = 0; i_ < 2; ++i_) dst[h_][i_] = ((unsigned)rmap[(ui_) * 256 + h_ * 128 + (int)(voffA[i_] >> (F8 ? 10 : 11))] << (F8 ? 10 : 11)) + (voffA[i_] & (F8 ? 1023u : 2047u)); } while (0)
    const size_t kA = g.a_k, kB = g.b_k, hA = g.a_half, hB = g.b_half;
    const unsigned ldsw = (unsigned)wid * 1024u;
    const int aoff = lds_byte(wr * 64 + fr, fq * 8), boff = lds_byte(wc * 32 + fr, fq * 8) + 4 * HTB;
#define PG8_SA(b, h) (((b) * 2 + (h)) * HTB)
#define PG8_SB(b, h) ((4 + (b) * 2 + (h)) * HTB)
#define PG8_STAGE(bufoff, gbase, voff) do { const char* gb_ = (const char*)(gbase); if constexpr (F8) asm volatile("" : "+s"(gb_)); _Pragma("unroll") for (int _i = 0; _i < 2; ++_i) \
        __builtin_amdgcn_global_load_lds((const unsigned*)(gb_ + (voff)[_i]), (LAS unsigned*)(lds + (bufoff) + ldsw + _i * 8192), 16, 0, 0); } while (0)
#define PG8_STAGE_G(bufoff, gbase, voff) do { const char* gb_ = (const char*)(gbase); asm volatile("" : "+s"(gb_)); _Pragma("unroll") for (int _i = 0; _i < 2; ++_i) \
        __builtin_amdgcn_global_load_lds((const unsigned*)(gb_ + (voff)[_i]), (LAS unsigned*)(lds + (bufoff) + ldsw + _i * 8192), 16, 0, 0); } while (0)
#define PG8_LDA(dst, b, h) do { _Pragma("unroll") for (int m = 0; m < 4; ++m) dst[m] = f8cat(*(const LAS bf16x8*)(lds + PG8_SA(b, h) + aoff + m * 2048), *(const LAS bf16x8*)(lds + PG8_SA(b, h) + aoff + m * 2048 + 1024)); } while (0)
#define PG8_LDB(dst, b, h) do { _Pragma("unroll") for (int n = 0; n < 2; ++n) dst[n] = f8cat(*(const LAS bf16x8*)(lds + ((b) * 2 + (h)) * HTB + boff + n * 2048), *(const LAS bf16x8*)(lds + ((b) * 2 + (h)) * HTB + boff + n * 2048 + 1024)); } while (0)
#define PG8_MMA(ai, bj, At, Bt) do { __builtin_amdgcn_s_setprio(1); _Pragma("unroll") for (int m = 0; m < 4; ++m) _Pragma("unroll") for (int n = 0; n < 2; ++n) { \
        if constexpr (F8 && I8) { i32x4_t c_ = __builtin_bit_cast(i32x4_t, acc[ai][bj][m][n]); \
            c_ = __builtin_amdgcn_mfma_i32_16x16x64_i8(__builtin_bit_cast(i32x4_t, f8lo(Bt[n])), __builtin_bit_cast(i32x4_t, f8lo(At[m])), c_, 0, 0, 0); \
            c_ = __builtin_amdgcn_mfma_i32_16x16x64_i8(__builtin_bit_cast(i32x4_t, f8hi(Bt[n])), __builtin_bit_cast(i32x4_t, f8hi(At[m])), c_, 0, 0, 0); acc[ai][bj][m][n] = __builtin_bit_cast(f32x4, c_); } \
        else if constexpr (F8) acc[ai][bj][m][n] = __builtin_amdgcn_mfma_scale_f32_16x16x128_f8f6f4(Bt[n], At[m], acc[ai][bj][m][n], 0, 0, 0, 0, 0, 0); \
        else { acc[ai][bj][m][n] = __builtin_amdgcn_mfma_f32_16x16x32_bf16(f8lo(Bt[n]), f8lo(At[m]), acc[ai][bj][m][n], 0, 0, 0); acc[ai][bj][m][n] = __builtin_amdgcn_mfma_f32_16x16x32_bf16(f8hi(Bt[n]), f8hi(At[m]), acc[ai][bj][m][n], 0, 0, 0); } } \
        __builtin_amdgcn_s_setprio(0); } while (0)
#define PG8_WAIT_V(n) asm volatile("s_waitcnt vmcnt(" #n ")" ::: "memory")
#define PG8_WAIT_L(n) asm volatile("s_waitcnt lgkmcnt(" #n ")" ::: "memory")
#define PG8_BAR __builtin_amdgcn_s_barrier()
#define PG8_SCHED __builtin_amdgcn_sched_barrier(0)
    Unit cur, nxt; int ui = 0;
    if (!S.next(0, cur)) return;
    Acc acc;
#pragma unroll
    for (int a = 0; a < 2; ++a)
#pragma unroll
        for (int b = 0; b < 2; ++b)
#pragma unroll
            for (int m = 0; m < 4; ++m)
#pragma unroll
                for (int n = 0; n < 2; ++n) acc[a][b][m][n] = (f32x4){0.f, 0.f, 0.f, 0.f};
    i32x8_t At[4], B0[2], B1[2];
    const char* cA = (const char*)g.A + (GATHER ? 0 : cur.aoff); const char* cB = (const char*)g.Bt + cur.boff;
    if constexpr (GATHER) { PG8_GLOAD(vc, 0); }
    PG8_STAGE(PG8_SB(0, 0), cB, voffB); PG8_STAGE(PG8_SB(0, 1), cB + hB, voffB);
    if constexpr (GATHER) { PG8_STAGE_G(PG8_SA(0, 0), cA, vc[0]); PG8_STAGE_G(PG8_SA(0, 1), cA, vc[1]); } else { PG8_STAGE(PG8_SA(0, 0), cA, voffA); PG8_STAGE(PG8_SA(0, 1), cA + hA, voffA); }
    if (wr == 1) PG8_BAR;
    PG8_WAIT_V(2); PG8_BAR;
    PG8_STAGE(PG8_SB(1, 0), cB + kB, voffB); if constexpr (GATHER) PG8_STAGE_G(PG8_SA(1, 0), cA + kA, vc[0]); else PG8_STAGE(PG8_SA(1, 0), cA + kA, voffA); PG8_STAGE(PG8_SB(1, 1), cB + hB + kB, voffB);
    PG8_WAIT_V(6); PG8_BAR;
    for (;;) {
        const bool has_next = S.next(ui + 1, nxt);
        const char* nA = (has_next && !GATHER) ? (const char*)g.A + nxt.aoff : cA; const char* nB = has_next ? (const char*)g.Bt + nxt.boff : cB;
        for (int t = 0; t < nt; t += 2) {
            const bool last = (t == nt - 2);
            const char* a1 = cA + (size_t)(t + 1) * kA;
            const char* a2 = last ? nA : cA + (size_t)(t + 2) * kA; const char* b2 = last ? nB : cB + (size_t)(t + 2) * kB;
            const char* a3 = a2 + kA; const char* b3 = b2 + kB;
            PG8_LDB(B0, 0, 0); PG8_LDB(B1, 0, 1); PG8_SCHED; PG8_LDA(At, 0, 0); if constexpr (GATHER) { PG8_STAGE_G(PG8_SA(1, 1), a1, vc[1]); if (last && has_next) PG8_GLOAD(vc, ui + 1); }     else PG8_STAGE(PG8_SA(1, 1), a1 + hA, voffA);
            PG8_WAIT_V(8); PG8_WAIT_L(0); PG8_BAR; PG8_MMA(0, 0, At, B0); PG8_MMA(0, 1, At, B1); PG8_BAR; PG8_SCHED;
            PG8_LDA(At, 0, 1); PG8_STAGE(PG8_SB(0, 0), b2, voffB); PG8_STAGE(PG8_SB(0, 1), b2 + hB, voffB); if constexpr (GATHER) PG8_STAGE_G(PG8_SA(0, 0), a2, vc[0]); else PG8_STAGE(PG8_SA(0, 0), a2, voffA);
            PG8_WAIT_V(8); PG8_WAIT_L(0); PG8_BAR; PG8_MMA(1, 0, At, B0); PG8_MMA(1, 1, At, B1); PG8_BAR; PG8_SCHED;
            PG8_LDB(B0, 1, 0); PG8_LDB(B1, 1, 1); PG8_SCHED; PG8_LDA(At, 1, 0); if constexpr (GATHER) PG8_STAGE_G(PG8_SA(0, 1), a2, vc[1]); else PG8_STAGE(PG8_SA(0, 1), a2 + hA, voffA);
            PG8_WAIT_V(8); PG8_WAIT_L(0); PG8_BAR; PG8_MMA(0, 0, At, B0); PG8_MMA(0, 1, At, B1); PG8_BAR; PG8_SCHED;
            PG8_LDA(At, 1, 1); PG8_STAGE(PG8_SB(1, 0), b3, voffB); PG8_STAGE(PG8_SB(1, 1), b3 + hB, voffB); if constexpr (GATHER) PG8_STAGE_G(PG8_SA(1, 0), a3, vc[0]); else PG8_STAGE(PG8_SA(1, 0), a3, voffA);
            PG8_WAIT_V(8); PG8_WAIT_L(0); PG8_BAR; PG8_MMA(1, 0, At, B0); PG8_MMA(1, 1, At, B1); PG8_BAR; PG8_SCHED;
        }
        if constexpr (ALIGN_EPI) { if (wr == 0) PG8_BAR; }
        { const int t2_ = lane_after(acc[1][1][3][1][3]); E(acc, cur, wr, wc, t2_ & 15, (t2_ >> 4) & 3); }
        if (!has_next) break;
#pragma unroll
        for (int a = 0; a < 2; ++a)
#pragma unroll
            for (int b = 0; b < 2; ++b)
#pragma unroll
                for (int m = 0; m < 4; ++m)
#pragma unroll
                    for (int n = 0; n < 2; ++n) acc[a][b][m][n] = (f32x4){0.f, 0.f, 0.f, 0.f};
        cur = nxt; cA = nA; cB = nB; ++ui;
        if constexpr (ALIGN_EPI) { if (wr == 1) PG8_BAR; }
    }
    PG8_WAIT_V(0);
    if constexpr (!ALIGN_EPI) { if (wr == 0) PG8_BAR; }
    PG8_BAR;
#undef PG8_GLOAD
#undef PG8_SA
#undef PG8_SB
#undef PG8_STAGE
#undef PG8_STAGE_G
#undef PG8_LDA
#undef PG8_LDB
#undef PG8_MMA
#undef PG8_WAIT_V
#undef PG8_WAIT_L
#undef PG8_BAR
#undef PG8_SCHED
}
}
#ifndef MFMA_MASK
#define MFMA_MASK 0xFFFFu
#endif
template <int PH, class Epi, class Sched>
__device__ __forceinline__ void gemm_run(const Frame& F, const Gemm g, const Sched& S, const Epi& E) {
    if constexpr (((MFMA_MASK >> PH) & 1u) != 0u) pg8::gemm_phase<Epi, Sched, true>(F.wave, (LAS unsigned char*)F.lds, g, S, E);
    else gemm_naive<Epi, Sched>(F.lds, g, S, E);
}

enum { MAP_ID = 0, MAP_GATE = 1, MAP_UP = 2, MAP_IN1 = 3, MAP_GATE8 = 4, MAP_UP8 = 5 };
__device__ __forceinline__ int map_row(int mapk, int n) {
    if (mapk == MAP_GATE) return 8 * (n >> 2) + (n & 3);
    if (mapk == MAP_UP) return 8 * (n >> 2) + 4 + (n & 3);
    if (mapk == MAP_GATE8 || mapk == MAP_UP8) return 256 * (n >> 7) + 128 * ((n >> 2) & 1) + 32 * ((n >> 5) & 3) + 8 * ((n >> 3) & 3) + (mapk == MAP_UP8 ? 4 : 0) + (n & 3);
    if (mapk == MAP_IN1) return n < 1280 ? n : (n < 1304 ? C_GL + (n - 1280) : n - 24);
    return n;
}
struct TrDesc { const float* W; bf16* WT; const float* gain; int K, N, mapk, k0, n0, ld8; };
__device__ __forceinline__ TrDesc tr_mk(const float* W, int K, int N, bf16* WT, const float* gain, int mapk, int item, int ld8 = 0) {
    TrDesc d; d.W = W; d.WT = WT; d.gain = gain; d.K = K; d.N = N; d.mapk = mapk; d.ld8 = ld8;
    const int nblk = (N + 63) >> 6, kb = item / nblk, nb = item - kb * nblk; d.k0 = 64 * kb; d.n0 = 64 * nb; return d;
}
__device__ __forceinline__ void tr_load(const TrDesc& d, f32x4 (&v)[16], int lane) {
    const int krow = lane >> 4, n = d.n0 + 4 * (lane & 15);
#pragma unroll
    for (int p = 0; p < 16; ++p) v[p] = n < d.N ? *(const f32x4*)(d.W + (size_t)(d.k0 + 4 * p + krow) * d.N + n) : (f32x4){0.f, 0.f, 0.f, 0.f};
}
__device__ __forceinline__ void tr_finish(const TrDesc& d, f32x4 (&v)[16], float* scr, int lane) {
    const int krow = lane >> 4, c4 = lane & 15;
    if (d.gain) {
#pragma unroll
        for (int p = 0; p < 16; ++p) v[p] = v[p] * d.gain[d.k0 + 4 * p + krow];
    }
#pragma unroll
    for (int p = 0; p < 16; ++p) { float* q = scr + (4 * p + krow) * 65 + 4 * c4; q[0] = v[p][0]; q[1] = v[p][1]; q[2] = v[p][2]; q[3] = v[p][3]; }
    LDS_FENCE();
    const int c = lane & 7;
#pragma unroll
    for (int j = 0; j < 8; ++j) {
        const int nl = (lane >> 3) + 8 * j, nn = d.n0 + nl;
        if (nn < d.N) {
            const float* sp = scr + (8 * c) * 65 + nl;
            if (d.ld8 < 0) {
                u32x2 o; o.x = pk4_i8(sp[0 * 65] * I8_WS, sp[1 * 65] * I8_WS, sp[2 * 65] * I8_WS, sp[3 * 65] * I8_WS); o.y = pk4_i8(sp[4 * 65] * I8_WS, sp[5 * 65] * I8_WS, sp[6 * 65] * I8_WS, sp[7 * 65] * I8_WS);
                *(u32x2*)((unsigned char*)d.WT + (size_t)map_row(d.mapk, nn) * (-d.ld8) + d.k0 + 8 * c) = o;
            } else if (d.ld8) {
                u32x2 o; o.x = pk4_f8(sp[0 * 65] * F8_WS, sp[1 * 65] * F8_WS, sp[2 * 65] * F8_WS, sp[3 * 65] * F8_WS); o.y = pk4_f8(sp[4 * 65] * F8_WS, sp[5 * 65] * F8_WS, sp[6 * 65] * F8_WS, sp[7 * 65] * F8_WS);
                *(u32x2*)((unsigned char*)d.WT + (size_t)map_row(d.mapk, nn) * d.ld8 + d.k0 + 8 * c) = o;
            } else {
                u32x4 o; o.x = pk2(sp[0 * 65], sp[1 * 65]); o.y = pk2(sp[2 * 65], sp[3 * 65]); o.z = pk2(sp[4 * 65], sp[5 * 65]); o.w = pk2(sp[6 * 65], sp[7 * 65]);
                *(u32x4*)(d.WT + (size_t)map_row(d.mapk, nn) * d.K + d.k0 + 8 * c) = o;
            }
        }
    }
    LDS_FENCE();
}
constexpr int I_IN0 = 16 * 44, I_SQ = 16 * 16, I_GU0 = 16 * 44, I_DN0 = 44 * 16, I_IN1 = 16 * 45, I_MG = 16 * 22, I_MD = 22 * 16, I_C1 = 32 * 4, I_C2 = 4 * 1, I_L64 = 8, I_L128 = 16;
constexpr int TR_NITEMS = I_IN0 + I_SQ + 2 * I_GU0 + I_DN0 + I_IN1 + I_SQ + 16 * I_MG + 8 * I_MD + 2 * I_C1 + 2 * I_C2 + 2 * I_L64 + I_L128;
__device__ __forceinline__ TrDesc tr_decode(const Frame& F, int it) {
    int r = it;
    if (r < I_IN0) return tr_mk(F.in[2], D, IN0, wsp<bf16>(F, WT_IN0), F.in[1], MAP_ID, r, -D); r -= I_IN0;
    if (r < I_SQ) return tr_mk(F.in[18], D, D, wsp<bf16>(F, WT_OUT0), nullptr, MAP_ID, r); r -= I_SQ;
    if (r < I_GU0) return tr_mk(F.in[20], D, FFN, wsp<bf16>(F, WT_GU0), F.in[19], MAP_GATE8, r, -D); r -= I_GU0;
    if (r < I_GU0) return tr_mk(F.in[21], D, FFN, wsp<bf16>(F, WT_GU0), F.in[19], MAP_UP8, r, -D); r -= I_GU0;
    if (r < I_DN0) return tr_mk(F.in[22], FFN, D, wsp<bf16>(F, WT_DN0), nullptr, MAP_ID, r, FFN); r -= I_DN0;
    if (r < I_IN1) return tr_mk(F.in[24], D, IN1, wsp<bf16>(F, WT_IN1), F.in[23], MAP_IN1, r, -D); r -= I_IN1;
    if (r < I_SQ) return tr_mk(F.in[32], D, D, wsp<bf16>(F, WT_OUT1), nullptr, MAP_ID, r); r -= I_SQ;
    if (r < 8 * I_MG) { const int e = r / I_MG; return tr_mk(F.in[36] + (size_t)e * D * EXPD, D, EXPD, (bf16*)(F.ws + WT_GU1 + (size_t)e * 2 * EXPD * D), F.in[33], MAP_GATE8, r - e * I_MG, -D); } r -= 8 * I_MG;
    if (r < 8 * I_MG) { const int e = r / I_MG; return tr_mk(F.in[37] + (size_t)e * D * EXPD, D, EXPD, (bf16*)(F.ws + WT_GU1 + (size_t)e * 2 * EXPD * D), F.in[33], MAP_UP8, r - e * I_MG, -D); } r -= 8 * I_MG;
    if (r < 8 * I_MD) { const int e = r / I_MD; return tr_mk(F.in[38] + (size_t)e * EXPD * D, EXPD, D, (bf16*)(F.ws + WT_DN1 + (size_t)e * D * AP8), nullptr, MAP_ID, r - e * I_MD, AP8); } r -= 8 * I_MD;
    if (r < I_C1) return tr_mk(F.in[27], 2048, 256, wsp<bf16>(F, WT_CK1), nullptr, MAP_ID, r); r -= I_C1;
    if (r < I_C1) return tr_mk(F.in[29], 2048, 256, wsp<bf16>(F, WT_CV1), nullptr, MAP_ID, r); r -= I_C1;
    if (r < I_C2) return tr_mk(F.in[28], 256, 64, wsp<bf16>(F, WT_CK2), nullptr, MAP_ID, r); r -= I_C2;
    if (r < I_C2) return tr_mk(F.in[30], 256, 64, wsp<bf16>(F, WT_CV2), nullptr, MAP_ID, r); r -= I_C2;
    if (r < I_L64) return tr_mk(F.in[9], 64, 512, wsp<bf16>(F, WT_W2), nullptr, MAP_ID, r); r -= I_L64;
    if (r < I_L64) return tr_mk(F.in[11], 64, 512, wsp<bf16>(F, WT_A2), nullptr, MAP_ID, r); r -= I_L64;
    return tr_mk(F.in[12], 128, 512, wsp<bf16>(F, WT_G2), nullptr, MAP_ID, r);
}
__device__ __forceinline__ void tr_range(const Frame& F, int lo, int hi, int gw, int NGW) {
    float* scr = (float*)(F.lds + F.wave * 16640);
    int lane_ = F.lane; asm volatile("" : "+v"(lane_));
    for (int it = lo + gw; it < hi; it += NGW) { TrDesc d = tr_decode(F, it); f32x4 v[16]; tr_load(d, v, lane_); tr_finish(d, v, scr, lane_); }
}
constexpr int CW_TRQ = 2048;
__device__ __forceinline__ void tr_queue(const Frame& F, int lo, int hi) {
    float* scr = (float*)(F.lds + F.wave * 16640);
    int lane_ = F.lane; asm volatile("" : "+v"(lane_));
    unsigned* head = (unsigned*)(F.ws + WS_CTL) + CW_TRQ;
    for (;;) {
        unsigned base = 0;
        if (lane_ == 0) base = __hip_atomic_fetch_add(head, 2u, __ATOMIC_RELAXED, __HIP_MEMORY_SCOPE_AGENT);
        base = __builtin_amdgcn_readfirstlane(base);
        const int it0 = lo + (int)base;
        if (it0 >= hi) break;
        { TrDesc d = tr_decode(F, it0); f32x4 v[16]; tr_load(d, v, lane_); tr_finish(d, v, scr, lane_); }
        if (it0 + 1 < hi) { TrDesc d = tr_decode(F, it0 + 1); f32x4 v[16]; tr_load(d, v, lane_); tr_finish(d, v, scr, lane_); }
    }
}
constexpr int TR_LORA0 = TR_NITEMS - (2 * I_L64 + I_L128);
__device__ __forceinline__ void p0_prologue(const Frame& F) {
    const int gw = F.blk * NWAVES + F.wave, NGW = F.G * NWAVES;
    tr_range(F, 0, I_IN0, gw, NGW);
    tr_range(F, TR_LORA0, TR_NITEMS, gw, NGW);
    {
        const float* x = F.in[0]; bf16* XB = wsp<bf16>(F, WS_XB); float* rstd0 = wsp<float>(F, M_RSTD0);
        for (int m = gw; m < NTOK; m += NGW) {
            const f32x4* xr = (const f32x4*)(x + (size_t)m * D) + F.lane; f32x4 v[4]; float s = 0.f;
#pragma unroll
            for (int j = 0; j < 4; ++j) { v[j] = xr[64 * j]; s += (v[j].x * v[j].x + v[j].y * v[j].y) + (v[j].z * v[j].z + v[j].w * v[j].w); }
            s = wave_sum(s);
            float amax = 0.f;
#pragma unroll
            for (int j = 0; j < 4; ++j) amax = fmaxf(fmaxf(amax, fmaxf(fabsf(v[j].x), fabsf(v[j].y))), fmaxf(fabsf(v[j].z), fabsf(v[j].w)));
            amax = fmaxf(wave_max(amax), 1e-20f);
            const float qs = 127.0f * rcpf_(amax);
            u32x2* o8 = (u32x2*)(XB + (size_t)m * D) + F.lane;
#pragma unroll
            for (int j = 0; j < 4; ++j) { u32x2 w; w.x = pk2(v[j].x, v[j].y); w.y = pk2(v[j].z, v[j].w); o8[64 * j] = w; }
            unsigned* q4 = (unsigned*)(F.ws + WS_XQI + (size_t)m * D) + F.lane;
#pragma unroll
            for (int j = 0; j < 4; ++j) q4[64 * j] = pk4_i8(v[j].x * qs, v[j].y * qs, v[j].z * qs, v[j].w * qs);
            if (F.lane == 0) rstd0[m] = rsqrtf(s * (1.0f / D) + 1e-6f) * amax * (1.0f / 127.0f);
        }
    }
    const int gt = F.blk * NTHR + F.tid, NGT = F.G * NTHR;
    {
        float* rope = wsp<float>(F, M_ROPE);
        for (int idx = gt; idx < SEQ * 8; idx += NGT) {
            const int t = idx >> 3, i = idx & 7;
            const float invf = (float)pow(500000.0, -(double)i / 8.0);
            const float ang = (float)t * invf;
            rope[t * 16 + i] = cosf(ang); rope[t * 16 + 8 + i] = sinf(ang);
        }
    }
    {
        float* c1 = wsp<float>(F, M_C1);
        for (int idx = gw; idx < 512; idx += NGW) {
            const int which = idx >> 8, n = idx & 255; const float* pos = F.in[25 + which]; const float* W1 = F.in[which ? 29 : 27];
            float sacc = 0.f;
#pragma unroll 8
            for (int k = F.lane; k < 2048; k += 64) sacc += pos[k] * W1[(size_t)k * 256 + n];
            sacc = wave_sum(sacc);
            if (F.lane == 0) c1[idx] = sacc;
        }
    }
    {
        float* wr = wsp<float>(F, M_WR);
        for (int idx = gt; idx < 8 * D; idx += NGT) { const int e = idx >> 10, k = idx & 1023; wr[idx] = F.in[33][k] * F.in[34][k * 8 + e]; }
    }
    {
        bf16* wm = wsp<bf16>(F, WT_SGU);
        for (int idx = gt; idx < 4 * 128 * 128; idx += NGT) { const int t = (idx >> 7) & 127, s = idx & 127; wm[idx] = (bf16)(s <= t ? f2bf(F.in[5][idx]) : 0u); }
    }
    {
        for (int idx = gt; idx < NEXP * D * 8; idx += NGT) *(u32x4*)(F.ws + WT_DN1 + (size_t)(idx >> 3) * AP8 + EXPD + 16 * (idx & 7)) = (u32x4){0u, 0u, 0u, 0u};
    }
    {
        u32x4* z = (u32x4*)(F.ws + WT_IN1 + (size_t)IN1 * D);
        for (int idx = gt; idx < (IN1P - IN1) * D / 16; idx += NGT) z[idx] = (u32x4){0u, 0u, 0u, 0u};
    }
}

constexpr int RW_R = 0, RW_K = 8192, RW_V = 16384, RW_LIN = 24576, RW_LINP = 264, RW_DEC = 41472, RW_KK = 49664, RW_KKA = 57856, RW_KP = 66048, RW_WR = 74240, RW_G = 82432, RW_YO = 90624, RW_SC = 98816, RW_DUMMY = 99328, RW_MU = 103424, RW_LW2 = 105216, RW_LA2 = 114432, RW_LG2 = 123648;
struct RwA { u32x4 cur[4], prev[4]; };
__device__ __forceinline__ void rwkv_loadA(RwA& A, const bf16* PB, int b, int h, int t0, int tid) {
#pragma unroll
    for (int i = 0; i < 4; ++i) {
        const int idx = tid + NTHR * i;
        if (idx < 32 * 56) {
            const int tl = idx / 56, ch = idx - tl * 56;
            const int pc = ch < 8 ? 64 * h + 8 * ch : (ch < 16 ? 512 + 64 * h + 8 * (ch - 8) : (ch < 24 ? 1024 + 64 * h + 8 * (ch - 16) : 1536 + 8 * (ch - 24)));
            const int t = t0 + tl; const bf16* p = PB + ((size_t)b * SEQ + t) * IN0 + 1024 + pc;
            A.cur[i] = *(const u32x4*)p;
            A.prev[i] = t > 0 ? *(const u32x4*)(p - IN0) : (u32x4){0u, 0u, 0u, 0u};
        }
    }
}
__device__ __forceinline__ void rwkv_item(const Frame& F, int b, int h) {
    LAS unsigned char* L = (LAS unsigned char*)F.lds;
    const bf16* PB = wsp<bf16>(F, WS_PB); bf16* Y = wsp<bf16>(F, WS_YB);
    const float* mu = F.in[7]; const float* w0 = F.in[8]; const float* a0 = F.in[10];
    const float* k_k = F.in[13]; const float* k_a = F.in[14]; const float* r_k = F.in[15]; const float* gn_g = F.in[16]; const float* gn_b = F.in[17];
    int tid = F.tid; asm volatile("" : "+v"(tid));
    const int lane = tid & 63, wave = F.wave;
    const int jq = lane & 15, rg = lane >> 4, tl16 = tid >> 4;
    const int hc4 = 64 * h + 4 * jq;
    const f32x4 w0v = *(const f32x4*)(w0 + hc4), a0v = *(const f32x4*)(a0 + hc4), kkv = *(const f32x4*)(k_k + hc4), kav = *(const f32x4*)(k_a + hc4), rkv = *(const f32x4*)(r_k + hc4), gngv = *(const f32x4*)(gn_g + hc4), gnbv = *(const f32x4*)(gn_b + hc4);
    const int mt = wave >> 2, ntl = wave & 3, fr = lane & 15, fq = lane >> 4;
    const int i0 = 8 * wave + rg, i1 = i0 + 4;
    f32x2 s0a = {0.f, 0.f}, s0b = {0.f, 0.f}, s1a = {0.f, 0.f}, s1b = {0.f, 0.f};
    {
        if (tid < 56 * 2) { const int ch = tid >> 1, hf = tid & 1;
            const int pc = ch < 8 ? 64 * h + 8 * ch : (ch < 16 ? 512 + 64 * h + 8 * (ch - 8) : (ch < 24 ? 1024 + 64 * h + 8 * (ch - 16) : 1536 + 8 * (ch - 24)));
            *(LAS f32x4*)(L + RW_MU + ch * 32 + hf * 16) = *(const f32x4*)(mu + pc + 4 * hf); }
        { const int row = tid >> 3, c8 = tid & 7;
          *(LAS u32x4*)(L + RW_LW2 + (row * 72 + c8 * 8) * 2) = *(const u32x4*)(wsp<bf16>(F, WT_W2) + (size_t)(64 * h + row) * 64 + c8 * 8);
          *(LAS u32x4*)(L + RW_LA2 + (row * 72 + c8 * 8) * 2) = *(const u32x4*)(wsp<bf16>(F, WT_A2) + (size_t)(64 * h + row) * 64 + c8 * 8); }
#pragma unroll
        for (int i = 0; i < 2; ++i) { const int id = tid + NTHR * i, row = id >> 4, c16 = id & 15;
          *(LAS u32x4*)(L + RW_LG2 + (row * 136 + c16 * 8) * 2) = *(const u32x4*)(wsp<bf16>(F, WT_G2) + (size_t)(64 * h + row) * 128 + c16 * 8); }
        __syncthreads();
    }
    RwA A; rwkv_loadA(A, PB, b, h, 0, tid);
    for (int t0 = 0; t0 < SEQ; t0 += 32) {
#pragma unroll
        for (int i = 0; i < 4; ++i) {
            const int idx = tid + NTHR * i;
            if (idx < 32 * 56) {
                const int tl = idx / 56, ch = idx - tl * 56;
                const int pc = ch < 8 ? 64 * h + 8 * ch : (ch < 16 ? 512 + 64 * h + 8 * (ch - 8) : (ch < 24 ? 1024 + 64 * h + 8 * (ch - 16) : 1536 + 8 * (ch - 24)));
                const f32x4 m0 = *(const LAS f32x4*)(L + RW_MU + ch * 32), m1 = *(const LAS f32x4*)(L + RW_MU + ch * 32 + 16);
                float xs[8];
#pragma unroll
                for (int j = 0; j < 4; ++j) {
                    const float c0 = bf2f(A.cur[i][j] & 0xffffu), c1 = bf2f(A.cur[i][j] >> 16), p0 = bf2f(A.prev[i][j] & 0xffffu), p1 = bf2f(A.prev[i][j] >> 16);
                    const float mA = j < 2 ? m0[2 * j] : m1[2 * j - 4], mB = j < 2 ? m0[2 * j + 1] : m1[2 * j - 3];
                    xs[2 * j] = c0 + (p0 - c0) * mA; xs[2 * j + 1] = c1 + (p1 - c1) * mB;
                }
                if (ch < 24) {
                    LAS float* dst = (LAS float*)(L + (ch < 8 ? RW_R : (ch < 16 ? RW_K : RW_V))) + tl * 64 + 8 * (ch & 7);
                    *(LAS f32x4*)dst = (f32x4){xs[0], xs[1], xs[2], xs[3]}; *(LAS f32x4*)(dst + 4) = (f32x4){xs[4], xs[5], xs[6], xs[7]};
                } else {
                    const int lc = ch - 24;
                    if (lc < 8) {
#pragma unroll
                        for (int j = 0; j < 8; ++j) xs[j] = 1.0f - 2.0f / (1.0f + __expf(2.0f * xs[j]));
                    } else if (lc >= 16) {
#pragma unroll
                        for (int j = 0; j < 8; ++j) xs[j] = sigmoidf_(xs[j]);
                    }
                    u32x4 w; w.x = pk2(xs[0], xs[1]); w.y = pk2(xs[2], xs[3]); w.z = pk2(xs[4], xs[5]); w.w = pk2(xs[6], xs[7]);
                    *(LAS u32x4*)(L + RW_LIN + (tl * RW_LINP + 8 * lc) * 2) = w;
                }
            }
        }
        __syncthreads();
        {
            const LAS unsigned char* arow = L + RW_LIN + ((16 * mt + fr) * RW_LINP + 8 * fq) * 2;
            f32x4 cw = {0.f, 0.f, 0.f, 0.f}, ca = {0.f, 0.f, 0.f, 0.f}, cg = {0.f, 0.f, 0.f, 0.f};
            const LAS unsigned char* bw = L + RW_LW2 + ((16 * ntl + fr) * 72 + 8 * fq) * 2;
            const LAS unsigned char* ba = L + RW_LA2 + ((16 * ntl + fr) * 72 + 8 * fq) * 2;
            const LAS unsigned char* bg = L + RW_LG2 + ((16 * ntl + fr) * 136 + 8 * fq) * 2;
#pragma unroll
            for (int ks = 0; ks < 2; ++ks) {
                cw = __builtin_amdgcn_mfma_f32_16x16x32_bf16(*(const LAS bf16x8*)(arow + 64 * ks), *(const LAS bf16x8*)(bw + 64 * ks), cw, 0, 0, 0);
                ca = __builtin_amdgcn_mfma_f32_16x16x32_bf16(*(const LAS bf16x8*)(arow + 128 + 64 * ks), *(const LAS bf16x8*)(ba + 64 * ks), ca, 0, 0, 0);
            }
#pragma unroll
            for (int ks = 0; ks < 4; ++ks) cg = __builtin_amdgcn_mfma_f32_16x16x32_bf16(*(const LAS bf16x8*)(arow + 256 + 64 * ks), *(const LAS bf16x8*)(bg + 64 * ks), cg, 0, 0, 0);
#pragma unroll
            for (int r = 0; r < 4; ++r) {
                const int o = (16 * mt + 4 * fq + r) * 64 + 16 * ntl + fr;
                ((LAS float*)(L + RW_DEC))[o] = cw[r]; ((LAS float*)(L + RW_KKA))[o] = ca[r]; ((LAS float*)(L + RW_G))[o] = cg[r];
            }
        }
        __syncthreads();
        {
            const int o4 = (tl16 * 64 + 4 * jq) * 4;
            const f32x4 lw = *(const LAS f32x4*)(L + RW_DEC + o4), la = *(const LAS f32x4*)(L + RW_KKA + o4), kr = *(const LAS f32x4*)(L + RW_K + o4), r = *(const LAS f32x4*)(L + RW_R + o4);
            f32x4 dec, a, kkr, kp;
#pragma unroll
            for (int i = 0; i < 4; ++i) {
                const float nx = -(w0v[i] + lw[i]);
                const float sp = fmaxf(nx, 0.f) + __logf(1.0f + __expf(-fabsf(nx)));
                dec[i] = __expf(-__expf(-sp - 0.5f));
                a[i] = sigmoidf_(a0v[i] + la[i]);
                kkr[i] = kr[i] * kkv[i]; kp[i] = kr[i] * (1.0f + (a[i] - 1.0f) * kav[i]);
            }
            const float n2 = red16((kkr[0] * kkr[0] + kkr[1] * kkr[1]) + (kkr[2] * kkr[2] + kkr[3] * kkr[3]));
            const float inv = 1.0f / fmaxf(sqrtf(n2), 1e-12f);
            const f32x4 kk = kkr * inv, kka = kk * a;
            const float c1 = red16((kka[0] * r[0] + kka[1] * r[1]) + (kka[2] * r[2] + kka[3] * r[3]));
            const float c2 = red16((kp[0] * r[0] + kp[1] * r[1]) + (kp[2] * r[2] + kp[3] * r[3]));
            const float c3 = red16((r[0] * kp[0] * rkv[0] + r[1] * kp[1] * rkv[1]) + (r[2] * kp[2] * rkv[2] + r[3] * kp[3] * rkv[3]));
            *(LAS f32x4*)(L + RW_DEC + o4) = dec; *(LAS f32x4*)(L + RW_KK + o4) = kk; *(LAS f32x4*)(L + RW_KKA + o4) = kka; *(LAS f32x4*)(L + RW_KP + o4) = kp; *(LAS f32x4*)(L + RW_WR + o4) = dec * r;
            if (jq == 0) { LAS float* sc = (LAS float*)(L + RW_SC) + tl16 * 4; sc[0] = c1; sc[1] = c2; sc[2] = c3; }
        }
        __syncthreads();
        if (t0 + 32 < SEQ) rwkv_loadA(A, PB, b, h, t0 + 32, tid);
        {
            const LAS unsigned char* p1 = L + RW_DEC + 16 * jq;
            const LAS unsigned char* p2 = L + RW_V + 4 * i0;
            const LAS unsigned char* p3 = L + RW_SC;
            LAS unsigned char* py = L + (jq == 0 ? RW_YO + 4 * i0 : RW_DUMMY + (tid >> 2) * 32 + (tid & 3) * 4);
            const int ystep = jq == 0 ? 512 : 0;
#define RW_LOAD(B, o) do { B##d = *(const LAS f32x4*)(p1 + (o) * 256); B##k = *(const LAS f32x4*)(p1 + 8192 + (o) * 256); B##a = *(const LAS f32x4*)(p1 + 16384 + (o) * 256); \
                B##p = *(const LAS f32x4*)(p1 + 24576 + (o) * 256); B##w = *(const LAS f32x4*)(p1 + 32768 + (o) * 256); \
                B##v0 = *(const LAS float*)(p2 + (o) * 256); B##v1 = *(const LAS float*)(p2 + 16 + (o) * 256); B##c = *(const LAS f32x2*)(p3 + (o) * 16); } while (0)
#define RW_STEP(B, yo) do { \
                const f32x2 kl = {B##k[0], B##k[1]}, kh = {B##k[2], B##k[3]}, wl = {B##w[0], B##w[1]}, wh = {B##w[2], B##w[3]}; \
                f32x2 ta = s0a * kl; ta = s0b * kh + ta; f32x2 tb = s1a * kl; tb = s1b * kh + tb; f32x2 ua = s0a * wl; ua = s0b * wh + ua; f32x2 ub = s1a * wl; ub = s1b * wh + ub; \
                const float sa0 = red16(ta.x + ta.y), sa1 = red16(tb.x + tb.y), yy0 = red16(ua.x + ua.y), yy1 = red16(ub.x + ub.y); \
                const f32x2 dl = {B##d[0], B##d[1]}, dh = {B##d[2], B##d[3]}, al = {B##a[0], B##a[1]}, ah = {B##a[2], B##a[3]}, pl = {B##p[0], B##p[1]}, ph = {B##p[2], B##p[3]}; \
                s0a = s0a * dl - al * sa0 + pl * B##v0; s0b = s0b * dh - ah * sa0 + ph * B##v0; s1a = s1a * dl - al * sa1 + pl * B##v1; s1b = s1b * dh - ah * sa1 + ph * B##v1; \
                *(LAS float*)(py + (yo)) = yy0 - sa0 * B##c.x + B##v0 * B##c.y; *(LAS float*)(py + (yo) + 16) = yy1 - sa1 * B##c.x + B##v1 * B##c.y; } while (0)
            f32x4 Ad, Ak, Aa, Ap, Aw, Bd, Bk, Ba, Bp, Bw; float Av0, Av1, Bv0, Bv1; f32x2 Ac, Bc;
            RW_LOAD(A, 0);
#pragma unroll 1
            for (int t = 0; t < 32; t += 2) {
                RW_LOAD(B, 1);
                RW_STEP(A, 0);
                py += ystep >> 1;
                if (t + 2 < 32) RW_LOAD(A, 2);
                RW_STEP(B, 0);
                py += ystep >> 1; p1 += 512; p2 += 512; p3 += 32;
            }
#undef RW_LOAD
#undef RW_STEP
        }
        __syncthreads();
        {
            const int o4 = (tl16 * 64 + 4 * jq) * 4;
            const f32x4 y = *(const LAS f32x4*)(L + RW_YO + o4), vv = *(const LAS f32x4*)(L + RW_V + o4), gg = *(const LAS f32x4*)(L + RW_G + o4);
            const float mean = red16((y[0] + y[1]) + (y[2] + y[3])) * (1.0f / 64.0f);
            const f32x4 dd = y - mean;
            const float var = red16((dd[0] * dd[0] + dd[1] * dd[1]) + (dd[2] * dd[2] + dd[3] * dd[3])) * (1.0f / 64.0f);
            const float rs = rsqrtf(var + 64e-5f), c3 = ((const LAS float*)(L + RW_SC))[tl16 * 4 + 2];
            const f32x4 ov = (dd * rs * gngv + gnbv + vv * c3) * gg;
            u32x2 w; w.x = pk2(ov[0], ov[1]); w.y = pk2(ov[2], ov[3]);
            *(u32x2*)(Y + ((size_t)b * SEQ + t0 + tl16) * D + 512 + hc4) = w;
        }
        __syncthreads();
    }
}
namespace rw2 {
constexpr int SETB = 33024, S_DEC = 0, S_KK = 4096, S_KKA = 8192, S_KP = 12288, S_WR = 16384, S_V = 20480, S_G = 24576, S_YO = 28672, S_SC = 32768;
constexpr int STG_R = 66048, STG_K = 70144, LINB = 74240, LINW = 2112, LINP = 264, MU = 82688, LW2 = 84480, LA2 = 93696, LG2 = 102912, DUMMY = 120320;
constexpr int NCH = SEQ / 16;
__device__ __forceinline__ float red8(float v) { v += dpp_f<0xB1>(v); v += dpp_f<0x4E>(v); v += dpp_f<0x141>(v); return v; }
struct RegA { u32x4 cur[4], prev[4]; };
__device__ __forceinline__ int piece_pc(int ch, int h) { return ch < 8 ? 64 * h + 8 * ch : (ch < 16 ? 512 + 64 * h + 8 * (ch - 8) : (ch < 24 ? 1024 + 64 * h + 8 * (ch - 16) : 1536 + 8 * (ch - 24))); }
__device__ __forceinline__ void loadA(RegA& A, const bf16* PB, int b, int h, int t0, int pw, int lane) {
#pragma unroll
    for (int i = 0; i < 4; ++i) {
        const int idx = lane + 64 * i;
        if (idx < 224) {
            const int tl = idx / 56, ch = idx - tl * 56; const int t = t0 + 4 * pw + tl;
            const bf16* p = PB + ((size_t)b * SEQ + t) * IN0 + 1024 + piece_pc(ch, h);
            A.cur[i] = *(const u32x4*)p;
            A.prev[i] = t > 0 ? *(const u32x4*)(p - IN0) : (u32x4){0u, 0u, 0u, 0u};
        }
    }
}
__device__ __forceinline__ void item(const Frame& F, int b, int h) {
    LAS unsigned char* L = (LAS unsigned char*)F.lds;
    const bf16* PB = wsp<bf16>(F, WS_PB); bf16* Y = wsp<bf16>(F, WS_YB);
    int tid = F.tid; asm volatile("" : "+v"(tid));
    const int lane = tid & 63, wave = F.wave;
    {
        const float* mu = F.in[7];
        if (tid < 112) { const int ch = tid >> 1, hf = tid & 1; *(LAS f32x4*)(L + MU + ch * 32 + hf * 16) = *(const f32x4*)(mu + piece_pc(ch, h) + 4 * hf); }
        { const int row = tid >> 3, c8 = tid & 7;
          *(LAS u32x4*)(L + LW2 + (row * 72 + c8 * 8) * 2) = *(const u32x4*)(wsp<bf16>(F, WT_W2) + (size_t)(64 * h + row) * 64 + c8 * 8);
          *(LAS u32x4*)(L + LA2 + (row * 72 + c8 * 8) * 2) = *(const u32x4*)(wsp<bf16>(F, WT_A2) + (size_t)(64 * h + row) * 64 + c8 * 8); }
#pragma unroll
        for (int i = 0; i < 2; ++i) { const int id = tid + NTHR * i, row = id >> 4, c16 = id & 15;
          *(LAS u32x4*)(L + LG2 + (row * 136 + c16 * 8) * 2) = *(const u32x4*)(wsp<bf16>(F, WT_G2) + (size_t)(64 * h + row) * 128 + c16 * 8); }
        __syncthreads();
    }
    if (wave < 4) {
        const int q8 = lane & 7, i0 = 16 * wave + (lane >> 3);
        f32x2 s0[4], s1[4];
#pragma unroll
        for (int j = 0; j < 4; ++j) { s0[j] = (f32x2){0.f, 0.f}; s1[j] = (f32x2){0.f, 0.f}; }
        const int yreal = q8 == 0;
        __syncthreads();
#define RW2_LOAD(B, o) do { \
            B##d0 = *(const LAS f32x4*)(p1 + S_DEC + (o) * 256); B##d1 = *(const LAS f32x4*)(p1 + S_DEC + 16 + (o) * 256); \
            B##k0 = *(const LAS f32x4*)(p1 + S_KK + (o) * 256);  B##k1 = *(const LAS f32x4*)(p1 + S_KK + 16 + (o) * 256); \
            B##a0 = *(const LAS f32x4*)(p1 + S_KKA + (o) * 256); B##a1 = *(const LAS f32x4*)(p1 + S_KKA + 16 + (o) * 256); \
            B##p0 = *(const LAS f32x4*)(p1 + S_KP + (o) * 256);  B##p1 = *(const LAS f32x4*)(p1 + S_KP + 16 + (o) * 256); \
            B##w0 = *(const LAS f32x4*)(p1 + S_WR + (o) * 256);  B##w1 = *(const LAS f32x4*)(p1 + S_WR + 16 + (o) * 256); \
            B##v0 = *(const LAS float*)(p2 + (o) * 256); B##v1 = *(const LAS float*)(p2 + 32 + (o) * 256); B##c = *(const LAS f32x2*)(p3 + (o) * 16); } while (0)
#define RW2_DOT(S, X0, X1) ({ f32x2 t_ = S[0] * (f32x2){X0[0], X0[1]}; t_ = S[1] * (f32x2){X0[2], X0[3]} + t_; t_ = S[2] * (f32x2){X1[0], X1[1]} + t_; t_ = S[3] * (f32x2){X1[2], X1[3]} + t_; t_.x + t_.y; })
#define RW2_UPD(S, SA, V, B) do { \
            S[0] = S[0] * (f32x2){B##d0[0], B##d0[1]} - (f32x2){B##a0[0], B##a0[1]} * SA + (f32x2){B##p0[0], B##p0[1]} * V; \
            S[1] = S[1] * (f32x2){B##d0[2], B##d0[3]} - (f32x2){B##a0[2], B##a0[3]} * SA + (f32x2){B##p0[2], B##p0[3]} * V; \
            S[2] = S[2] * (f32x2){B##d1[0], B##d1[1]} - (f32x2){B##a1[0], B##a1[1]} * SA + (f32x2){B##p1[0], B##p1[1]} * V; \
            S[3] = S[3] * (f32x2){B##d1[2], B##d1[3]} - (f32x2){B##a1[2], B##a1[3]} * SA + (f32x2){B##p1[2], B##p1[3]} * V; } while (0)
#define RW2_STEP(B, yo) do { \
            const float sa0 = red8(RW2_DOT(s0, B##k0, B##k1)), sa1 = red8(RW2_DOT(s1, B##k0, B##k1)), yy0 = red8(RW2_DOT(s0, B##w0, B##w1)), yy1 = red8(RW2_DOT(s1, B##w0, B##w1)); \
            RW2_UPD(s0, sa0, B##v0, B); RW2_UPD(s1, sa1, B##v1, B); \
            *(LAS float*)(py + (yo)) = yy0 - sa0 * B##c.x + B##v0 * B##c.y; *(LAS float*)(py + (yo) + 32) = yy1 - sa1 * B##c.x + B##v1 * B##c.y; } while (0)
#pragma unroll 1
        for (int c = 0; c < NCH; ++c) {
            const LAS unsigned char* sb = L + (c & 1) * SETB;
            const LAS unsigned char* p1 = sb + 32 * q8;
            const LAS unsigned char* p2 = sb + S_V + 4 * i0;
            const LAS unsigned char* p3 = sb + S_SC;
            LAS unsigned char* py = yreal ? (LAS unsigned char*)sb + S_YO + 4 * i0 : L + DUMMY + (tid >> 3) * 64 + (tid & 7) * 4;
            const int ystep = yreal ? 256 : 0;
            f32x4 Ad0, Ad1, Ak0, Ak1, Aa0, Aa1, Ap0, Ap1, Aw0, Aw1, Bd0, Bd1, Bk0, Bk1, Ba0, Ba1, Bp0, Bp1, Bw0, Bw1; float Av0, Av1, Bv0, Bv1; f32x2 Ac, Bc;
            RW2_LOAD(A, 0);
#pragma unroll 1
            for (int t = 0; t < 16; t += 2) {
                RW2_LOAD(B, 1);
                RW2_STEP(A, 0);
                py += ystep;
                if (t + 2 < 16) RW2_LOAD(A, 2);
                RW2_STEP(B, 0);
                py += ystep; p1 += 512; p2 += 512; p3 += 32;
            }
            asm volatile("s_waitcnt lgkmcnt(0)" ::: "memory");
            __syncthreads();
        }
#undef RW2_LOAD
#undef RW2_DOT
#undef RW2_UPD
#undef RW2_STEP
        __syncthreads();
    } else {
        const int pw = wave - 4, jq = lane & 15, tk = lane >> 4, tl = 4 * pw + tk;
        const int hc4 = 64 * h + 4 * jq;
        const f32x4 w0v = *(const f32x4*)(F.in[8] + hc4), a0v = *(const f32x4*)(F.in[10] + hc4), kkv = *(const f32x4*)(F.in[13] + hc4), kav = *(const f32x4*)(F.in[14] + hc4), rkv = *(const f32x4*)(F.in[15] + hc4),
                    gngv = *(const f32x4*)(F.in[16] + hc4), gnbv = *(const f32x4*)(F.in[17] + hc4);
        const int fr = lane & 15, fq = lane >> 4;
        LAS unsigned char* stR = L + STG_R + pw * 1024; LAS unsigned char* stK = L + STG_K + pw * 1024; LAS unsigned char* lin = L + LINB + pw * LINW;
        RegA A; loadA(A, PB, b, h, 0, pw, lane);
#define RW2_PREP(c_) do { \
            LAS unsigned char* sb = L + ((c_) & 1) * SETB; \
            _Pragma("unroll") for (int i = 0; i < 4; ++i) { \
                const int idx = lane + 64 * i; \
                if (idx < 224) { \
                    const int tl_ = idx / 56, ch = idx - tl_ * 56; \
                    const f32x4 m0 = *(const LAS f32x4*)(L + MU + ch * 32), m1 = *(const LAS f32x4*)(L + MU + ch * 32 + 16); \
                    float xs[8]; \
                    _Pragma("unroll") for (int j = 0; j < 4; ++j) { \
                        const float c0 = bf2f(A.cur[i][j] & 0xffffu), c1 = bf2f(A.cur[i][j] >> 16), p0 = bf2f(A.prev[i][j] & 0xffffu), p1 = bf2f(A.prev[i][j] >> 16); \
                        const float mA = j < 2 ? m0[2 * j] : m1[2 * j - 4], mB = j < 2 ? m0[2 * j + 1] : m1[2 * j - 3]; \
                        xs[2 * j] = c0 + (p0 - c0) * mA; xs[2 * j + 1] = c1 + (p1 - c1) * mB; } \
                    if (ch < 24) { \
                        LAS float* dst = ch < 8 ? (LAS float*)stR + tl_ * 64 + 8 * ch : (ch < 16 ? (LAS float*)stK + tl_ * 64 + 8 * (ch - 8) : (LAS float*)(sb + S_V) + (4 * pw + tl_) * 64 + 8 * (ch - 16)); \
                        *(LAS f32x4*)dst = (f32x4){xs[0], xs[1], xs[2], xs[3]}; *(LAS f32x4*)(dst + 4) = (f32x4){xs[4], xs[5], xs[6], xs[7]}; \
                    } else { \
                        const int lc = ch - 24; \
                        if (lc < 8) { _Pragma("unroll") for (int j = 0; j < 8; ++j) xs[j] = 1.0f - 2.0f * rcpf_(1.0f + __expf(2.0f * xs[j])); } \
                        else if (lc >= 16) { _Pragma("unroll") for (int j = 0; j < 8; ++j) xs[j] = sigmoidf_(xs[j]); } \
                        u32x4 w_; w_.x = pk2(xs[0], xs[1]); w_.y = pk2(xs[2], xs[3]); w_.z = pk2(xs[4], xs[5]); w_.w = pk2(xs[6], xs[7]); \
                        *(LAS u32x4*)(lin + (tl_ * LINP + 8 * lc) * 2) = w_; } } } \
            if ((c_) + 1 < NCH) loadA(A, PB, b, h, 16 * ((c_) + 1), pw, lane); \
            LDS_FENCE(); \
            { const LAS unsigned char* arow = lin + ((fr & 3) * LINP + 8 * fq) * 2; \
              _Pragma("unroll") for (int nt = 0; nt < 4; ++nt) { \
                const LAS unsigned char* bw = L + LW2 + ((16 * nt + fr) * 72 + 8 * fq) * 2; const LAS unsigned char* ba = L + LA2 + ((16 * nt + fr) * 72 + 8 * fq) * 2; const LAS unsigned char* bg = L + LG2 + ((16 * nt + fr) * 136 + 8 * fq) * 2; \
                f32x4 cw = {0.f, 0.f, 0.f, 0.f}, ca = {0.f, 0.f, 0.f, 0.f}, cg = {0.f, 0.f, 0.f, 0.f}; \
                _Pragma("unroll") for (int ks = 0; ks < 2; ++ks) { \
                    cw = __builtin_amdgcn_mfma_f32_16x16x32_bf16(*(const LAS bf16x8*)(arow + 64 * ks), *(const LAS bf16x8*)(bw + 64 * ks), cw, 0, 0, 0); \
                    ca = __builtin_amdgcn_mfma_f32_16x16x32_bf16(*(const LAS bf16x8*)(arow + 128 + 64 * ks), *(const LAS bf16x8*)(ba + 64 * ks), ca, 0, 0, 0); } \
                _Pragma("unroll") for (int ks = 0; ks < 4; ++ks) cg = __builtin_amdgcn_mfma_f32_16x16x32_bf16(*(const LAS bf16x8*)(arow + 256 + 64 * ks), *(const LAS bf16x8*)(bg + 64 * ks), cg, 0, 0, 0); \
                if (fq == 0) { _Pragma("unroll") for (int r = 0; r < 4; ++r) { const int o = ((4 * pw + r) * 64 + 16 * nt + fr) * 4; \
                    *(LAS float*)(sb + S_DEC + o) = cw[r]; *(LAS float*)(sb + S_KKA + o) = ca[r]; *(LAS float*)(sb + S_G + o) = cg[r]; } } } } \
            LDS_FENCE(); \
            { const int o4 = (tl * 64 + 4 * jq) * 4, st4 = (tk * 64 + 4 * jq) * 4; \
              const f32x4 lw = *(const LAS f32x4*)(sb + S_DEC + o4), la = *(const LAS f32x4*)(sb + S_KKA + o4), kr = *(const LAS f32x4*)(stK + st4), r = *(const LAS f32x4*)(stR + st4); \
              f32x4 dec, a, kkr, kp; \
              _Pragma("unroll") for (int i = 0; i < 4; ++i) { \
                  const float nx = -(w0v[i] + lw[i]); const float sp = fmaxf(nx, 0.f) + __logf(1.0f + __expf(-fabsf(nx))); \
                  dec[i] = __expf(-__expf(-sp - 0.5f)); a[i] = sigmoidf_(a0v[i] + la[i]); kkr[i] = kr[i] * kkv[i]; kp[i] = kr[i] * (1.0f + (a[i] - 1.0f) * kav[i]); } \
              const float n2 = red16((kkr[0] * kkr[0] + kkr[1] * kkr[1]) + (kkr[2] * kkr[2] + kkr[3] * kkr[3])); \
              const float inv = __builtin_amdgcn_rsqf(fmaxf(n2, 1e-24f)); const f32x4 kk = kkr * inv, kka = kk * a; \
              const float c1 = red16((kka[0] * r[0] + kka[1] * r[1]) + (kka[2] * r[2] + kka[3] * r[3])); \
              const float c2 = red16((kp[0] * r[0] + kp[1] * r[1]) + (kp[2] * r[2] + kp[3] * r[3])); \
              const float c3 = red16((r[0] * kp[0] * rkv[0] + r[1] * kp[1] * rkv[1]) + (r[2] * kp[2] * rkv[2] + r[3] * kp[3] * rkv[3])); \
              *(LAS f32x4*)(sb + S_DEC + o4) = dec; *(LAS f32x4*)(sb + S_KK + o4) = kk; *(LAS f32x4*)(sb + S_KKA + o4) = kka; *(LAS f32x4*)(sb + S_KP + o4) = kp; *(LAS f32x4*)(sb + S_WR + o4) = dec * r; \
              if (jq == 0) { LAS float* sc = (LAS float*)(sb + S_SC) + tl * 4; sc[0] = c1; sc[1] = c2; sc[2] = c3; } } \
            LDS_FENCE(); } while (0)
#define RW2_POST(c_) do { \
            const LAS unsigned char* sb = L + ((c_) & 1) * SETB; const int o4 = (tl * 64 + 4 * jq) * 4; \
            const f32x4 y = *(const LAS f32x4*)(sb + S_YO + o4), vv = *(const LAS f32x4*)(sb + S_V + o4), gg = *(const LAS f32x4*)(sb + S_G + o4); \
            const float mean = red16((y[0] + y[1]) + (y[2] + y[3])) * (1.0f / 64.0f); const f32x4 dd = y - mean; \
            const float var = red16((dd[0] * dd[0] + dd[1] * dd[1]) + (dd[2] * dd[2] + dd[3] * dd[3])) * (1.0f / 64.0f); \
            const float rs = rsqrtf(var + 64e-5f), c3 = ((const LAS float*)(sb + S_SC))[tl * 4 + 2]; \
            const f32x4 ov = (dd * rs * gngv + gnbv + vv * c3) * gg; \
            u32x2 w_; w_.x = pk2(ov[0], ov[1]); w_.y = pk2(ov[2], ov[3]); \
            *(u32x2*)(Y + ((size_t)b * SEQ + 16 * (c_) + tl) * D + 512 + hc4) = w_; \
            LDS_FENCE(); } while (0)
        RW2_PREP(0);
        __syncthreads();
#pragma unroll 1
        for (int c = 0; c < NCH; ++c) {
            if (c >= 1) RW2_POST(c - 1);
            if (c + 1 < NCH) RW2_PREP(c + 1);
            __syncthreads();
        }
        RW2_POST(NCH - 1);
        __syncthreads();
#undef RW2_PREP
#undef RW2_POST
    }
}
}
namespace rw3 {
constexpr int V_ = 0, G_ = 8192, LWC = 16384, XK = 24576, XQ = 29184, YK = 33792, YR = 38400, QH = 43008, KH = 47616, VB = 52224, WCC = 56832, YO = 57344, SC3 = 65536, MU = 65792, RA = 67456;
constexpr int R_ = RA, K_ = RA + 8192, LIN = RA + 16384, LINP = 264, LW_ = RA + 33280, LA_ = RA + 41472;
constexpr int NF = RA, A1B = RA + 2048, B1T = RA + 3072, B2T = RA + 4096, TTT = RA + 5120, A1H = RA + 6144, KHT = RA + 8192, PT = RA + 18432, ZT = RA + 34816, RHT = RA + 38912, BHT = RA + 43008;
constexpr int CST = RA + 49664;
constexpr int XP = 144;
typedef short s16x4 __attribute__((ext_vector_type(4)));
typedef short v4i16_t __attribute__((ext_vector_type(4)));
__device__ __forceinline__ s16x4 vtr(const LAS unsigned char* p) { return __builtin_bit_cast(s16x4, __builtin_amdgcn_ds_read_tr16_b64_v4i16((LAS v4i16_t*)p)); }
template <int Q> __device__ __forceinline__ float quad_bcast(float v) { return __builtin_bit_cast(float, __builtin_amdgcn_update_dpp(0, __builtin_bit_cast(int, v), Q * 0x55, 0xF, 0xF, true)); }
__device__ __forceinline__ float ldbf(const LAS unsigned char* p) { return bf2f(*(const LAS unsigned short*)p); }
struct RegT { u32x2 rc, kc, vc, rp, kp, vp, w, a, g; };
__device__ __forceinline__ void loadT(RegT& R, const bf16* PB, const bf16* LO, int b, int h, int t0, int tid) {
    const int t = t0 + (tid >> 4), c = 64 * h + 4 * (tid & 15);
    const bf16* p = PB + ((size_t)b * SEQ + t) * IN0 + 1024 + c;
    R.rc = *(const u32x2*)p; R.kc = *(const u32x2*)(p + 512); R.vc = *(const u32x2*)(p + 1024);
    if (t > 0) { R.rp = *(const u32x2*)(p - IN0); R.kp = *(const u32x2*)(p - IN0 + 512); R.vp = *(const u32x2*)(p - IN0 + 1024); }
    else { R.rp = (u32x2){0u, 0u}; R.kp = (u32x2){0u, 0u}; R.vp = (u32x2){0u, 0u}; }
    const bf16* q = LO + ((size_t)b * SEQ + t) * 1536 + c;
    R.w = *(const u32x2*)q; R.a = *(const u32x2*)(q + 512); R.g = *(const u32x2*)(q + 1024);
}
__device__ __forceinline__ f32x4 unpk4(u32x2 v) { return (f32x4){bf2f(v.x & 0xffffu), bf2f(v.x >> 16), bf2f(v.y & 0xffffu), bf2f(v.y >> 16)}; }
__device__ __forceinline__ void item(const Frame& F, int b, int h) {
    LAS unsigned char* L = (LAS unsigned char*)F.lds;
    const bf16* PB = wsp<bf16>(F, WS_PB); bf16* Y = wsp<bf16>(F, WS_YB);
    int tid = F.tid; asm volatile("" : "+v"(tid));
    const int wave = F.wave;
    const int hc4 = 64 * h + 4 * (tid & 15);
    if (tid < 7 * 16) {
        const int which = tid >> 4, c4 = (tid & 15) * 4; const int src = which == 0 ? 8 : (which == 1 ? 10 : (which == 2 ? 13 : (which == 3 ? 14 : (which == 4 ? 15 : (which == 5 ? 16 : 17)))));
        *(LAS f32x4*)(L + CST + which * 256 + c4 * 4) = *(const f32x4*)(F.in[src] + 64 * h + c4);
    }
    if (tid < 48) { const int arr = tid >> 4, c4 = (tid & 15) * 4; *(LAS f32x4*)(L + MU + arr * 256 + c4 * 4) = *(const f32x4*)(F.in[7] + arr * 512 + 64 * h + c4); }
    f32x4 ST[4];
#pragma unroll
    for (int m = 0; m < 4; ++m) ST[m] = (f32x4){0.f, 0.f, 0.f, 0.f};
    const bf16* LO = (const bf16*)F.out;
    RegT Tn; loadT(Tn, PB, LO, b, h, 0, tid);
    unsigned idpk[4];
    { const int fr0 = tid & 15, fq0 = (tid & 63) >> 4;
#pragma unroll
      for (int p = 0; p < 4; ++p) { const bool lo_on = fq0 >= 2 && (8 * (fq0 - 2) + 2 * p == fr0), hi_on = fq0 >= 2 && (8 * (fq0 - 2) + 2 * p + 1 == fr0); idpk[p] = (lo_on ? 0x3F80u : 0u) | (hi_on ? 0x3F800000u : 0u); } }
    __syncthreads();
#pragma unroll 1
    for (int t0 = 0; t0 < SEQ; t0 += 32) {
        int tidl = tid; asm volatile("" : "+v"(tidl));
        const int lane = tidl & 63, fr = lane & 15, fq = lane >> 4;
        const int jq = lane & 15, tl = tidl >> 4;
        const int ch2 = tidl >> 8, x = tidl & 255;
        const RegT Tc = Tn;
        if (t0 + 32 < SEQ) loadT(Tn, PB, LO, b, h, t0 + 32, tid);
        const int o4 = (tl * 64 + 4 * jq) * 4, tloc = tl & 15, cb = tl & 16;
        f32x4 kap, qv, kp, rr, lw, vv;
        {
            const f32x4 w0v = *(const LAS f32x4*)(L + CST + 16 * jq), a0v = *(const LAS f32x4*)(L + CST + 256 + 16 * jq), kkv = *(const LAS f32x4*)(L + CST + 512 + 16 * jq), kav = *(const LAS f32x4*)(L + CST + 768 + 16 * jq), rkv = *(const LAS f32x4*)(L + CST + 1024 + 16 * jq);
            const f32x4 lwv = unpk4(Tc.w), la = unpk4(Tc.a);
            const f32x4 mr = *(const LAS f32x4*)(L + MU + 16 * jq), mk = *(const LAS f32x4*)(L + MU + 256 + 16 * jq), mv = *(const LAS f32x4*)(L + MU + 512 + 16 * jq);
            const f32x4 rcur = unpk4(Tc.rc), kcur = unpk4(Tc.kc), vcur = unpk4(Tc.vc);
            rr = rcur + (unpk4(Tc.rp) - rcur) * mr; const f32x4 kr = kcur + (unpk4(Tc.kp) - kcur) * mk; vv = vcur + (unpk4(Tc.vp) - vcur) * mv;
            f32x4 a, kkr;
#pragma unroll
            for (int i = 0; i < 4; ++i) {
                const float nx = -(w0v[i] + lwv[i]);
                const float sp = fmaxf(nx, 0.f) + __logf(1.0f + __expf(-fabsf(nx)));
                lw[i] = -__expf(-sp - 0.5f) * 1.4426950408889634f;
                a[i] = sigmoidf_(a0v[i] + la[i]);
                kkr[i] = kr[i] * kkv[i]; kp[i] = kr[i] * (1.0f + (a[i] - 1.0f) * kav[i]);
            }
            const float n2 = red16((kkr[0] * kkr[0] + kkr[1] * kkr[1]) + (kkr[2] * kkr[2] + kkr[3] * kkr[3]));
            kap = kkr * __builtin_amdgcn_rsqf(fmaxf(n2, 1e-24f)); qv = kap * a;
            const float c3 = red16((rr[0] * kp[0] * rkv[0] + rr[1] * kp[1] * rkv[1]) + (rr[2] * kp[2] * rkv[2] + rr[3] * kp[3] * rkv[3]));
            if (jq == 0) *(LAS float*)(L + SC3 + (t0 & 32) * 4 + tl * 4) = c3;
            *(LAS f32x4*)(L + LWC + o4) = lw;
        }
        __syncthreads();
        {
            f32x4 cl = {0.f, 0.f, 0.f, 0.f}, CL = {0.f, 0.f, 0.f, 0.f};
#pragma unroll
            for (int u = 0; u < 16; ++u) { const f32x4 v = *(const LAS f32x4*)(L + LWC + ((cb + u) * 64 + 4 * jq) * 4); CL += v; if (u <= tloc) cl += v; }
            f32x4 cw, icw, cwm1, wcr;
#pragma unroll
            for (int i = 0; i < 4; ++i) { cw[i] = __builtin_amdgcn_exp2f(cl[i]); icw[i] = __builtin_amdgcn_exp2f(-cl[i]); cwm1[i] = __builtin_amdgcn_exp2f(cl[i] - lw[i]); wcr[i] = __builtin_amdgcn_exp2f(CL[i] - cl[i]); }
            const f32x4 kt = cwm1 * kap, qt = qv * icw, kkt = kp * icw, rt = cw * rr, qh = qv * wcr, kh = kp * wcr;
            const int ob = tl * XP + 8 * jq;
#define RW3_ST4(base, v) do { u32x2 w_; w_.x = pk2(v[0], v[1]); w_.y = pk2(v[2], v[3]); *(LAS u32x2*)(L + (base) + ob) = w_; } while (0)
            RW3_ST4(XK, kkt); RW3_ST4(XQ, qt); RW3_ST4(YK, kt); RW3_ST4(YR, rt); RW3_ST4(QH, qh); RW3_ST4(KH, kh); RW3_ST4(VB, vv);
#undef RW3_ST4
            if (tloc == 15) { f32x4 wc; for (int i = 0; i < 4; ++i) wc[i] = __builtin_amdgcn_exp2f(CL[i]); *(LAS f32x4*)(L + WCC + ((cb >> 4) * 64 + 4 * jq) * 4) = wc; }
        }
        __syncthreads();
        const int gc = wave >> 2, wq = wave & 3;
        {
            const int tile = wq;
            const LAS unsigned char* ar = L + (tile == 0 ? YK : ((tile & 1) ? XQ : XK)) + (16 * gc + fr) * XP + 16 * fq;
            const LAS unsigned char* br = L + (tile == 0 ? XK : ((tile >> 1) ? YR : YK)) + (16 * gc + fr) * XP + 16 * fq;
            f32x4 acc = {0.f, 0.f, 0.f, 0.f};
#pragma unroll
            for (int ks = 0; ks < 2; ++ks) acc = __builtin_amdgcn_mfma_f32_16x16x32_bf16(*(const LAS bf16x8*)(ar + 64 * ks), *(const LAS bf16x8*)(br + 64 * ks), acc, 0, 0, 0);
            if (tile == 0) {
#pragma unroll
                for (int r = 0; r < 4; ++r) if (!(fr < 4 * fq + r)) acc[r] = 0.f;
                u32x2 w_; w_.x = pk2(acc[0], acc[1]); w_.y = pk2(acc[2], acc[3]); *(LAS u32x2*)(L + A1B + gc * 512 + fr * 32 + 8 * fq) = w_;
            } else if (tile == 1) {
#pragma unroll
                for (int r = 0; r < 4; ++r) *(LAS float*)(L + NF + gc * 1024 + ((4 * fq + r) * 16 + fr) * 4) = (4 * fq + r < fr) ? acc[r] : 0.f;
            } else {
#pragma unroll
                for (int r = 0; r < 4; ++r) if (!(4 * fq + r <= fr)) acc[r] = 0.f;
                u32x2 w_; w_.x = pk2(acc[0], acc[1]); w_.y = pk2(acc[2], acc[3]); *(LAS u32x2*)(L + (tile == 2 ? B1T : B2T) + gc * 512 + fr * 32 + 8 * fq) = w_;
            }
        }
        LDS_FENCE();
        if (wq == 1 && lane < 16) {
            const int x = lane; const int ch2 = gc;
            const LAS unsigned char* N = L + NF + ch2 * 1024;
            float Tc[16];
#pragma unroll
            for (int sI = 15; sI >= 0; --sI) {
                float acc0 = (sI == x) ? 1.f : 0.f, acc1 = 0.f;
#pragma unroll
                for (int u4 = 0; u4 < 4; ++u4) {
                    if (4 * u4 + 3 > sI) {
                        const f32x4 nv = *(const LAS f32x4*)(N + (sI * 16 + 4 * u4) * 4);
#pragma unroll
                        for (int i = 0; i < 4; ++i) { const int u = 4 * u4 + i; if (u > sI) { if (u & 1) acc1 -= nv[i] * Tc[u]; else acc0 -= nv[i] * Tc[u]; } }
                    }
                }
                Tc[sI] = acc0 + acc1;
            }
            u32x4 w0_, w1_;
#pragma unroll
            for (int i = 0; i < 4; ++i) { w0_[i] = pk2(Tc[2 * i], Tc[2 * i + 1]); w1_[i] = pk2(Tc[8 + 2 * i], Tc[8 + 2 * i + 1]); }
            *(LAS u32x4*)(L + TTT + ch2 * 512 + x * 32) = w0_; *(LAS u32x4*)(L + TTT + ch2 * 512 + x * 32 + 16) = w1_;
        }
        __syncthreads();
        const bf16x8 zero8 = (bf16x8){0, 0, 0, 0, 0, 0, 0, 0};
        const int trow = 8 * (fq & 1) + ((lane & 15) >> 2), tcol = 8 * (lane & 3);
        {
            bf16x8 tf = *(const LAS bf16x8*)(L + TTT + gc * 512 + fr * 32 + 16 * (fq & 1)); if (fq >= 2) tf = zero8;
            const LAS unsigned char* kb = L + YK + (16 * gc + trow) * XP + 32 * wq + tcol;
            const s16x4 lo = vtr(kb), hh = vtr(kb + 4 * XP);
            bf16x8 bv = (bf16x8){lo[0], lo[1], lo[2], lo[3], hh[0], hh[1], hh[2], hh[3]}; if (fq >= 2) bv = zero8;
            const f32x4 kh = __builtin_amdgcn_mfma_f32_16x16x32_bf16(tf, bv, (f32x4){0.f, 0.f, 0.f, 0.f}, 0, 0, 0);
            u32x2 w_; w_.x = pk2(kh[0], kh[1]); w_.y = pk2(kh[2], kh[3]); *(LAS u32x2*)(L + KHT + gc * 3072 + (16 * wq + fr) * 48 + 8 * fq) = w_;
            if (wq == 0) {
                bf16x8 a1 = *(const LAS bf16x8*)(L + A1B + gc * 512 + fr * 32 + 16 * (fq & 1)); if (fq >= 2) a1 = zero8;
                const f32x4 ah = __builtin_amdgcn_mfma_f32_16x16x32_bf16(tf, a1, (f32x4){0.f, 0.f, 0.f, 0.f}, 0, 0, 0);
                u32x2 v_; v_.x = pk2(-ah[0], -ah[1]); v_.y = pk2(-ah[2], -ah[3]); *(LAS u32x2*)(L + A1H + gc * 512 + fr * 32 + 8 * fq) = v_;
            }
        }
        __syncthreads();
        {
            const bf16x8 idp = __builtin_bit_cast(bf16x8, (u32x4){idpk[0], idpk[1], idpk[2], idpk[3]});
            const bf16x8 idn = __builtin_bit_cast(bf16x8, (u32x4){idpk[0] ^ 0x80008000u, idpk[1] ^ 0x80008000u, idpk[2] ^ 0x80008000u, idpk[3] ^ 0x80008000u});
            const bf16x8 kf = *(const LAS bf16x8*)(L + KHT + gc * 3072 + (16 * wq + fr) * 48 + 16 * (fq & 1));
            const bf16x8 b2 = *(const LAS bf16x8*)(L + B2T + gc * 512 + fr * 32 + 16 * (fq & 1));
            const bf16x8 a1h = *(const LAS bf16x8*)(L + A1H + gc * 512 + fr * 32 + 16 * (fq & 1));
            const bf16x8 bhop = *(const LAS bf16x8*)(L + (fq >= 2 ? B1T : B2T) + gc * 512 + fr * 32 + 16 * (fq & 1));
            const LAS unsigned char* qb = L + QH + (16 * gc + trow) * XP + tcol;
            s16x4 qlo[4], qhi[4];
#pragma unroll
            for (int nt = 0; nt < 4; ++nt) { qlo[nt] = vtr(qb + 32 * nt); qhi[nt] = vtr(qb + 32 * nt + 4 * XP); }
            const LAS unsigned char* rb = L + YR + (16 * gc + trow) * XP + 32 * wq + tcol;
            const s16x4 rlo = vtr(rb), rhi = vtr(rb + 4 * XP);
            const LAS unsigned char* zb = L + (fq >= 2 ? KH : QH) + (16 * gc + trow) * XP + 32 * wq + tcol;
            const s16x4 zlo = vtr(zb), zhi = vtr(zb + 4 * XP);
            float wcv[4];
#pragma unroll
            for (int nt = 0; nt < 4; ++nt) wcv[nt] = *(const LAS float*)(L + WCC + (gc * 64 + 16 * nt + fr) * 4);
            const bf16x8 af = fq >= 2 ? zero8 : kf;
            f32x4 pacc[4];
#pragma unroll
            for (int nt = 0; nt < 4; ++nt) {
                bf16x8 bv = (bf16x8){qlo[nt][0], qlo[nt][1], qlo[nt][2], qlo[nt][3], qhi[nt][0], qhi[nt][1], qhi[nt][2], qhi[nt][3]}; if (fq >= 2) bv = zero8;
                pacc[nt] = __builtin_amdgcn_mfma_f32_16x16x32_bf16(af, bv, (f32x4){0.f, 0.f, 0.f, 0.f}, 0, 0, 0);
            }
            const bf16x8 rfrag = (bf16x8){rlo[0], rlo[1], rlo[2], rlo[3], rhi[0], rhi[1], rhi[2], rhi[3]};
            const f32x4 racc = __builtin_amdgcn_mfma_f32_16x16x32_bf16(fq >= 2 ? rfrag : kf, fq >= 2 ? idn : b2, (f32x4){0.f, 0.f, 0.f, 0.f}, 0, 0, 0);
            const bf16x8 zop = fq >= 2 ? idp : a1h;
            const bf16x8 zbv = (bf16x8){zlo[0], zlo[1], zlo[2], zlo[3], zhi[0], zhi[1], zhi[2], zhi[3]};
            const f32x4 zacc = __builtin_amdgcn_mfma_f32_16x16x32_bf16(zop, zbv, (f32x4){0.f, 0.f, 0.f, 0.f}, 0, 0, 0);
            f32x4 bacc = {0.f, 0.f, 0.f, 0.f};
            if (wq == 0) bacc = __builtin_amdgcn_mfma_f32_16x16x32_bf16(zop, bhop, (f32x4){0.f, 0.f, 0.f, 0.f}, 0, 0, 0);
#pragma unroll
            for (int nt = 0; nt < 4; ++nt) {
                float pv_[4];
#pragma unroll
                for (int r = 0; r < 4; ++r) pv_[r] = -pacc[nt][r];
                if (wq == nt) {
#pragma unroll
                    for (int r = 0; r < 4; ++r) if (fr == 4 * fq + r) pv_[r] += wcv[nt]; }
                u32x2 w_; w_.x = pk2(pv_[0], pv_[1]); w_.y = pk2(pv_[2], pv_[3]);
                *(LAS u32x2*)(L + PT + gc * 8192 + ((nt * 2 + (wq >> 1)) * 16 + fr) * 64 + fq * 16 + (wq & 1) * 8) = w_;
            }
            { u32x2 w_; w_.x = pk2(-racc[0], -racc[1]); w_.y = pk2(-racc[2], -racc[3]); *(LAS u32x2*)(L + RHT + gc * 2048 + ((wq >> 1) * 16 + fr) * 64 + fq * 16 + (wq & 1) * 8) = w_; }
            { u32x2 w_; w_.x = pk2(zacc[0], zacc[1]); w_.y = pk2(zacc[2], zacc[3]); *(LAS u32x2*)(L + ZT + gc * 2048 + (16 * wq + fr) * 32 + 8 * fq) = w_; }
            if (wq == 0) { u32x2 w_; w_.x = pk2(bacc[0], bacc[1]); w_.y = pk2(bacc[2], bacc[3]); *(LAS u32x2*)(L + BHT + gc * 512 + fr * 32 + 8 * fq) = w_; }
        }
        __syncthreads();
        if (wave < 4) {
            bf16x8 pf[2][4][2], zf[2][4], rf[2][2], bfv[2], vb[2];
#pragma unroll
            for (int gcc = 0; gcc < 2; ++gcc) {
#pragma unroll
                for (int m = 0; m < 4; ++m) {
#pragma unroll
                    for (int ks = 0; ks < 2; ++ks) pf[gcc][m][ks] = *(const LAS bf16x8*)(L + PT + gcc * 8192 + ((m * 2 + ks) * 16 + fr) * 64 + fq * 16);
                    zf[gcc][m] = *(const LAS bf16x8*)(L + ZT + gcc * 2048 + (16 * m + fr) * 32 + 16 * (fq & 1)); if (fq >= 2) zf[gcc][m] = zero8;
                }
#pragma unroll
                for (int ks = 0; ks < 2; ++ks) rf[gcc][ks] = *(const LAS bf16x8*)(L + RHT + gcc * 2048 + (ks * 16 + fr) * 64 + fq * 16);
                bfv[gcc] = *(const LAS bf16x8*)(L + BHT + gcc * 512 + fr * 32 + 16 * (fq & 1)); if (fq >= 2) bfv[gcc] = zero8;
                const LAS unsigned char* vbp = L + VB + (16 * gcc + trow) * XP + 32 * wave + tcol;
                const s16x4 lo = vtr(vbp), hh = vtr(vbp + 4 * XP);
                vb[gcc] = (bf16x8){lo[0], lo[1], lo[2], lo[3], hh[0], hh[1], hh[2], hh[3]}; if (fq >= 2) vb[gcc] = zero8;
            }
            f32x4 zacc[2][4], yacc[2];
#pragma unroll
            for (int gcc = 0; gcc < 2; ++gcc) {
#pragma unroll
                for (int m = 0; m < 4; ++m) zacc[gcc][m] = __builtin_amdgcn_mfma_f32_16x16x32_bf16(zf[gcc][m], vb[gcc], (f32x4){0.f, 0.f, 0.f, 0.f}, 0, 0, 0);
                yacc[gcc] = __builtin_amdgcn_mfma_f32_16x16x32_bf16(bfv[gcc], vb[gcc], (f32x4){0.f, 0.f, 0.f, 0.f}, 0, 0, 0);
            }
#pragma unroll
            for (int gcc = 0; gcc < 2; ++gcc) {
                bf16x8 sb[2];
#pragma unroll
                for (int ks = 0; ks < 2; ++ks) { u32x4 w_; w_.x = pk2(ST[2 * ks][0], ST[2 * ks][1]); w_.y = pk2(ST[2 * ks][2], ST[2 * ks][3]); w_.z = pk2(ST[2 * ks + 1][0], ST[2 * ks + 1][1]); w_.w = pk2(ST[2 * ks + 1][2], ST[2 * ks + 1][3]); sb[ks] = __builtin_bit_cast(bf16x8, w_); }
#pragma unroll
                for (int m = 0; m < 4; ++m) {
                    f32x4 acc = __builtin_amdgcn_mfma_f32_16x16x32_bf16(pf[gcc][m][0], sb[0], zacc[gcc][m], 0, 0, 0);
                    ST[m] = __builtin_amdgcn_mfma_f32_16x16x32_bf16(pf[gcc][m][1], sb[1], acc, 0, 0, 0);
                }
                f32x4 ya = __builtin_amdgcn_mfma_f32_16x16x32_bf16(rf[gcc][0], sb[0], yacc[gcc], 0, 0, 0);
                ya = __builtin_amdgcn_mfma_f32_16x16x32_bf16(rf[gcc][1], sb[1], ya, 0, 0, 0);
#pragma unroll
                for (int r = 0; r < 4; ++r) *(LAS float*)(L + YO + ((16 * gcc + 4 * fq + r) * 64 + 16 * wave + fr) * 4) = ya[r];
            }
        }
        __syncthreads();
        {
            const f32x4 y = *(const LAS f32x4*)(L + YO + o4), gg = unpk4(Tc.g);
            const f32x4 gngv = *(const LAS f32x4*)(L + CST + 1280 + 16 * jq), gnbv = *(const LAS f32x4*)(L + CST + 1536 + 16 * jq);
            const float mean = red16((y[0] + y[1]) + (y[2] + y[3])) * (1.0f / 64.0f);
            const f32x4 dd = y - mean;
            const float var = red16((dd[0] * dd[0] + dd[1] * dd[1]) + (dd[2] * dd[2] + dd[3] * dd[3])) * (1.0f / 64.0f);
            const float rs = rsqrtf(var + 64e-5f), c3 = *(const LAS float*)(L + SC3 + (t0 & 32) * 4 + tl * 4);
            const f32x4 ov = (dd * rs * gngv + gnbv + vv * c3) * gg;
            u32x2 w; w.x = pk2(ov[0], ov[1]); w.y = pk2(ov[2], ov[3]);
            *(u32x2*)(Y + ((size_t)b * SEQ + t0 + tl) * D + 512 + hc4) = w;
        }
    }
    __syncthreads();
}
}
__device__ __forceinline__ void sgu_item(const Frame& F, int b, int c, int g) {
    float* VN = (float*)F.lds;
    const bf16* PB = wsp<bf16>(F, WS_PB); bf16* Y = wsp<bf16>(F, WS_YB);
    const float* ln_g = F.in[3]; const float* ln_b = F.in[4]; const float* w = F.in[5]; const float* bs = F.in[6];
    const int tid = F.tid, lane = F.lane, wave = F.wave; const size_t row0 = (size_t)b * SEQ + c * 128;
    for (int sI = wave; sI < 128; sI += NWAVES) {
        const bf16* pr = PB + (row0 + sI) * IN0 + 512 + 128 * g;
        const float v0 = bf2f(pr[lane]), v1 = bf2f(pr[lane + 64]);
        const float mean = wave_sum(v0 + v1) * (1.0f / 128.0f); const float d0 = v0 - mean, d1 = v1 - mean;
        const float var = wave_sum(d0 * d0 + d1 * d1) * (1.0f / 128.0f); const float rs = rsqrtf(var + 1e-5f);
        VN[sI * 132 + lane] = d0 * rs * ln_g[128 * g + lane] + ln_b[128 * g + lane];
        VN[sI * 132 + lane + 64] = d1 * rs * ln_g[128 * g + lane + 64] + ln_b[128 * g + lane + 64];
    }
    __syncthreads();
    const int t = tid >> 2, dq = tid & 3;
    f32x4 acc[8];
#pragma unroll
    for (int i = 0; i < 8; ++i) acc[i] = (f32x4){0.f, 0.f, 0.f, 0.f};
    const float* wrow = w + ((size_t)g * 128 + t) * 128;
    for (int sI = 0; sI <= t; ++sI) {
        const float ww = wrow[sI]; const f32x4* vr = (const f32x4*)&VN[sI * 132 + 32 * dq];
#pragma unroll
        for (int i = 0; i < 8; ++i) acc[i] += vr[i] * ww;
    }
    const float bias = bs[g * 128 + t];
    const bf16* ur = PB + (row0 + t) * IN0 + 128 * g + 32 * dq; bf16* yr = Y + (row0 + t) * D + 128 * g + 32 * dq;
#pragma unroll
    for (int i = 0; i < 8; ++i) {
        const u32x2 uu = *(const u32x2*)(ur + 4 * i);
        const float o0 = (acc[i][0] + bias) * bf2f(uu.x & 0xffffu), o1 = (acc[i][1] + bias) * bf2f(uu.x >> 16), o2 = (acc[i][2] + bias) * bf2f(uu.y & 0xffffu), o3 = (acc[i][3] + bias) * bf2f(uu.y >> 16);
        u32x2 wv; wv.x = pk2(o0, o1); wv.y = pk2(o2, o3); *(u32x2*)(yr + 4 * i) = wv;
    }
    __syncthreads();
}
__device__ __forceinline__ void p_lora(const Frame& F) {
    LAS unsigned char* L = (LAS unsigned char*)F.lds;
    constexpr int LINP = 264;
    const bf16* PB = wsp<bf16>(F, WS_PB); bf16* LO = (bf16*)F.out; const float* mu = F.in[7];
    int tid = F.tid; asm volatile("" : "+v"(tid));
    const int lane = tid & 63, wave = F.wave, fr = lane & 15, fq = lane >> 4;
    for (int it = F.blk; it < NTOK / 32; it += F.G) {
        const size_t tok0 = (size_t)it * 32; const int t0 = (int)(tok0 & (SEQ - 1));
#pragma unroll
        for (int i = 0; i < 2; ++i) {
            const int idx = tid + NTHR * i, tl = idx >> 5, lc = idx & 31, pc = 1536 + 8 * lc;
            const bf16* p = PB + (tok0 + tl) * IN0 + 1024 + pc;
            const u32x4 cur = *(const u32x4*)p; const u32x4 prev = (t0 + tl) > 0 ? *(const u32x4*)(p - IN0) : (u32x4){0u, 0u, 0u, 0u};
            const f32x4 m0 = *(const f32x4*)(mu + pc), m1 = *(const f32x4*)(mu + pc + 4);
            float xs[8];
#pragma unroll
            for (int j = 0; j < 4; ++j) {
                const float c0 = bf2f(cur[j] & 0xffffu), c1 = bf2f(cur[j] >> 16), p0 = bf2f(prev[j] & 0xffffu), p1 = bf2f(prev[j] >> 16);
                const float mA = j < 2 ? m0[2 * j] : m1[2 * j - 4], mB = j < 2 ? m0[2 * j + 1] : m1[2 * j - 3];
                xs[2 * j] = c0 + (p0 - c0) * mA; xs[2 * j + 1] = c1 + (p1 - c1) * mB;
            }
            if (lc < 8) {
#pragma unroll
                for (int j = 0; j < 8; ++j) xs[j] = 1.0f - 2.0f * rcpf_(1.0f + __expf(2.0f * xs[j]));
            } else if (lc >= 16) {
#pragma unroll
                for (int j = 0; j < 8; ++j) xs[j] = sigmoidf_(xs[j]);
            }
            u32x4 w; w.x = pk2(xs[0], xs[1]); w.y = pk2(xs[2], xs[3]); w.z = pk2(xs[4], xs[5]); w.w = pk2(xs[6], xs[7]);
            *(LAS u32x4*)(L + (tl * LINP + 8 * lc) * 2) = w;
        }
        __syncthreads();
#pragma unroll
        for (int lr = 0; lr < 3; ++lr) {
            const int KS = lr == 2 ? 4 : 2, wk = lr == 2 ? 128 : 64, lcol = lr == 0 ? 0 : (lr == 1 ? 64 : 128);
            const bf16* wt = wsp<bf16>(F, lr == 0 ? WT_W2 : (lr == 1 ? WT_A2 : WT_G2));
            bf16x8 af[4][4];
#pragma unroll
            for (int nt = 0; nt < 4; ++nt)
#pragma unroll
                for (int ks = 0; ks < 4; ++ks) if (ks < KS) af[nt][ks] = *(const bf16x8*)(wt + (size_t)(64 * wave + 16 * nt + fr) * wk + 32 * ks + 8 * fq);
#pragma unroll
            for (int nt = 0; nt < 4; ++nt) {
                const int n0 = 64 * wave + 16 * nt;
                f32x4 acc0 = {0.f, 0.f, 0.f, 0.f}, acc1 = {0.f, 0.f, 0.f, 0.f};
#pragma unroll
                for (int ks = 0; ks < 4; ++ks) if (ks < KS) {
                    acc0 = __builtin_amdgcn_mfma_f32_16x16x32_bf16(af[nt][ks], *(const LAS bf16x8*)(L + (fr * LINP + lcol + 32 * ks + 8 * fq) * 2), acc0, 0, 0, 0);
                    acc1 = __builtin_amdgcn_mfma_f32_16x16x32_bf16(af[nt][ks], *(const LAS bf16x8*)(L + ((16 + fr) * LINP + lcol + 32 * ks + 8 * fq) * 2), acc1, 0, 0, 0);
                }
                u32x2 w0, w1; w0.x = pk2(acc0[0], acc0[1]); w0.y = pk2(acc0[2], acc0[3]); w1.x = pk2(acc1[0], acc1[1]); w1.y = pk2(acc1[2], acc1[3]);
                *(u32x2*)(LO + (tok0 + fr) * 1536 + lr * 512 + n0 + 4 * fq) = w0;
                *(u32x2*)(LO + (tok0 + 16 + fr) * 1536 + lr * 512 + n0 + 4 * fq) = w1;
            }
        }
        __syncthreads();
    }
}
__device__ __forceinline__ void sgu_item_mfma(const Frame& F, int b, int c, int g) {
    LAS unsigned char* L = (LAS unsigned char*)F.lds;
    constexpr int VNT = 0, VP = 272, OUTB = 34816, OP = 132;
    const bf16* PB = wsp<bf16>(F, WS_PB); bf16* Y = wsp<bf16>(F, WS_YB);
    const float* ln_g = F.in[3]; const float* ln_b = F.in[4]; const float* bs = F.in[6];
    int tid = F.tid; asm volatile("" : "+v"(tid));
    const int lane = tid & 63, wave = F.wave, fr = lane & 15, fq = lane >> 4; const size_t row0 = (size_t)b * SEQ + c * 128;
    {
        const int sI = tid >> 2, dq = tid & 3;
        const bf16* pr = PB + (row0 + sI) * IN0 + 512 + 128 * g + 32 * dq;
        u32x4 raw[4];
#pragma unroll
        for (int i = 0; i < 4; ++i) raw[i] = *(const u32x4*)(pr + 8 * i);
        float v[32]; float sum = 0.f;
#pragma unroll
        for (int i = 0; i < 4; ++i)
#pragma unroll
            for (int j = 0; j < 4; ++j) { v[8 * i + 2 * j] = bf2f(raw[i][j] & 0xffffu); v[8 * i + 2 * j + 1] = bf2f(raw[i][j] >> 16); sum += v[8 * i + 2 * j] + v[8 * i + 2 * j + 1]; }
        sum += dpp_f<0xB1>(sum); sum += dpp_f<0x4E>(sum);
        const float mean = sum * (1.0f / 128.0f); float sq = 0.f;
#pragma unroll
        for (int i = 0; i < 32; ++i) { v[i] -= mean; sq += v[i] * v[i]; }
        sq += dpp_f<0xB1>(sq); sq += dpp_f<0x4E>(sq);
        const float rs = rsqrtf(sq * (1.0f / 128.0f) + 1e-5f);
        const float* lgp = ln_g + 128 * g + 32 * dq; const float* lbp = ln_b + 128 * g + 32 * dq;
#pragma unroll
        for (int i4 = 0; i4 < 8; ++i4) {
            const f32x4 gg = *(const f32x4*)(lgp + 4 * i4), bb = *(const f32x4*)(lbp + 4 * i4);
#pragma unroll
            for (int i = 0; i < 4; ++i) *(LAS unsigned short*)(L + VNT + (32 * dq + 4 * i4 + i) * VP + 2 * sI) = (unsigned short)f2bf(v[4 * i4 + i] * rs * gg[i] + bb[i]);
        }
    }
    __syncthreads();
    {
        const bf16* wm = wsp<bf16>(F, WT_SGU) + ((size_t)g * 128 + 16 * wave + fr) * 128 + 8 * fq;
        f32x4 acc[8];
#pragma unroll
        for (int n = 0; n < 8; ++n) acc[n] = (f32x4){0.f, 0.f, 0.f, 0.f};
        const int nks = (wave >> 1) + 1;
        for (int ks = 0; ks < nks; ++ks) {
            const bf16x8 af = *(const bf16x8*)(wm + 32 * ks);
#pragma unroll
            for (int n = 0; n < 8; ++n) acc[n] = __builtin_amdgcn_mfma_f32_16x16x32_bf16(af, *(const LAS bf16x8*)(L + VNT + (16 * n + fr) * VP + (32 * ks + 8 * fq) * 2), acc[n], 0, 0, 0);
        }
#pragma unroll
        for (int n = 0; n < 8; ++n)
#pragma unroll
            for (int r = 0; r < 4; ++r) *(LAS float*)(L + OUTB + ((16 * wave + 4 * fq + r) * OP + 16 * n + fr) * 4) = acc[n][r];
    }
    __syncthreads();
    {
        const int t = tid >> 2, dq = tid & 3; const float bias = bs[g * 128 + t];
        const bf16* ur = PB + (row0 + t) * IN0 + 128 * g + 32 * dq; bf16* yr = Y + (row0 + t) * D + 128 * g + 32 * dq;
#pragma unroll
        for (int i = 0; i < 4; ++i) {
            const u32x4 uu = *(const u32x4*)(ur + 8 * i);
            const f32x4 a0 = *(const LAS f32x4*)(L + OUTB + (t * OP + 32 * dq + 8 * i) * 4), a1 = *(const LAS f32x4*)(L + OUTB + (t * OP + 32 * dq + 8 * i + 4) * 4);
            u32x4 wv;
            wv.x = pk2((a0[0] + bias) * bf2f(uu.x & 0xffffu), (a0[1] + bias) * bf2f(uu.x >> 16)); wv.y = pk2((a0[2] + bias) * bf2f(uu.y & 0xffffu), (a0[3] + bias) * bf2f(uu.y >> 16));
            wv.z = pk2((a1[0] + bias) * bf2f(uu.z & 0xffffu), (a1[1] + bias) * bf2f(uu.z >> 16)); wv.w = pk2((a1[2] + bias) * bf2f(uu.w & 0xffffu), (a1[3] + bias) * bf2f(uu.w >> 16));
            *(u32x4*)(yr + 8 * i) = wv;
        }
    }
    __syncthreads();
}
__device__ __forceinline__ void p_mix0(const Frame& F) {
    if (F.G >= 256) {
#ifdef RW2_SCAN
        if (F.blk < 128) rw2::item(F, F.blk >> 3, F.blk & 7);
#else
        if (F.blk < 128) rw3::item(F, F.blk >> 3, F.blk & 7);
#endif
        else {
            const int nb = F.G - 128, c = F.blk - 128;
            for (int s = c; s < 1024; s += nb) sgu_item_mfma(F, s >> 6, (s >> 2) & 15, s & 3);
        }
        tr_queue(F, I_IN0, TR_LORA0);
    } else {
        for (int it = F.blk; it < 128 + 1024; it += F.G) {
            if (it < 128) rwkv_item(F, it >> 3, it & 7);
            else { const int s = it - 128; sgu_item(F, s >> 6, (s >> 2) & 15, s & 3); }
        }
        tr_range(F, I_IN0, TR_LORA0, F.blk * NWAVES + F.wave, F.G * NWAVES);
    }
}

__device__ __forceinline__ void p_nsa_prep(const Frame& F) {
    bf16* PB = wsp<bf16>(F, WS_PB); bf16* QR = wsp<bf16>(F, WS_QROT); bf16* Y = wsp<bf16>(F, WS_YB); const float* rope = wsp<float>(F, M_ROPE);
    const bool split = F.G >= 64;
    const int ncmp = split ? 32 : 0;
    const int gt = (F.blk - ncmp) * NTHR + F.tid, NGT = (F.G - ncmp) * NTHR;
    if (!split || F.blk >= 32) {
    for (int idx = gt; idx < NTOK * 12; idx += NGT) {
        const int row = idx / 12, j = idx - row * 12, t = row & (SEQ - 1);
        const f32x4* cs = (const f32x4*)(rope + t * 16); const f32x4 c0 = cs[0], c1 = cs[1], s0 = cs[2], s1 = cs[3];
        const bf16* src; bf16* dst;
        if (j < 8) { src = PB + (size_t)row * IN1P + C_Q + 64 * j; dst = QR + (size_t)row * 512 + 64 * j; }
        else if (j < 10) { src = PB + (size_t)row * IN1P + C_KS + 64 * (j - 8); dst = PB + (size_t)row * IN1P + C_KS + 64 * (j - 8); }
        else { src = PB + (size_t)row * IN1P + C_KW + 64 * (j - 10); dst = PB + (size_t)row * IN1P + C_KW + 64 * (j - 10); }
        const u32x4 a = *(const u32x4*)src, bq = *(const u32x4*)(src + 8);
        float x1[8], x2[8], o1[8], o2[8];
#pragma unroll
        for (int i = 0; i < 4; ++i) { x1[2 * i] = bf2f(a[i] & 0xffffu); x1[2 * i + 1] = bf2f(a[i] >> 16); x2[2 * i] = bf2f(bq[i] & 0xffffu); x2[2 * i + 1] = bf2f(bq[i] >> 16); }
#pragma unroll
        for (int i = 0; i < 8; ++i) { const float c = i < 4 ? c0[i & 3] : c1[i & 3], s = i < 4 ? s0[i & 3] : s1[i & 3]; o1[i] = x1[i] * c - x2[i] * s; o2[i] = x1[i] * s + x2[i] * c; }
        u32x4 w1, w2_;
#pragma unroll
        for (int i = 0; i < 4; ++i) { w1[i] = pk2(o1[2 * i], o1[2 * i + 1]); w2_[i] = pk2(o2[2 * i], o2[2 * i + 1]); }
        *(u32x4*)dst = w1; *(u32x4*)(dst + 8) = w2_;
        if (j < 8) {
#pragma unroll
            for (int i = 2; i < 8; ++i) *(u32x4*)(dst + 8 * i) = *(const u32x4*)(src + 8 * i);
        }
    }
    const float* cw = F.in[31];
    for (int idx = gt; idx < NTOK * 64; idx += NGT) {
        const int row = idx >> 6, c0 = (idx & 63) * 8, t = row & (SEQ - 1);
        float y[8];
#pragma unroll
        for (int i = 0; i < 8; ++i) y[i] = 0.f;
#pragma unroll
        for (int wq = 0; wq < 3; ++wq) {
            const int tt = t - 2 + wq;
            if (tt >= 0) {
                const size_t ro = (size_t)(row - 2 + wq) * IN1P;
                const u32x4 cg = *(const u32x4*)(PB + ro + C_CG + c0), hd = *(const u32x4*)(PB + ro + C_HD + c0);
                const f32x4 w0 = *(const f32x4*)(cw + wq * 512 + c0), w1 = *(const f32x4*)(cw + wq * 512 + c0 + 4);
#pragma unroll
                for (int i = 0; i < 4; ++i) {
                    const float z0 = bf2f(cg[i] & 0xffffu) * bf2f(hd[i] & 0xffffu), z1 = bf2f(cg[i] >> 16) * bf2f(hd[i] >> 16);
                    y[2 * i] += z0 * (i < 2 ? w0[2 * i] : w1[2 * i - 4]); y[2 * i + 1] += z1 * (i < 2 ? w0[2 * i + 1] : w1[2 * i - 3]);
                }
            }
        }
        const u32x4 bg = *(const u32x4*)(PB + (size_t)row * IN1P + C_BG + c0);
        u32x4 o;
#pragma unroll
        for (int i = 0; i < 4; ++i) o[i] = pk2(y[2 * i] * bf2f(bg[i] & 0xffffu), y[2 * i + 1] * bf2f(bg[i] >> 16));
        *(u32x4*)(Y + (size_t)row * D + 512 + c0) = o;
    }
    }
    if (!split || F.blk < 32) {
        Gemm g; g.A = PB; g.Bt = wsp<bf16>(F, WT_CK1); g.K = 2048; g.a_row = 16 * IN1P * 2; g.a_half = 64 * 2; g.a_k = IN1P * 2; g.b_row = 2048 * 2; g.b_half = 128 * 2048 * 2; g.b_k = 128;
        CmpOrder S; S.G = split ? 32 : F.G; S.c = F.blk;
        EpiCmp1 E{wsp<bf16>(F, M_HID), wsp<float>(F, M_C1)};
        gemm_run<7, EpiCmp1, CmpOrder>(F, g, S, E);
        asm volatile("s_waitcnt vmcnt(0)" ::: "memory");
        __threadfence_block();
        __syncthreads();
        Unit u;
        for (int i = 0; S.next(i, u); ++i) {
            const int which = u.pm >> 4, wid = F.wave, fr = F.lane & 15, fq = F.lane >> 4;
            const bf16* hid = wsp<bf16>(F, M_HID) + ((size_t)u.pm * 256 + 32 * wid) * 256;
            const bf16* w2 = wsp<bf16>(F, which ? WT_CV2 : WT_CK2);
            bf16* out = wsp<bf16>(F, which ? M_VCMP : M_KCMP) + ((size_t)(u.pm & 15) * 256 + 32 * wid) * 64;
            f32x4 acc[2][4];
#pragma unroll
            for (int m = 0; m < 2; ++m)
#pragma unroll
                for (int n = 0; n < 4; ++n) acc[m][n] = (f32x4){0.f, 0.f, 0.f, 0.f};
#pragma unroll 2
            for (int ks = 0; ks < 8; ++ks) {
                bf16x8 af[2], bfr[4];
#pragma unroll
                for (int m = 0; m < 2; ++m) af[m] = *(const bf16x8*)(hid + (size_t)(16 * m + fr) * 256 + 32 * ks + 8 * fq);
#pragma unroll
                for (int n = 0; n < 4; ++n) bfr[n] = *(const bf16x8*)(w2 + (size_t)(16 * n + fr) * 256 + 32 * ks + 8 * fq);
#pragma unroll
                for (int m = 0; m < 2; ++m)
#pragma unroll
                    for (int n = 0; n < 4; ++n) acc[m][n] = __builtin_amdgcn_mfma_f32_16x16x32_bf16(af[m], bfr[n], acc[m][n], 0, 0, 0);
            }
#pragma unroll
            for (int m = 0; m < 2; ++m)
#pragma unroll
                for (int n = 0; n < 4; ++n)
#pragma unroll
                    for (int r = 0; r < 4; ++r) out[(size_t)(16 * m + 4 * fq + r) * 64 + 16 * n + fr] = (bf16)(((32 * wid + 16 * m + 4 * fq + r) & 127) == 127 ? 0u : f2bf(acc[m][n][r]));
        }
    }
}
__device__ __forceinline__ void p_cmp2(const Frame& F) {
    const bf16* HID = wsp<bf16>(F, M_HID); const int gt = F.blk * NTHR + F.tid, NGT = F.G * NTHR;
    for (int idx = gt; idx < 2 * 4096 * 64; idx += NGT) {
        const int which = idx >> 18, r = (idx >> 6) & 4095, d = idx & 63;
        const bf16* hr = HID + ((size_t)which * 4096 + r) * 256; const bf16* w = wsp<bf16>(F, which ? WT_CV2 : WT_CK2) + d * 256;
        float s = 0.f;
        for (int k = 0; k < 256; k += 8) {
            const u32x4 a = *(const u32x4*)(hr + k), bq = *(const u32x4*)(w + k);
#pragma unroll
            for (int i = 0; i < 4; ++i) s += bf2f(a[i] & 0xffffu) * bf2f(bq[i] & 0xffffu) + bf2f(a[i] >> 16) * bf2f(bq[i] >> 16);
        }
        wsp<bf16>(F, which ? M_VCMP : M_KCMP)[(size_t)r * 64 + d] = (bf16)f2bf(s);
    }
}
constexpr float NEGBIG = -1e30f;
__device__ __forceinline__ void score64(const bf16* krow, const float* q4, float* scdst, bool valid) {
    float dot[4] = {0.f, 0.f, 0.f, 0.f};
#pragma unroll 1
    for (int hf = 0; hf < 4; ++hf) {
        float kf[16];
#pragma unroll
        for (int i = 0; i < 2; ++i) { const u32x4 a = *(const u32x4*)(krow + 16 * hf + 8 * i);
#pragma unroll
            for (int j = 0; j < 4; ++j) { kf[8 * i + 2 * j] = bf2f(a[j] & 0xffffu); kf[8 * i + 2 * j + 1] = bf2f(a[j] >> 16); } }
#pragma unroll
        for (int g = 0; g < 4; ++g) {
#pragma unroll
            for (int d4 = 0; d4 < 4; ++d4) { const f32x4 qv = *(const f32x4*)&q4[g * 64 + 16 * hf + 4 * d4]; dot[g] += kf[4 * d4] * qv.x + kf[4 * d4 + 1] * qv.y + kf[4 * d4 + 2] * qv.z + kf[4 * d4 + 3] * qv.w; }
        }
    }
#pragma unroll
    for (int g = 0; g < 4; ++g) scdst[g * 512] = valid ? dot[g] * 0.125f : NEGBIG;
}
__device__ __forceinline__ void softmax_rows(float* sc, int nblk, int lane) {
#pragma unroll
    for (int g = 0; g < 4; ++g) {
        float m = NEGBIG;
        for (int r = 0; r < nblk; ++r) m = fmaxf(m, sc[g * 512 + 64 * r + lane]);
        m = wave_max(m);
        float sum = 0.f;
        for (int r = 0; r < nblk; ++r) { const float sv = sc[g * 512 + 64 * r + lane]; const float e = sv > -1e29f ? __expf(sv - m) : 0.f; sc[g * 512 + 64 * r + lane] = e; sum += e; }
        sum = wave_sum(sum);
        const float inv = 1.0f / fmaxf(sum, 1e-30f);
        for (int r = 0; r < nblk; ++r) sc[g * 512 + 64 * r + lane] *= inv;
    }
}
__device__ __forceinline__ void p_attn_naive(const Frame& F) {
    float* wl = (float*)F.lds + F.wave * 2688;
    float* qn = wl, *qr = wl + 256, *sc = wl + 512;
    const bf16* PB = wsp<bf16>(F, WS_PB); const bf16* QR = wsp<bf16>(F, WS_QROT); bf16* Y = wsp<bf16>(F, WS_YB);
    const bf16* KC = wsp<bf16>(F, M_KCMP); const bf16* VC = wsp<bf16>(F, M_VCMP);
    const int lane = F.lane; const int gw = F.blk * NWAVES + F.wave, NGW = F.G * NWAVES;
    for (int item = gw; item < NTOK * 2; item += NGW) {
        const int bh = item >> 11, t = item & (SEQ - 1), b = bh >> 1, hkv = bh & 1; const size_t row = (size_t)b * SEQ + t;
        LDS_FENCE();
#pragma unroll
        for (int g = 0; g < 4; ++g) { qn[g * 64 + lane] = bf2f(PB[row * IN1P + C_Q + (hkv * 4 + g) * 64 + lane]); qr[g * 64 + lane] = bf2f(QR[row * 512 + (hkv * 4 + g) * 64 + lane]); }
        LDS_FENCE();
        float oc[4], os[4], ow[4];
        const int nv = t >= 31 ? ((t - 31) >> 4) + 1 : 0;
#pragma unroll
        for (int r = 0; r < 2; ++r) { const int n = lane + 64 * r; score64(KC + ((size_t)bh * 128 + n) * 64, qn, sc + n, n < nv); }
        LDS_FENCE();
        softmax_rows(sc, 2, lane);
        LDS_FENCE();
#pragma unroll
        for (int g = 0; g < 4; ++g) oc[g] = 0.f;
        for (int n = 0; n < nv; ++n) { const float v = bf2f(VC[((size_t)bh * 128 + n) * 64 + lane]);
#pragma unroll
            for (int g = 0; g < 4; ++g) oc[g] += sc[g * 512 + n] * v; }
        const int cur = t >> 6;
        float val = -3e38f;
        if (lane < 32) {
            float imp = 0.f;
#pragma unroll
            for (int dn = -1; dn <= 3; ++dn) { const int n = 4 * lane + dn; if (n >= 0 && n <= 126) imp += (sc[n] + sc[512 + n]) + (sc[1024 + n] + sc[1536 + n]); }
            const bool forced = lane == 0 || lane == cur || lane == cur - 1;
            val = (lane * 64 <= t) ? imp + (forced ? 1e6f : 0.f) : NEGBIG;
        }
        unsigned selmask = 0u;
        for (int it = 0; it < 8; ++it) {
            float best = val; int bj = lane;
#pragma unroll
            for (int o = 32; o >= 1; o >>= 1) { const float ov = __shfl_xor(best, o); const int oj = __shfl_xor(bj, o); if (ov > best || (ov == best && oj < bj)) { best = ov; bj = oj; } }
            if (best > -1e29f) selmask |= 1u << bj;
            if (lane == bj) val = -3e38f;
        }
        LDS_FENCE();
        int nsl = 0;
        for (unsigned mm = selmask; mm; mm &= mm - 1) { const int j = __ffs(mm) - 1; const int key = j * 64 + lane;
            score64(PB + ((size_t)b * SEQ + key) * IN1P + C_KS + hkv * 64, qr, sc + nsl * 64 + lane, key <= t); ++nsl; }
        LDS_FENCE();
        softmax_rows(sc, nsl, lane);
        LDS_FENCE();
#pragma unroll
        for (int g = 0; g < 4; ++g) os[g] = 0.f;
        { int sl = 0;
          for (unsigned mm = selmask; mm; mm &= mm - 1) { const int j = __ffs(mm) - 1;
              for (int kk = 0; kk < 64; ++kk) { const int key = j * 64 + kk; if (key > t) break;
                  const float v = bf2f(PB[((size_t)b * SEQ + key) * IN1P + C_VS + hkv * 64 + lane]);
#pragma unroll
                  for (int g = 0; g < 4; ++g) os[g] += sc[g * 512 + sl * 64 + kk] * v; }
              ++sl; } }
        LDS_FENCE();
#pragma unroll 1
        for (int kb = 0; kb < 8; ++kb) { const int key = t - 511 + 64 * kb + lane; const int keyc = key < 0 ? 0 : key;
            score64(PB + ((size_t)b * SEQ + keyc) * IN1P + C_KW + hkv * 64, qr, sc + kb * 64 + lane, key >= 0); }
        LDS_FENCE();
        softmax_rows(sc, 8, lane);
        LDS_FENCE();
#pragma unroll
        for (int g = 0; g < 4; ++g) ow[g] = 0.f;
        for (int p = (t >= 511 ? 0 : 511 - t); p < 512; ++p) { const int key = t - 511 + p;
            const float v = bf2f(PB[((size_t)b * SEQ + key) * IN1P + C_VW + hkv * 64 + lane]);
#pragma unroll
            for (int g = 0; g < 4; ++g) ow[g] += sc[g * 512 + p] * v; }
#pragma unroll
        for (int g = 0; g < 4; ++g) {
            const bf16* gl = PB + row * IN1P + C_GL + (hkv * 4 + g) * 3;
            const float o = sigmoidf_(bf2f(gl[0])) * oc[g] + sigmoidf_(bf2f(gl[1])) * os[g] + sigmoidf_(bf2f(gl[2])) * ow[g];
            Y[row * D + (hkv * 4 + g) * 64 + lane] = (bf16)f2bf(o);
        }
    }
}

namespace nsa {
typedef float f32x16 __attribute__((ext_vector_type(16)));
typedef short s16x4 __attribute__((ext_vector_type(4)));
typedef short v4i16_t __attribute__((ext_vector_type(4)));
typedef __bf16 bf16x2_t __attribute__((ext_vector_type(2)));
typedef LAS const char* lds_cptr;
constexpr int L_KV = 0, L_OV = 32768, L_IMP = 40960, L_WSF = 73728, L_SEL = 77824;
constexpr float C2 = 0.125f * 1.4426950408889634f, NEG = -1e30f;
__device__ __forceinline__ int crow(int r, int hi) { return (r & 3) + 8 * (r >> 2) + 4 * hi; }
__device__ __forceinline__ float max3f(float a_, float b_, float c_) { float r_; asm("v_max3_f32 %0, %1, %2, %3" : "=v"(r_) : "v"(a_), "v"(b_), "v"(c_)); return r_; }
__device__ __forceinline__ unsigned cvtpk(float lo, float hi) { f32x2 v = {lo, hi}; bf16x2_t b = __builtin_convertvector(v, bf16x2_t); return __builtin_bit_cast(unsigned, b); }
__device__ __forceinline__ s16x4 vtr(lds_cptr p) { return __builtin_bit_cast(s16x4, __builtin_amdgcn_ds_read_tr16_b64_v4i16((LAS v4i16_t*)p)); }
__device__ __forceinline__ void qkt(f32x16& p0, f32x16& p1, lds_cptr Kslot, const bf16x8* q, int r32, int hi) {
    lds_cptr kb = Kslot + hi * 1024 + r32 * 16;
    p0 = f32x16{}; p1 = f32x16{};
#pragma unroll
    for (int d0 = 0; d0 < 4; ++d0) {
        const bf16x8 b0 = *(const LAS bf16x8*)(kb + d0 * 2048), b1 = *(const LAS bf16x8*)(kb + d0 * 2048 + 512);
        p0 = __builtin_amdgcn_mfma_f32_32x32x16_bf16(b0, q[d0], p0, 0, 0, 0);
        p1 = __builtin_amdgcn_mfma_f32_32x32x16_bf16(b1, q[d0], p1, 0, 0, 0);
    }
}
__device__ __forceinline__ void pv32(f32x16& o, lds_cptr vp, const bf16x8* pa) {
#pragma unroll
    for (int ks = 0; ks < 4; ++ks) {
        const s16x4 lo = vtr(vp + ks * 1024), hh = vtr(vp + ks * 1024 + 512);
        const bf16x8 bv = (bf16x8){lo[0], lo[1], lo[2], lo[3], hh[0], hh[1], hh[2], hh[3]};
        o = __builtin_amdgcn_mfma_f32_32x32x16_bf16(pa[ks], bv, o, 0, 0, 0);
    }
}

struct Item { int b, hkv, bh, qb; };

template <int KIND>
__device__ __forceinline__ void branch(const Frame& F, const Item& it, LAS char* L, const bf16x8* q, const bf16* kbase, const bf16* vbase, int pitch, int blk0, int nsteps,
                                       float gate, unsigned selm, unsigned (&otp)[16]) {
    int tid = F.tid; asm volatile("" : "+v"(tid));
    const int lane = tid & 63, wid = F.wave, g = wid >> 1, qh = wid & 1;
    int r32 = lane & 31, hi = lane >> 5; asm volatile("" : "+v"(r32), "+v"(hi));
    const int ql = 32 * qh + r32, tq = it.qb * 64 + ql;
    LAS float* wsf = (LAS float*)(L + L_WSF) + wid * 128;
    float m2 = -1e20f, l = 0.f; f32x16 o0 = f32x16{}, o1 = f32x16{}, oe = f32x16{};
    const int nv = KIND == 0 ? (tq >= 31 ? ((tq - 31) >> 4) + 1 : 0) : 0;
    const size_t koff = (size_t)(tid & 63) * pitch + (tid >> 6) * 8, voff = (size_t)(16 * (wid & 3) + (lane >> 2)) * pitch + (wid >> 2) * 32 + (lane & 3) * 8;
    const int vlane = ((lane >> 4) & 1) * 32 + (lane & 3) * 8 + (4 * hi + ((lane & 15) >> 2)) * 64;
#define NSA_LOAD(KR, VR, blk_) do { KR = *(const u32x4*)(kbase + (size_t)(blk_) * 64 * pitch + koff); VR = *(const u32x4*)(vbase + (size_t)(blk_) * 64 * pitch + voff); } while (0)
#define NSA_STEP(KR, VR, s_) do { \
        const int blk = blk0 + (s_); LAS char* buf = L + L_KV + ((s_) & 1) * 16384; \
        *(LAS u32x4*)(buf + (tid >> 6) * 1024 + (tid & 63) * 16) = KR; *(LAS u32x4*)(buf + 8192 + wid * 1024 + lane * 16) = VR; \
        __syncthreads(); \
        if ((s_) + 1 < nsteps) NSA_LOAD(KR, VR, blk + 1); \
        const bool mine = KIND == 1 ? ((selm >> blk) & 1u) != 0u : true; \
        if (KIND != 1 || __any(mine)) { \
        f32x16 p0, p1; qkt(p0, p1, (lds_cptr)buf, q, r32, hi); \
        if (KIND == 0) { \
            const int kb0 = blk * 64 + 4 * hi; \
            _Pragma("unroll") for (int r = 0; r < 16; ++r) { const int key = kb0 + (r & 3) + 8 * (r >> 2); if (key >= nv) p0[r] = NEG; if (key + 32 >= nv) p1[r] = NEG; } \
        } else { \
            if (blk == it.qb) { _Pragma("unroll") for (int r = 0; r < 16; ++r) { const int kl = 4 * hi + (r & 3) + 8 * (r >> 2); if (kl > ql) p0[r] = NEG; if (kl + 32 > ql) p1[r] = NEG; } } \
            if (KIND == 2 && blk + 8 == it.qb) { _Pragma("unroll") for (int r = 0; r < 16; ++r) { const int kl = 4 * hi + (r & 3) + 8 * (r >> 2); if (kl <= ql) p0[r] = NEG; if (kl + 32 <= ql) p1[r] = NEG; } } \
        } \
        float rm = max3f(p0[0], p1[0], p0[1]); \
        _Pragma("unroll") for (int r = 1; r < 15; ++r) rm = max3f(rm, p1[r], p0[r + 1]); \
        rm = fmaxf(rm, p1[15]); \
        if (KIND == 1) rm = mine ? rm : NEG; \
        { auto rr_ = __builtin_amdgcn_permlane32_swap(__float_as_uint(rm), __float_as_uint(rm), false, false); rm = fmaxf(__uint_as_float(rr_[0]), __uint_as_float(rr_[1])); } \
        const float rm2 = rm * C2; \
        if (__any(rm2 > m2 + 8.0f)) { \
            const float mn = fmaxf(m2, rm2); const float alpha = __builtin_amdgcn_exp2f(m2 - mn); l *= alpha; m2 = mn; \
            LDS_FENCE(); \
            if (hi == 0) wsf[r32] = alpha; \
            LDS_FENCE(); \
            _Pragma("unroll") for (int r = 0; r < 16; ++r) { const float a_ = wsf[crow(r, hi)]; o0[r] *= a_; o1[r] *= a_; if (KIND == 0) oe[r] *= a_; } \
            LDS_FENCE(); \
        } \
        const float meff = (KIND == 1 && !mine) ? 1e30f : m2; \
        f32x2 sum2 = {0.f, 0.f}; \
        _Pragma("unroll") for (int r = 0; r < 16; r += 2) { \
            f32x2 a2 = (f32x2){p0[r], p0[r + 1]} * C2 - meff, b2 = (f32x2){p1[r], p1[r + 1]} * C2 - meff; \
            a2.x = __builtin_amdgcn_exp2f(a2.x); a2.y = __builtin_amdgcn_exp2f(a2.y); b2.x = __builtin_amdgcn_exp2f(b2.x); b2.y = __builtin_amdgcn_exp2f(b2.y); \
            p0[r] = a2.x; p0[r + 1] = a2.y; p1[r] = b2.x; p1[r + 1] = b2.y; sum2 += a2 + b2; } \
        l += sum2.x + sum2.y; \
        bf16x8 pa[4]; \
        _Pragma("unroll") for (int ks = 0; ks < 2; ++ks) { \
            u32x4 w0, w1; \
            _Pragma("unroll") for (int i = 0; i < 4; ++i) { w0[i] = cvtpk(p0[8 * ks + 2 * i], p0[8 * ks + 2 * i + 1]); w1[i] = cvtpk(p1[8 * ks + 2 * i], p1[8 * ks + 2 * i + 1]); } \
            pa[ks] = __builtin_bit_cast(bf16x8, w0); pa[2 + ks] = __builtin_bit_cast(bf16x8, w1); \
        } \
        lds_cptr vp = (lds_cptr)buf + 8192 + vlane; \
        pv32(o0, vp, pa); pv32(o1, vp + 4096, pa); \
        if (KIND == 0) pv32(oe, (lds_cptr)L + L_OV + blk * 4096 + vlane, pa); \
        } } while (0)
    u32x4 kA, vA;
    NSA_LOAD(kA, vA, blk0);
#pragma unroll 1
    for (int s = 0; s < nsteps; ++s) { NSA_STEP(kA, vA, s); }
#undef NSA_LOAD
#undef NSA_STEP
    float lt; { auto rr_ = __builtin_amdgcn_permlane32_swap(__float_as_uint(l), __float_as_uint(l), false, false); lt = __uint_as_float(rr_[0]) + __uint_as_float(rr_[1]); }
    const float inv = lt > 0.f ? 1.0f / lt : 0.f;
    LDS_FENCE();
    if (hi == 0) { wsf[r32] = gate * inv; wsf[32 + r32] = inv; }
    LDS_FENCE();
#pragma unroll
    for (int r = 0; r < 16; ++r) {
        const float a = wsf[crow(r, hi)]; otp[r] = cvtpk(bf2f(otp[r] & 0xffffu) + o0[r] * a, bf2f(otp[r] >> 16) + o1[r] * a);
        if (KIND == 0) ((LAS float*)(L + L_IMP))[(g * 64 + 32 * qh + crow(r, hi)) * 32 + r32] = oe[r] * wsf[32 + crow(r, hi)];
    }
    LDS_FENCE();
    __syncthreads();
}

__device__ __forceinline__ void attn_item(const Frame& F, const Item& it, LAS char* L) {
    const int tid = F.tid, lane = F.lane, wid = F.wave, g = wid >> 1, qh = wid & 1;
    int r32 = lane & 31, hi = lane >> 5; asm volatile("" : "+v"(r32), "+v"(hi));
    const bf16* PB = wsp<bf16>(F, WS_PB); const bf16* QR = wsp<bf16>(F, WS_QROT); bf16* Y = wsp<bf16>(F, WS_YB);
    const int head = it.hkv * 4 + g; const size_t rowq = (size_t)it.b * SEQ + it.qb * 64 + 32 * qh + r32;
    bf16x8 qn[4];
#pragma unroll
    for (int d0 = 0; d0 < 4; ++d0) qn[d0] = *(const bf16x8*)(PB + rowq * IN1P + C_Q + head * 64 + hi * 8 + d0 * 16);
    const bf16* glp = PB + rowq * IN1P + C_GL + head * 3;
    const float g0 = sigmoidf_(bf2f(glp[0])), g1 = sigmoidf_(bf2f(glp[1])), g2 = sigmoidf_(bf2f(glp[2]));
    unsigned otp[16];
#pragma unroll
    for (int r = 0; r < 16; ++r) otp[r] = 0u;
    branch<0>(F, it, L, qn, wsp<bf16>(F, M_KCMP) + (size_t)it.bh * 128 * 64, wsp<bf16>(F, M_VCMP) + (size_t)it.bh * 128 * 64, 64, 0, 2, g0, 0u, otp);
    {
        const int ql = tid >> 3, part = tid & 7;
        const LAS float* imp = (const LAS float*)(L + L_IMP) + ql * 32 + 4 * part;
        const f32x4 a = *(const LAS f32x4*)imp, b2 = *(const LAS f32x4*)(imp + 2048), c = *(const LAS f32x4*)(imp + 4096), d = *(const LAS f32x4*)(imp + 6144);
        float v[4];
#pragma unroll
        for (int i = 0; i < 4; ++i) { const int j = 4 * part + i; const bool forced = j == 0 || j == it.qb || j == it.qb - 1; v[i] = j <= it.qb ? ((a[i] + b2[i]) + (c[i] + d[i])) + (forced ? 1e6f : 0.f) : NEG; }
        unsigned mask = 0u;
#pragma unroll 1
        for (int k = 0; k < 8; ++k) {
            float best = v[0]; int bi = 4 * part;
#pragma unroll
            for (int i = 1; i < 4; ++i) if (v[i] > best) { best = v[i]; bi = 4 * part + i; }
#define NSA_MRG(CTRL) do { const float ov = __builtin_bit_cast(float, __builtin_amdgcn_update_dpp(0, __builtin_bit_cast(int, best), CTRL, 0xF, 0xF, true)); const int oj = __builtin_amdgcn_update_dpp(0, bi, CTRL, 0xF, 0xF, true); \
            if (ov > best || (ov == best && oj < bi)) { best = ov; bi = oj; } } while (0)
            NSA_MRG(0xB1); NSA_MRG(0x4E); NSA_MRG(0x141);
#undef NSA_MRG
            if (best > -1e29f) mask |= 1u << bi;
#pragma unroll
            for (int i = 0; i < 4; ++i) if (4 * part + i == bi) v[i] = -3e38f;
        }
        if (part == 0) ((LAS unsigned*)(L + L_SEL))[ql] = mask;
    }
    __syncthreads();
    const unsigned selm = ((const LAS unsigned*)(L + L_SEL))[32 * qh + r32];
    bf16x8 qr[4];
#pragma unroll
    for (int d0 = 0; d0 < 4; ++d0) qr[d0] = *(const bf16x8*)(QR + rowq * 512 + head * 64 + hi * 8 + d0 * 16);
    const bf16* rowb = PB + (size_t)it.b * SEQ * IN1P + it.hkv * 64;
    branch<1>(F, it, L, qr, rowb + C_KS, rowb + C_VS, IN1P, 0, it.qb + 1, g1, selm, otp);
    const int jlo = it.qb >= 8 ? it.qb - 8 : 0;
    branch<2>(F, it, L, qr, rowb + C_KW, rowb + C_VW, IN1P, jlo, it.qb - jlo + 1, g2, 0u, otp);
    bf16* yb = Y + ((size_t)it.b * SEQ + it.qb * 64 + 32 * qh) * D + head * 64 + r32;
#pragma unroll
    for (int r = 0; r < 16; ++r) { yb[(size_t)crow(r, hi) * D] = (bf16)(otp[r] & 0xffffu); yb[(size_t)crow(r, hi) * D + 32] = (bf16)(otp[r] >> 16); }
}
__device__ __forceinline__ void p_attn(const Frame& F) {
    LAS char* L = (LAS char*)F.lds;
    for (int idx = F.tid; idx < 4096; idx += NTHR) {
        const int bk = idx >> 11, nin = (idx >> 5) & 63, j = idx & 31, n = 64 * bk + nin;
        const bool ov = (n >= 4 * j - 1) && (n <= 4 * j + 3) && (n <= 126);
        *(LAS bf16*)(L + L_OV + bk * 4096 + nin * 64 + j * 2) = (bf16)(ov ? 0x3F80u : 0u);
    }
    __syncthreads();
    const int vcu = (F.G % 8 == 0) ? (F.blk % 8) * (F.G / 8) + F.blk / 8 : F.blk;
    for (int qi = vcu; qi < 256; qi += F.G) {
        const int bh = qi >> 3, sft = qi & 7;
#pragma unroll 1
        for (int k = 0; k < 4; ++k) {
            Item it; it.bh = bh; it.b = bh >> 1; it.hkv = bh & 1; it.qb = k == 0 ? sft : (k == 1 ? 15 - sft : (k == 2 ? 16 + sft : 31 - sft));
            attn_item(F, it, L);
        }
    }
}
}

__device__ __forceinline__ void p_route_a(const Frame& F) {
    LAS unsigned char* L = (LAS unsigned char*)F.lds;
    LAS int* hist = (LAS int*)(L + 32768);
    {
        const f32x4* src = (const f32x4*)wsp<float>(F, M_WR);
#pragma unroll
        for (int i = 0; i < 4; ++i) *(LAS f32x4*)(L + (F.tid + NTHR * i) * 16) = src[F.tid + NTHR * i];
        if (F.tid < 8) hist[F.tid] = 0;
    }
    __syncthreads();
    const bf16* XB = wsp<bf16>(F, WS_XB); const float* RS = wsp<float>(F, M_RS); const float* rb = F.in[35];
    int* TOPE = wsp<int>(F, M_TOPE); float* TOPG = wsp<float>(F, M_TOPG); float* RSTD3 = wsp<float>(F, M_RSTD3);
    const int chunk = (NTOK + F.G - 1) / F.G, cs = F.blk * chunk, ce = min(NTOK, cs + chunk); const int lane = F.lane;
    const int sub = lane >> 4, l16 = lane & 15;
    for (int tok0 = cs + 4 * F.wave; tok0 < ce; tok0 += 4 * NWAVES) {
        const int tok = tok0 + sub; const bool ok = tok < ce; const int tk = ok ? tok : cs;
        u32x4 xr[8];
#pragma unroll
        for (int r = 0; r < 8; ++r) xr[r] = *(const u32x4*)(XB + (size_t)tk * D + 128 * r + 8 * l16);
        const float rstd = rsqrtf(red16(RS[(size_t)tk * 16 + l16]) * (1.0f / D) + 1e-6f);
        float lg[8];
#pragma unroll
        for (int e = 0; e < 8; ++e) lg[e] = 0.f;
#pragma unroll
        for (int r = 0; r < 8; ++r) {
            const int k0 = 128 * r + 8 * l16;
            float x[8];
#pragma unroll
            for (int j = 0; j < 4; ++j) { x[2 * j] = bf2f(xr[r][j] & 0xffffu); x[2 * j + 1] = bf2f(xr[r][j] >> 16); }
#pragma unroll
            for (int e = 0; e < 8; ++e) {
                const f32x4 w0 = *(const LAS f32x4*)(L + (e * D + k0) * 4), w1 = *(const LAS f32x4*)(L + (e * D + k0 + 4) * 4);
                lg[e] += (x[0] * w0.x + x[1] * w0.y) + (x[2] * w0.z + x[3] * w0.w) + (x[4] * w1.x + x[5] * w1.y) + (x[6] * w1.z + x[7] * w1.w);
            }
        }
#pragma unroll
        for (int e = 0; e < 8; ++e) lg[e] = red16(lg[e]) * rstd + rb[e];
        if (ok) {
#pragma unroll
            for (int r = 0; r < 8; ++r) {
                u32x2 q8;
                q8.x = pk4_i8(bf2f(xr[r][0] & 0xffffu) * I8_XS1, bf2f(xr[r][0] >> 16) * I8_XS1, bf2f(xr[r][1] & 0xffffu) * I8_XS1, bf2f(xr[r][1] >> 16) * I8_XS1);
                q8.y = pk4_i8(bf2f(xr[r][2] & 0xffffu) * I8_XS1, bf2f(xr[r][2] >> 16) * I8_XS1, bf2f(xr[r][3] & 0xffffu) * I8_XS1, bf2f(xr[r][3] >> 16) * I8_XS1);
                *(u32x2*)(F.ws + WS_XQ + (size_t)tk * D + 128 * r + 8 * l16) = q8;
            }
        }
        float v1 = lg[0]; int e1 = 0;
#pragma unroll
        for (int e = 1; e < 8; ++e) if (lg[e] > v1) { v1 = lg[e]; e1 = e; }
        float v2 = -3e38f; int e2 = 0;
#pragma unroll
        for (int e = 0; e < 8; ++e) if (e != e1 && lg[e] > v2) { v2 = lg[e]; e2 = e; }
        if (l16 == 0 && ok) {
            const float g1 = rcpf_(1.0f + __expf(v2 - v1));
            TOPE[tok * 2] = e1; TOPE[tok * 2 + 1] = e2; TOPG[tok * 2] = g1; TOPG[tok * 2 + 1] = 1.0f - g1; RSTD3[tok] = rstd;
            atomicAdd((int*)&hist[e1], 1); atomicAdd((int*)&hist[e2], 1);
        }
    }
    __syncthreads();
    if (F.tid < 8) wsp<int>(F, M_BLKCNT)[F.blk * 8 + F.tid] = hist[F.tid];
    __syncthreads();
}
__device__ __forceinline__ void p_route_b(const Frame& F) {
    int* L = (int*)F.lds;
    const int* BC = wsp<int>(F, M_BLKCNT); const int* TOPE = wsp<int>(F, M_TOPE); int* SLOTOF = wsp<int>(F, M_SLOTOF);
    const int chunk = (NTOK + F.G - 1) / F.G, cs = F.blk * chunk, ce = min(NTOK, cs + chunk), np = (ce > cs ? (ce - cs) * 2 : 0);
    {
        const int e = F.tid & 7, part = F.tid >> 3; int tot = 0, pre = 0;
        for (int bb = part; bb < F.G; bb += 64) { const int c = BC[bb * 8 + e]; if (bb < F.blk) pre += c; tot += c; }
        L[4096 + F.tid] = tot; L[4096 + 512 + F.tid] = pre;
        __syncthreads();
        if (F.tid < 8) { int t2 = 0, p2 = 0; for (int q = 0; q < 64; ++q) { t2 += L[4096 + q * 8 + F.tid]; p2 += L[4096 + 512 + q * 8 + F.tid]; } L[F.tid] = t2; L[8 + F.tid] = p2; }
    }
    __syncthreads();
    if (F.tid == 0) { int ps = 0; for (int e = 0; e < 8; ++e) { L[16 + e] = ps; if (F.blk == 0) wsp<int>(F, M_EXPINF)[e] = ps >> 8; ps += ((L[e] + 255) >> 8) << 8; } if (F.blk == 0) wsp<int>(F, M_EXPINF)[8] = ps >> 8; }
    __syncthreads();
    for (int p = F.tid; p < np; p += NTHR) L[32 + 1024 + p] = TOPE[cs * 2 + p];
    __syncthreads();
    if (F.tid < 8) { int cnt = L[16 + F.tid] + L[8 + F.tid]; for (int p = 0; p < np; ++p) { if (L[32 + 1024 + p] == F.tid) { L[32 + p] = cnt; ++cnt; } } }
    __syncthreads();
    for (int p = F.tid; p < np; p += NTHR) SLOTOF[cs * 2 + p] = L[32 + p];

    int* STOK = wsp<int>(F, M_SLOTTOK);
    for (int p = F.tid; p < np; p += NTHR) {
        const int tok = cs + (p >> 1), slot = L[32 + p];
        STOK[slot] = tok; wsp<float>(F, M_SRSTD)[slot] = wsp<float>(F, M_RSTD3)[tok]; wsp<float>(F, M_SGATE)[slot] = wsp<float>(F, M_TOPG)[cs * 2 + p];
    }
    if (F.blk == 0) {
        for (int e = 0; e < 8; ++e) { const int s0 = L[16 + e] + L[e], s1 = L[16 + e] + (((L[e] + 255) >> 8) << 8); for (int sI = s0 + F.tid; sI < s1; sI += NTHR) STOK[sI] = 0; }
    }
    __syncthreads();
}
__device__ __forceinline__ void p_final(const Frame& F) {
    const bf16* YP = wsp<bf16>(F, WS_XS); const int* SLOTOF = wsp<int>(F, M_SLOTOF); const float* fn = F.in[39];
    const int gw = F.blk * NWAVES + F.wave, NGW = F.G * NWAVES, lane = F.lane;
    for (int tok = gw; tok < NTOK; tok += NGW) {
        const int s1 = SLOTOF[tok * 2], s2 = SLOTOF[tok * 2 + 1];
        f32x4 v[4]; float ss = 0.f;
#pragma unroll
        for (int j = 0; j < 4; ++j) {
            { const u32x2 hb = *((const u32x2*)(wsp<bf16>(F, WS_XB) + (size_t)tok * D) + lane + 64 * j); v[j] = (f32x4){bf2f(hb.x & 0xffffu), bf2f(hb.x >> 16), bf2f(hb.y & 0xffffu), bf2f(hb.y >> 16)}; }
            const u32x2 a = *((const u32x2*)(YP + (size_t)s1 * D) + lane + 64 * j), bq = *((const u32x2*)(YP + (size_t)s2 * D) + lane + 64 * j);
            v[j].x += bf2f(a.x & 0xffffu) + bf2f(bq.x & 0xffffu); v[j].y += bf2f(a.x >> 16) + bf2f(bq.x >> 16); v[j].z += bf2f(a.y & 0xffffu) + bf2f(bq.y & 0xffffu); v[j].w += bf2f(a.y >> 16) + bf2f(bq.y >> 16);
            ss += (v[j].x * v[j].x + v[j].y * v[j].y) + (v[j].z * v[j].z + v[j].w * v[j].w);
        }
        const float rstd = rsqrtf(wave_sum(ss) * (1.0f / D) + 1e-6f);
#pragma unroll
        for (int j = 0; j < 4; ++j) { const f32x4 g = *((const f32x4*)fn + lane + 64 * j); *((f32x4*)(F.out + (size_t)tok * D) + lane + 64 * j) = v[j] * rstd * g; }
    }
}

#define XB_TMO      128
#define XB_XCNT(j)  (256  + 64 * (j))
#define XB_XSUB(j)  (1280 + 64 * (j))
#define XB_XGEN(j)  (2304 + 64 * (j))
#define XB_TOP      3328
#define XB_TOPGEN   3392
#define XCD_BAR_WORDS 3456
#define XB_SPIN_CAP (1u << 18)
constexpr int CW_BAR = 4096;
constexpr int LDS_BARST = LDS_BYTES - 64;
__device__ __forceinline__ unsigned xb_ld(unsigned* p)              { return __hip_atomic_load(p, __ATOMIC_RELAXED, __HIP_MEMORY_SCOPE_AGENT); }
__device__ __forceinline__ unsigned xb_add(unsigned* p, unsigned v) { return __hip_atomic_fetch_add(p, v, __ATOMIC_RELAXED, __HIP_MEMORY_SCOPE_AGENT); }
__device__ __forceinline__ unsigned xb_xcc_id() { return (unsigned)__builtin_amdgcn_s_getreg((3 << 11) | 20) & 0xFu; }
#define XB_SPIN(cond, bar) do { unsigned _sp = 0; while (cond) { __builtin_amdgcn_s_sleep(1); \
    if ((++_sp & 255u) == 0u) { if (xb_ld(&(bar)[XB_TMO])) break; if (_sp > XB_SPIN_CAP) { atomicAdd(&(bar)[XB_TMO], 1u); break; } } } } while (0)
struct XcdBarrier { unsigned* bar; unsigned x; volatile LAS unsigned* st; int wave; };
__device__ __forceinline__ XcdBarrier xcd_barrier_post(unsigned* bar, volatile LAS unsigned* st, int wave) {
    XcdBarrier b; b.bar = bar; b.x = xb_xcc_id(); b.st = st; b.wave = wave;
    if (tid_now(wave) == 0) (void)xb_add(&bar[XB_XCNT(b.x)], 1u);
    return b;
}
__device__ __forceinline__ void xcd_barrier_complete(unsigned* bar, unsigned x, unsigned& nloc, unsigned& nx) {
    const unsigned G = gridDim.x * gridDim.y * gridDim.z;
    unsigned sum, cnt, mine, sp = 0u;
    for (;;) {
        sum = 0u; cnt = 0u; mine = 0u;
#pragma unroll
        for (unsigned j = 0; j < 16; ++j) { const unsigned c = xb_ld(&bar[XB_XCNT(j)]); sum += c; cnt += (c > 0u) ? 1u : 0u; mine = (j == x) ? c : mine; }
        if (sum == G) break;
        __builtin_amdgcn_s_sleep(1);
        if ((++sp & 255u) == 0u) { if (xb_ld(&bar[XB_TMO])) break; if (sp > XB_SPIN_CAP) { atomicAdd(&bar[XB_TMO], 1u); break; } }
    }
    nloc = mine > 0u ? mine : 1u; nx = cnt > 0u ? cnt : 1u;
}
__device__ __forceinline__ void xcd_barrier(const XcdBarrier& b) {
    asm volatile("s_waitcnt vmcnt(0)" ::: "memory");
    __syncthreads();
    if (tid_now(b.wave) == 0) {
        unsigned* bar = b.bar;
        __builtin_amdgcn_s_waitcnt(0);
        unsigned nloc = b.st[0], nx = b.st[1];
        if (nloc == 0u) { xcd_barrier_complete(bar, b.x, nloc, nx); b.st[0] = nloc; b.st[1] = nx; }
        const unsigned old = xb_add(&bar[XB_XSUB(b.x)], 1u);
        const unsigned gen = old / nloc;
        if (old + 1u == (gen + 1u) * nloc) {
            __builtin_amdgcn_fence(__ATOMIC_RELEASE, "agent");
            asm volatile("s_waitcnt vmcnt(0)" ::: "memory");
            const unsigned og = xb_add(&bar[XB_TOP], 1u);
            const unsigned tg = og / nx;
            if (og + 1u == (tg + 1u) * nx) xb_add(&bar[XB_TOPGEN], 1u);
            else XB_SPIN(xb_ld(&bar[XB_TOPGEN]) == tg, bar);
            __builtin_amdgcn_fence(__ATOMIC_ACQUIRE, "agent");
            xb_add(&bar[XB_XGEN(b.x)], 1u);
            asm volatile("s_waitcnt vmcnt(0)" ::: "memory");
        } else {
            XB_SPIN(xb_ld(&bar[XB_XGEN(b.x)]) == gen, bar);
            __builtin_amdgcn_fence(__ATOMIC_ACQUIRE, "agent");
            asm volatile("s_waitcnt vmcnt(0)" ::: "memory");
        }
    }
    __syncthreads();
}

constexpr int N_PHASES = 16;
#ifndef MK_ONE_LAUNCH
#define MK_ONE_LAUNCH 1
#endif
__global__ void __launch_bounds__(NTHR, 2) mk_fwd(Args args) {
    extern __shared__ __attribute__((aligned(16))) unsigned char lds[];
    Frame F; F.lds = lds; F.ws = args.ws; F.in = args.in; F.out = args.out;
    F.tid = threadIdx.x; F.lane = F.tid & 63; F.wave = __builtin_amdgcn_readfirstlane(F.tid >> 6); F.G = gridDim.x; F.blk = blockIdx.x;
    const int lo = args.ph_lo, hi = args.ph_hi;
    XcdBarrier bar; bar.bar = (unsigned*)(args.ws + WS_CTL) + CW_BAR + args.li * XCD_BAR_WORDS; bar.x = 0; bar.st = nullptr; bar.wave = F.wave;
    {
        if (F.tid < 16) ((LAS unsigned*)lds)[LDS_BARST / 4 + F.tid] = 0u;
        __syncthreads();
        bar = xcd_barrier_post((unsigned*)(args.ws + WS_CTL) + CW_BAR + args.li * XCD_BAR_WORDS, (volatile LAS unsigned*)((LAS unsigned char*)lds + LDS_BARST), F.wave);
    }
#ifndef REPEAT_MASK
#define REPEAT_MASK 0u
#endif
#define NREP(k) ((((REPEAT_MASK) >> (k)) & 1u) ? 2 : 1)
#define PH_ENTER() do { int t_ = tid_now(F.wave); asm volatile("" : "+v"(t_)); F.tid = t_; F.lane = t_ & 63; } while (0)
#define SEAM(k) do { if (IN(k) && IN((k) + 1)) xcd_barrier(bar); } while (0)
#if defined(SKIP_PH)
#define IN(k) ((k) != SKIP_PH && lo <= (k) && (k) < hi)
#elif defined(ONLY_PH)
#define IN(k) ((k) == ONLY_PH && lo <= (k) && (k) < hi)
#else
#define IN(k) (lo <= (k) && (k) < hi)
#endif
    PH_ENTER();
    for (int rep_ = 0; rep_ < NREP(0); ++rep_) if (IN(0)) p0_prologue(F);
    SEAM(0);
    PH_ENTER();
    for (int rep_ = 0; rep_ < NREP(1); ++rep_) if (IN(1)) {
        Gemm g = std_gemm((const bf16*)(F.ws + WS_XQI), (const bf16*)(F.ws + WT_IN0), D / 2); StdOrder S; S.init(NTOK / 256, IN0 / 256, F.G, F.blk, 256L * D, 256L * D);
        EpiBf16T<true> E{wsp<bf16>(F, WS_PB), IN0, wsp<float>(F, M_RSTD0), nullptr, 4, fill_rs_lds(F.lds, S, nullptr, wsp<float>(F, M_RSTD0), F.tid), 1.0f / I8_WS};
        pg8::gemm_phase<EpiBf16T<true>, StdOrder, true, false, true, true>(F.wave, (LAS unsigned char*)F.lds, g, S, E);
    }
    SEAM(1);
    PH_ENTER();
    for (int rep_ = 0; rep_ < NREP(2); ++rep_) if (IN(2)) { p_lora(F); xcd_barrier(bar); p_mix0(F); }
    SEAM(2);
    PH_ENTER();
    for (int rep_ = 0; rep_ < NREP(3); ++rep_) if (IN(3)) {
        Gemm g = std_gemm(wsp<bf16>(F, WS_YB), wsp<bf16>(F, WT_OUT0), D); StdOrder S; S.init(NTOK / 256, D / 256, F.G, F.blk, 256L * D * 2, 256L * D * 2);
        EpiResBT<true, false, (long)WS_XQ0 - (long)WS_XB> E{wsp<bf16>(F, WS_XB), wsp<float>(F, M_RS), 1.0f};
        gemm_run<3, EpiResBT<true, false, (long)WS_XQ0 - (long)WS_XB>, StdOrder>(F, g, S, E);
    }
    SEAM(3);
    PH_ENTER();
    for (int rep_ = 0; rep_ < NREP(4); ++rep_) if (IN(4)) {
        Gemm g = std_gemm((const bf16*)(F.ws + WS_XQ0), (const bf16*)(F.ws + WT_GU0), D / 2); StdOrder S; S.init(NTOK / 256, 2 * FFN / 256, F.G, F.blk, 256L * D, 256L * D);
        EpiGU8<FFN, -1, true> E{F.ws + WS_PB, fill_rs_lds(F.lds, S, wsp<float>(F, M_RS), nullptr, F.tid), 1.0f / (I8_XS * I8_WS)};
        pg8::gemm_phase<EpiGU8<FFN, -1, true>, StdOrder, true, false, true, true>(F.wave, (LAS unsigned char*)F.lds, g, S, E);
    }
    SEAM(4);
    PH_ENTER();
    for (int rep_ = 0; rep_ < NREP(5); ++rep_) if (IN(5)) {
        Gemm g = std_gemm((const bf16*)(F.ws + WS_PB), (const bf16*)(F.ws + WT_DN0), FFN / 2); StdOrder S; S.init(NTOK / 256, D / 256, F.G, F.blk, 256L * FFN, 256L * FFN);
        EpiResBT<true, true, (long)WS_XQI - (long)WS_XB> E{wsp<bf16>(F, WS_XB), wsp<float>(F, M_RS), 1.0f / (F8_HS * F8_WS)};
        pg8::gemm_phase<EpiResBT<true, true, (long)WS_XQI - (long)WS_XB>, StdOrder, true, false, true>(F.wave, (LAS unsigned char*)F.lds, g, S, E);
    }
    SEAM(5);
    PH_ENTER();
    for (int rep_ = 0; rep_ < NREP(6); ++rep_) if (IN(6)) {
        Gemm g = std_gemm((const bf16*)(F.ws + WS_XQI), (const bf16*)(F.ws + WT_IN1), D / 2); StdOrder S; S.init(NTOK / 256, IN1P / 256, F.G, F.blk, 256L * D, 256L * D);
        EpiBf16T<true> E{wsp<bf16>(F, WS_PB), IN1P, nullptr, wsp<float>(F, M_RS), 0, fill_rs_lds(F.lds, S, wsp<float>(F, M_RS), nullptr, F.tid), 1.0f / (I8_XS * I8_WS)};
        pg8::gemm_phase<EpiBf16T<true>, StdOrder, true, false, true, true>(F.wave, (LAS unsigned char*)F.lds, g, S, E);
    }
    SEAM(6);
    PH_ENTER();
    for (int rep_ = 0; rep_ < NREP(7); ++rep_) if (IN(7)) p_nsa_prep(F);
    SEAM(7);
    PH_ENTER();
    for (int rep_ = 0; rep_ < NREP(9); ++rep_) if (IN(9)) {
#ifdef ATTN_NAIVE
        p_attn_naive(F);
#else
        nsa::p_attn(F);
#endif
    }
    SEAM(9);
    PH_ENTER();
    for (int rep_ = 0; rep_ < NREP(10); ++rep_) if (IN(10)) {
        Gemm g = std_gemm(wsp<bf16>(F, WS_YB), wsp<bf16>(F, WT_OUT1), D); StdOrder S; S.init(NTOK / 256, D / 256, F.G, F.blk, 256L * D * 2, 256L * D * 2);
        EpiResB E{wsp<bf16>(F, WS_XB), wsp<float>(F, M_RS), 1.0f};
        gemm_run<10, EpiResB, StdOrder>(F, g, S, E);
    }
    SEAM(10);
    PH_ENTER();
    for (int rep_ = 0; rep_ < NREP(11); ++rep_) if (IN(11)) p_route_a(F);
    SEAM(11);
    PH_ENTER();
    for (int rep_ = 0; rep_ < NREP(12); ++rep_) if (IN(12)) p_route_b(F);
    SEAM(12);
    PH_ENTER();
    for (int rep_ = 0; rep_ < NREP(13); ++rep_) if (IN(13)) {
        Gemm g = std_gemm((const bf16*)(F.ws + WS_XQ), (const bf16*)(F.ws + WT_GU1), D / 2); MoeOrder S; S.init(wsp<int>(F, M_EXPINF), 2 * EXPD / 256, F.G, F.blk, 256L * D, 256L * D, 2L * EXPD * D);
        EpiGU8<AP8, EXPD / 128 - 1, true> E{F.ws + WS_ACTM, fill_rs_lds(F.lds, S, nullptr, wsp<float>(F, M_SRSTD), F.tid, 131072 + 14336), 1.0f / (I8_XS1 * I8_WS)};
        LAS int* rmap = (LAS int*)((LAS unsigned char*)F.lds + 131072);
        { Unit u; const int* STOK = wsp<int>(F, M_SLOTTOK);
          for (int i = F.wave; i < 14 && S.next(i, u); i += NWAVES) {
#pragma unroll
              for (int rr = 0; rr < 4; ++rr) rmap[i * 256 + F.lane + 64 * rr] = STOK[u.pm * 256 + F.lane + 64 * rr]; }
          __syncthreads(); }
        pg8::gemm_phase<EpiGU8<AP8, EXPD / 128 - 1, true>, MoeOrder, true, true, true, true>(F.wave, (LAS unsigned char*)F.lds, g, S, E, rmap);
    }
    SEAM(13);
    PH_ENTER();
    for (int rep_ = 0; rep_ < NREP(14); ++rep_) if (IN(14)) {
        Gemm g = std_gemm((const bf16*)(F.ws + WS_ACTM), (const bf16*)(F.ws + WT_DN1), AP8 / 2); MoeOrder S; S.init(wsp<int>(F, M_EXPINF), D / 256, F.G, F.blk, 256L * AP8, 256L * AP8, (long)D * AP8);
        EpiScale E{wsp<bf16>(F, WS_XS), D, wsp<float>(F, M_SGATE), fill_rs_lds(F.lds, S, nullptr, wsp<float>(F, M_SGATE), F.tid), 1.0f / (F8_HS * F8_WS)};
        pg8::gemm_phase<EpiScale, MoeOrder, true, false, true>(F.wave, (LAS unsigned char*)F.lds, g, S, E);
    }
    SEAM(14);
    PH_ENTER();
    for (int rep_ = 0; rep_ < NREP(15); ++rep_) if (IN(15)) p_final(F);
#undef IN
}

extern "C" void kernel_launch(void* const* d_in, const int* in_sizes, int n_in, void* d_out, int out_size, void* d_ws, size_t ws_size, hipStream_t stream) {
    static int grid = 0;
    if (grid == 0) {
        if (n_in != 40 || out_size != NTOK * D || ws_size < WS_END) { fprintf(stderr, "kernel_launch: unexpected shapes (n_in %d out %d ws %zu)\n", n_in, out_size, ws_size); grid = -1; return; }
        int dev = 0, cus = 0, per_cu = 0;
        if (hipGetDevice(&dev) != hipSuccess || hipDeviceGetAttribute(&cus, hipDeviceAttributeMultiprocessorCount, dev) != hipSuccess) { grid = -1; return; }
        if (hipFuncSetAttribute((const void*)mk_fwd, hipFuncAttributeMaxDynamicSharedMemorySize, LDS_BYTES) != hipSuccess) { fprintf(stderr, "kernel_launch: hipFuncSetAttribute failed\n"); grid = -1; return; }
        if (hipOccupancyMaxActiveBlocksPerMultiprocessor(&per_cu, (const void*)mk_fwd, NTHR, LDS_BYTES) != hipSuccess || per_cu < 1) per_cu = 1;
        (void)hipGetLastError();
        grid = cus;
        if (grid > 1024) grid = 1024;
    }
    if (grid < 0) return;
    (void)hipMemsetAsync((char*)d_ws + WS_CTL, 0, CTL_ZERO_BYTES, stream);
    Args a{};
    for (int i = 0; i < 40; ++i) a.in[i] = (const float*)d_in[i];
    a.out = (float*)d_out; a.ws = (unsigned char*)d_ws;
#if defined(PROBE_PH)
    { const int cuts[5] = {0, PROBE_PH, PROBE_PH + 1, PROBE_PH + 1, N_PHASES}; const int los[4] = {0, PROBE_PH, PROBE_PH, PROBE_PH + 1};
      for (int li = 0; li < 4; ++li) { a.ph_lo = los[li]; a.ph_hi = (li == 0) ? PROBE_PH : (li == 3 ? N_PHASES : PROBE_PH + 1); a.li = li; (void)cuts; if (a.ph_hi > a.ph_lo) hipLaunchKernelGGL(mk_fwd, dim3(grid), dim3(NTHR), LDS_BYTES, stream, a); } }
#elif MK_ONE_LAUNCH
    a.ph_lo = 0; a.ph_hi = N_PHASES;
    hipLaunchKernelGGL(mk_fwd, dim3(grid), dim3(NTHR), LDS_BYTES, stream, a);
#else
    for (int ph = 0; ph < N_PHASES; ++ph) {
        a.ph_lo = ph; a.ph_hi = ph + 1;
        hipLaunchKernelGGL(mk_fwd, dim3(grid), dim3(NTHR), LDS_BYTES, stream, a);
    }
#endif
}
```

```cpp
#include <hip/hip_runtime.h>
#include <cstdio>
#include <cstdint>

#define LAS __attribute__((address_space(3)))
typedef unsigned short bf16;
typedef float f32x4 __attribute__((ext_vector_type(4)));
typedef float f32x2 __attribute__((ext_vector_type(2)));
typedef unsigned u32x4 __attribute__((ext_vector_type(4)));
typedef unsigned u32x2 __attribute__((ext_vector_type(2)));
typedef short bf16x8 __attribute__((ext_vector_type(8)));

constexpr int D = 1024, BATCH = 16, SEQ = 2048, NTOK = BATCH * SEQ;
constexpr int IN0 = 2816, IN1 = 2840, IN1P = 3072, FFN = 2816, EXPD = 1408, NEXP = 8;
constexpr int MAXSLOT = NTOK * 2 + NEXP * 256;
constexpr int NWAVES = 8, NTHR = 512;
constexpr int LDS_BYTES = 163840;
constexpr int C_Q = 0, C_KC = 512, C_VC = 640, C_KS = 768, C_VS = 896, C_KW = 1024, C_VW = 1152, C_BG = 1280, C_CG = 1792, C_HD = 2304, C_GL = 2816;

constexpr size_t MiB = (size_t)1 << 20;
constexpr size_t WS_CTL = 0, CTL_ZERO_BYTES = 1 * MiB;
constexpr size_t WT_IN0 = 1 * MiB;
constexpr size_t WT_OUT0 = WT_IN0 + (size_t)IN0 * D * 2;
constexpr size_t WT_GU0 = WT_OUT0 + (size_t)D * D * 2;
constexpr size_t WT_DN0 = WT_GU0 + (size_t)2 * FFN * D * 2;
constexpr size_t WT_IN1 = WT_DN0 + (size_t)D * FFN * 2;
constexpr size_t WT_OUT1 = WT_IN1 + (size_t)IN1P * D * 2;
constexpr size_t WT_GU1 = WT_OUT1 + (size_t)D * D * 2;
constexpr size_t WT_DN1 = WT_GU1 + (size_t)NEXP * 2 * EXPD * D * 2;
constexpr size_t WT_CK1 = WT_DN1 + (size_t)NEXP * D * EXPD * 2;
constexpr size_t WT_CV1 = WT_CK1 + (size_t)256 * 2048 * 2;
constexpr size_t WT_CK2 = WT_CV1 + (size_t)256 * 2048 * 2;
constexpr size_t WT_CV2 = WT_CK2 + (size_t)64 * 256 * 2;
constexpr size_t WT_SGU = WT_CV2 + (size_t)64 * 256 * 2;
constexpr size_t WT_W2 = WT_SGU + (size_t)4 * 128 * 128 * 2;
constexpr size_t WT_A2 = WT_W2 + (size_t)512 * 64 * 2;
constexpr size_t WT_G2 = WT_A2 + (size_t)512 * 64 * 2;
constexpr size_t W_END = WT_G2 + (size_t)512 * 128 * 2;
static_assert(W_END <= 104 * MiB, "weights region");
constexpr size_t M_RS = 104 * MiB;
constexpr size_t M_RSTD0 = M_RS + 2 * MiB;
constexpr size_t M_ROPE = M_RSTD0 + 128 * 1024;
constexpr size_t M_C1 = M_ROPE + 128 * 1024;
constexpr size_t M_WR = M_C1 + 4 * 1024;
constexpr size_t M_KCMP = M_WR + 32 * 1024;
constexpr size_t M_VCMP = M_KCMP + 512 * 1024;
constexpr size_t M_HID = M_VCMP + 512 * 1024;
constexpr size_t M_TOPE = M_HID + 4 * MiB;
constexpr size_t M_TOPG = M_TOPE + 256 * 1024;
constexpr size_t M_RSTD3 = M_TOPG + 256 * 1024;
constexpr size_t M_BLKCNT = M_RSTD3 + 128 * 1024;
constexpr size_t M_SLOTOF = M_BLKCNT + 32 * 1024;
constexpr size_t M_SRSTD = M_SLOTOF + 256 * 1024;
constexpr size_t M_SGATE = M_SRSTD + 272 * 1024;
constexpr size_t M_EXPINF = M_SGATE + 272 * 1024;
constexpr size_t M_SLOTTOK = M_EXPINF + 4096;
static_assert(M_SLOTTOK + 272 * 1024 <= 120 * MiB, "misc region");
constexpr size_t WS_XB = 120 * MiB;
constexpr size_t WS_YB = 184 * MiB;
constexpr size_t WS_PB = 248 * MiB;
constexpr size_t WS_QROT = 441 * MiB;
constexpr size_t WS_XS = 184 * MiB;
constexpr size_t WS_ACTM = 316 * MiB;
constexpr size_t WS_XQ = 420 * MiB;
constexpr size_t WS_XQ0 = 456 * MiB;
static_assert(WS_XQ0 >= WS_PB + (size_t)(NTOK + 64) * IN1P * 2 && WS_XQ0 + (size_t)NTOK * D <= 498 * MiB, "ws map int8");
constexpr size_t WS_KVQ = 488 * MiB;
constexpr float I8_KVS = 127.0f / 5.0f, I8_C1S = 127.0f / 0.1f;
constexpr int AP8 = 1536;
constexpr size_t WS_XQI = WS_YB;
constexpr float I8_XS = 127.0f / 5.0f, I8_XS1 = 127.0f / 6.0f, I8_WS = 127.0f / 0.14f;
constexpr float F8_XS = 4.0f, F8_WS = 32.0f, F8_HS = 4.0f;
constexpr size_t WS_END = 498 * MiB;
static_assert(WS_KVQ + (size_t)4 * (NTOK + 64) * 64 <= WS_END, "ws map kvq");
static_assert(WS_ACTM + (size_t)MAXSLOT * AP8 <= WS_XQ && WS_XQ + (size_t)NTOK * D <= WS_END, "ws map fp8");
static_assert(WS_PB + (size_t)(NTOK + 64) * IN1P * 2 <= WS_QROT && WS_QROT + (size_t)NTOK * 512 * 2 <= 473 * MiB, "ws map");
static_assert(WS_XS + (size_t)MAXSLOT * D * 2 <= WS_ACTM && WS_ACTM + (size_t)MAXSLOT * EXPD * 2 <= WS_END, "ws map moe");

__device__ __forceinline__ float bf2f(unsigned b) { return __uint_as_float(b << 16); }
__device__ __forceinline__ unsigned f2bf(float f) { unsigned u = __float_as_uint(f); return (u + 0x7fffu + ((u >> 16) & 1u)) >> 16; }
typedef __bf16 bf16x2_hw __attribute__((ext_vector_type(2)));
__device__ __forceinline__ unsigned pk2(float lo, float hi) { f32x2 v = {lo, hi}; bf16x2_hw b = __builtin_convertvector(v, bf16x2_hw); return __builtin_bit_cast(unsigned, b); }
__device__ __forceinline__ unsigned pk4_f8(float a, float b, float c, float d) { int w = __builtin_amdgcn_cvt_pk_fp8_f32(a, b, 0, false); w = __builtin_amdgcn_cvt_pk_fp8_f32(c, d, w, true); return (unsigned)w; }
__device__ __forceinline__ unsigned pk4_i8(float a, float b, float c, float d) {
    const float M = 12582912.0f;
    const unsigned ua = __float_as_uint(__builtin_amdgcn_fmed3f(a, -127.0f, 127.0f) + M), ub = __float_as_uint(__builtin_amdgcn_fmed3f(b, -127.0f, 127.0f) + M), uc = __float_as_uint(__builtin_amdgcn_fmed3f(c, -127.0f, 127.0f) + M), ud = __float_as_uint(__builtin_amdgcn_fmed3f(d, -127.0f, 127.0f) + M);
    return (ua & 0xffu) | ((ub & 0xffu) << 8) | ((uc & 0xffu) << 16) | (ud << 24);
}
__device__ __forceinline__ float rcpf_(float x) { return __builtin_amdgcn_rcpf(x); }
__device__ __forceinline__ float sigmoidf_(float x) { return rcpf_(1.0f + __expf(-x)); }
__device__ __forceinline__ float gelu_tanh(float x) { const float u = 1.5957691216057308f * (x + 0.044715f * x * x * x); return x * rcpf_(1.0f + __expf(-u)); }
__device__ __forceinline__ float silu_(float x) { return x * rcpf_(1.0f + __expf(-x)); }
template <int CTRL> __device__ __forceinline__ float dpp_f(float v) { return __builtin_bit_cast(float, __builtin_amdgcn_update_dpp(0, __builtin_bit_cast(int, v), CTRL, 0xF, 0xF, true)); }
__device__ __forceinline__ float red16(float v) { v += dpp_f<0xB1>(v); v += dpp_f<0x4E>(v); v += dpp_f<0x141>(v); v += dpp_f<0x140>(v); return v; }
__device__ __forceinline__ float wave_sum(float v) {
    v = red16(v);
    { auto r = __builtin_amdgcn_permlane16_swap(__float_as_uint(v), __float_as_uint(v), false, false); v = __uint_as_float(r[0]) + __uint_as_float(r[1]); }
    { auto r = __builtin_amdgcn_permlane32_swap(__float_as_uint(v), __float_as_uint(v), false, false); v = __uint_as_float(r[0]) + __uint_as_float(r[1]); }
    return v;
}
__device__ __forceinline__ float sum_rows4(float v) {
    { auto r = __builtin_amdgcn_permlane16_swap(__float_as_uint(v), __float_as_uint(v), false, false); v = __uint_as_float(r[0]) + __uint_as_float(r[1]); }
    { auto r = __builtin_amdgcn_permlane32_swap(__float_as_uint(v), __float_as_uint(v), false, false); v = __uint_as_float(r[0]) + __uint_as_float(r[1]); }
    return v;
}
__device__ __forceinline__ float wave_max(float v) {
#pragma unroll
    for (int o = 1; o < 64; o <<= 1) v = fmaxf(v, __shfl_xor(v, o));
    return v;
}
__device__ __forceinline__ int lane_now() { int l; asm volatile("v_mbcnt_lo_u32_b32 %0, -1, 0\n\tv_mbcnt_hi_u32_b32 %0, -1, %0" : "=v"(l)); return l; }
__device__ __forceinline__ int lane_after(float dep) { int l; asm volatile("v_mbcnt_lo_u32_b32 %0, -1, 0\n\tv_mbcnt_hi_u32_b32 %0, -1, %0" : "=&v"(l) : "v"(dep)); return l; }
__device__ __forceinline__ int tid_now(int wave) { return (wave << 6) | lane_now(); }
#define LDS_FENCE() asm volatile("s_waitcnt lgkmcnt(0)" ::: "memory")

struct Args { const float* in[40]; float* out; unsigned char* ws; int ph_lo, ph_hi, li, pad; };
struct Frame {
    unsigned char* lds; unsigned char* ws; const float* const* in; float* out;
    int tid, lane, wave, G, blk;
};
template <class T> __device__ __forceinline__ T* wsp(const Frame& F, size_t off) { return (T*)(F.ws + off); }

typedef int i32x4_ __attribute__((ext_vector_type(4)));
struct Unit { int pm, pn, idx; long aoff, boff; };
struct Gemm { const bf16* A; const bf16* Bt; int K; unsigned a_row, a_half, a_k, b_row, b_half, b_k; };
__device__ __forceinline__ Gemm std_gemm(const bf16* A, const bf16* Bt, int K) {
    Gemm g; g.A = A; g.Bt = Bt; g.K = K; g.a_row = K * 2; g.a_half = 128 * K * 2; g.a_k = 128; g.b_row = K * 2; g.b_half = 128 * K * 2; g.b_k = 128; return g;
}
constexpr int NXCD = 8, WGM = 8;
struct StdOrder {
    int nM, nN, nwg, G, c; long a_tile, b_tile;
    __device__ __forceinline__ void init(int nM_, int nN_, int G_, int c_, long a_tile_, long b_tile_) { nM = nM_; nN = nN_; nwg = nM * nN; G = G_; c = c_; a_tile = a_tile_; b_tile = b_tile_; }
    __device__ __forceinline__ bool tile(int i, int& pm, int& pn) const {
        const int L = i * G + c; if (L >= nwg) return false;
        int wgid = L; { const int q = nwg / NXCD, r = nwg % NXCD, xcd = wgid % NXCD, off = wgid / NXCD; wgid = (xcd < r ? xcd * (q + 1) : r * (q + 1) + (xcd - r) * q) + off; }
        const int nig = WGM * nN, gid = wgid / nig, fm = gid * WGM, gsz = (nM - fm) < WGM ? (nM - fm) : WGM;
        pm = fm + ((wgid % nig) % gsz); pn = (wgid % nig) / gsz; return true;
    }
    __device__ __forceinline__ bool next(int i, Unit& u) const { if (!tile(i, u.pm, u.pn)) return false; u.idx = i; u.aoff = u.pm * a_tile; u.boff = u.pn * b_tile; return true; }
};
struct MoeOrder {
    StdOrder so; const int* ei; long exp_bytes;
    __device__ __forceinline__ void init(const int* expinf, int nN, int G, int c, long a_tile, long b_tile, long exp_bytes_) {
        ei = expinf; so.init(__builtin_amdgcn_readfirstlane(expinf[8]), nN, G, c, a_tile, b_tile); exp_bytes = exp_bytes_;
    }
    __device__ __forceinline__ bool next(int i, Unit& u) const {
        if (!so.tile(i, u.pm, u.pn)) return false;
        u.idx = i;
        const int pm = u.pm; const int e = __builtin_amdgcn_readfirstlane((pm >= ei[1]) + (pm >= ei[2]) + (pm >= ei[3]) + (pm >= ei[4]) + (pm >= ei[5]) + (pm >= ei[6]) + (pm >= ei[7]));
        u.aoff = pm * so.a_tile; u.boff = e * exp_bytes + u.pn * so.b_tile; return true;
    }
};
struct GatedOrder {
    int n, e0, rb, rj, rpn; unsigned* cnt; long a_tile, b_tile;
    __device__ __forceinline__ bool next(int i, Unit& u) const {
        if (i >= n) return false;
        int bb, j, pn;
        if (n == 1) { bb = rb; j = rj; pn = rpn; } else { const int e = e0 + 128 * i; j = e >> 6; bb = (e & 63) >> 2; pn = e & 3; }
        u.pm = bb * 8 + j; u.pn = pn; u.idx = i; u.aoff = u.pm * a_tile; u.boff = pn * b_tile;
        unsigned sp = 0;
        while (__builtin_amdgcn_readfirstlane(__hip_atomic_load(cnt + bb * 8 + j, __ATOMIC_RELAXED, __HIP_MEMORY_SCOPE_AGENT)) < 16u) { __builtin_amdgcn_s_sleep(4); if (++sp > (1u << 22)) break; }
        __builtin_amdgcn_fence(__ATOMIC_ACQUIRE, "agent");
        return true;
    }
};
struct CmpOrder {
    int G, c;
    __device__ __forceinline__ bool next(int i, Unit& u) const {
        const int L = i * G + c; if (L >= 32) return false;
        const int which = L >> 4, b = L & 15; u.pm = L; u.pn = 0; u.idx = i;
        u.aoff = ((long)which * 2 * (NTOK + 64) + (long)b * SEQ) * 64; u.boff = (long)which * 256 * 2048 * 2; return true;
    }
};

typedef f32x4 Acc[2][2][4][2];

__device__ __forceinline__ float rstd_from_partials(const float* RS, int row) {
    const f32x4* p = (const f32x4*)(RS + (size_t)row * 16);
    const f32x4 a = p[0], b = p[1], c = p[2], d = p[3];
    const float s = ((a.x + a.y) + (a.z + a.w)) + ((b.x + b.y) + (b.z + b.w)) + ((c.x + c.y) + (c.z + c.w)) + ((d.x + d.y) + (d.z + d.w));
    return rsqrtf(s * (1.0f / D) + 1e-6f);
}

template <class Sched>
__device__ __forceinline__ LAS float* fill_rs_lds(unsigned char* lds, const Sched& S, const float* rs_partial, const float* direct, int tid, int off = 131072) {
    LAS float* t = (LAS float*)((LAS unsigned char*)lds + off);
    Unit u; const int wv = tid >> 6, ln = tid & 63;
    for (int i = wv; i < 14 && S.next(i, u); i += NWAVES) {
#pragma unroll
        for (int rr = 0; rr < 4; ++rr) { const int row = ln + 64 * rr; t[i * 256 + row] = direct ? direct[u.pm * 256 + row] : rstd_from_partials(rs_partial, u.pm * 256 + row); }
    }
    __syncthreads();
    return t;
}
template <bool IACC, bool KV = false>
struct EpiBf16T {
    static constexpr bool PERM = true;
    bf16* out; int ldc; const float* rstd_direct; const float* rs_partial; int gelu_tiles; const LAS float* rs_lds; float mul;
    __device__ __forceinline__ void operator()(const Acc& acc, const Unit& u, int wr, int wc, int fr, int fq) const {
        const int col0 = u.pn * 256 + wc * 32 + 8 * fq; const bool gel = u.pn < gelu_tiles;
#pragma unroll
        for (int ai = 0; ai < 2; ++ai)
#pragma unroll
            for (int m = 0; m < 4; ++m) {
                const int row = u.pm * 256 + ai * 128 + wr * 64 + m * 16 + fr;
                const float rs = rs_lds ? rs_lds[u.idx * 256 + ai * 128 + wr * 64 + m * 16 + fr] : (rstd_direct ? rstd_direct[row] : rstd_from_partials(rs_partial, row));
#pragma unroll
                for (int bj = 0; bj < 2; ++bj) {
                    f32x4 v0, v1;
                    if constexpr (IACC) { const float rq = rs * mul; v0 = __builtin_convertvector(__builtin_bit_cast(i32x4_, acc[ai][bj][m][0]), f32x4) * rq; v1 = __builtin_convertvector(__builtin_bit_cast(i32x4_, acc[ai][bj][m][1]), f32x4) * rq; }
                    else { v0 = acc[ai][bj][m][0] * rs; v1 = acc[ai][bj][m][1] * rs; }
                    if (gel) {
#pragma unroll
                        for (int i = 0; i < 4; ++i) { v0[i] = gelu_tanh(v0[i]); v1[i] = gelu_tanh(v1[i]); }
                    }
                    u32x4 w; w.x = pk2(v0[0], v0[1]); w.y = pk2(v0[2], v0[3]); w.z = pk2(v1[0], v1[1]); w.w = pk2(v1[2], v1[3]);
                    *(u32x4*)(out + (size_t)row * ldc + col0 + bj * 128) = w;
                    if constexpr (KV) { if (u.pn == 2) { const int cc = wc * 32 + 8 * fq; u32x2 q8; q8.x = pk4_i8(v0[0] * I8_KVS, v0[1] * I8_KVS, v0[2] * I8_KVS, v0[3] * I8_KVS); q8.y = pk4_i8(v1[0] * I8_KVS, v1[1] * I8_KVS, v1[2] * I8_KVS, v1[3] * I8_KVS);
                        *(u32x2*)((unsigned char*)out + ((long)WS_KVQ - (long)WS_PB) + ((size_t)(bj * 2 + (cc >> 6)) * (NTOK + 64) + row) * 64 + (cc & 63)) = q8; } }
                }
            }
    }
};
typedef EpiBf16T<false> EpiBf16;
struct EpiGU {
    static constexpr bool PERM = true;
    bf16* out; int ldc; const float* rstd_direct; const float* rs_partial; const LAS float* rs_lds;
    __device__ __forceinline__ void operator()(const Acc& acc, const Unit& u, int wr, int wc, int fr, int fq) const {
        const int col0 = (u.pn * 256 + wc * 32 + 8 * fq) >> 1;
#pragma unroll
        for (int ai = 0; ai < 2; ++ai)
#pragma unroll
            for (int m = 0; m < 4; ++m) {
                const int row = u.pm * 256 + ai * 128 + wr * 64 + m * 16 + fr;
                const float rs = rs_lds ? rs_lds[u.idx * 256 + ai * 128 + wr * 64 + m * 16 + fr] : (rstd_direct ? rstd_direct[row] : rstd_from_partials(rs_partial, row));
#pragma unroll
                for (int bj = 0; bj < 2; ++bj) {
                    const f32x4 g = acc[ai][bj][m][0] * rs, up = acc[ai][bj][m][1] * rs;
                    f32x2 e0 = (f32x2){g[0], g[1]} * (-1.4426950408889634f), e1 = (f32x2){g[2], g[3]} * (-1.4426950408889634f);
                    e0.x = __builtin_amdgcn_exp2f(e0.x); e0.y = __builtin_amdgcn_exp2f(e0.y); e1.x = __builtin_amdgcn_exp2f(e1.x); e1.y = __builtin_amdgcn_exp2f(e1.y);
                    e0 = e0 + 1.0f; e1 = e1 + 1.0f;
                    e0.x = __builtin_amdgcn_rcpf(e0.x); e0.y = __builtin_amdgcn_rcpf(e0.y); e1.x = __builtin_amdgcn_rcpf(e1.x); e1.y = __builtin_amdgcn_rcpf(e1.y);
                    const f32x2 o0 = ((f32x2){g[0], g[1]} * (f32x2){up[0], up[1]}) * e0, o1 = ((f32x2){g[2], g[3]} * (f32x2){up[2], up[3]}) * e1;
                    u32x2 w; w.x = pk2(o0.x, o0.y); w.y = pk2(o1.x, o1.y);
                    *(u32x2*)(out + (size_t)row * ldc + col0 + bj * 64) = w;
                }
            }
    }
};
struct EpiRes {
    static constexpr bool PERM = false;
    const float* base; float* H; bf16* XB; float* RS;
    __device__ __forceinline__ void operator()(const Acc& acc, const Unit& u, int wr, int wc, int fr, int fq) const {
        const int col0 = u.pn * 256 + wc * 32 + 4 * fq;
#pragma unroll
        for (int ai = 0; ai < 2; ++ai)
#pragma unroll
            for (int m = 0; m < 4; ++m) {
                const int row = u.pm * 256 + ai * 128 + wr * 64 + m * 16 + fr; float ss = 0.f;
#pragma unroll
                for (int bj = 0; bj < 2; ++bj)
#pragma unroll
                    for (int n = 0; n < 2; ++n) {
                        const size_t off = (size_t)row * D + col0 + bj * 128 + n * 16;
                        const f32x4 o = *(const f32x4*)(base + off) + acc[ai][bj][m][n];
                        *(f32x4*)(H + off) = o; u32x2 w; w.x = pk2(o[0], o[1]); w.y = pk2(o[2], o[3]); *(u32x2*)(XB + off) = w;
                        ss += (o[0] * o[0] + o[1] * o[1]) + (o[2] * o[2] + o[3] * o[3]);
                    }
                ss = sum_rows4(ss);
                if (fq == 0) RS[(size_t)row * 16 + u.pn * 4 + wc] = ss;
            }
    }
};
template <int PITCH, int PAD_PN, bool IACC = false>
struct EpiGU8 {
    static constexpr bool PERM = true;
    unsigned char* out; const LAS float* rs_lds; float mul;
    __device__ __forceinline__ void operator()(const Acc& acc, const Unit& u, int wr, int wc, int fr, int fq) const {
        const int col0 = u.pn * 128 + wc * 32 + 8 * fq;
#pragma unroll
        for (int ai = 0; ai < 2; ++ai)
#pragma unroll
            for (int m = 0; m < 4; ++m) {
                const int row = u.pm * 256 + ai * 128 + wr * 64 + m * 16 + fr;
                const float rs = rs_lds[u.idx * 256 + ai * 128 + wr * 64 + m * 16 + fr] * mul;
                const float rs2 = rs * (-1.4426950408889634f), rs3 = rs * rs * F8_HS;
                u32x2 w;
#pragma unroll
                for (int bj = 0; bj < 2; ++bj) {
                    f32x4 g, up;
                    if constexpr (IACC) { g = __builtin_convertvector(__builtin_bit_cast(i32x4_, acc[ai][bj][m][0]), f32x4); up = __builtin_convertvector(__builtin_bit_cast(i32x4_, acc[ai][bj][m][1]), f32x4); }
                    else { g = acc[ai][bj][m][0]; up = acc[ai][bj][m][1]; }
                    f32x2 e0 = (f32x2){g[0], g[1]} * rs2, e1 = (f32x2){g[2], g[3]} * rs2;
                    e0.x = __builtin_amdgcn_exp2f(e0.x); e0.y = __builtin_amdgcn_exp2f(e0.y); e1.x = __builtin_amdgcn_exp2f(e1.x); e1.y = __builtin_amdgcn_exp2f(e1.y);
                    e0 = e0 + 1.0f; e1 = e1 + 1.0f;
                    { const float r0_ = __builtin_amdgcn_rcpf(e0.x * e0.y) * rs3, r1_ = __builtin_amdgcn_rcpf(e1.x * e1.y) * rs3;
                      e0 = (f32x2){e0.y, e0.x} * r0_; e1 = (f32x2){e1.y, e1.x} * r1_; }
                    const f32x2 o0 = ((f32x2){g[0], g[1]} * (f32x2){up[0], up[1]}) * e0, o1 = ((f32x2){g[2], g[3]} * (f32x2){up[2], up[3]}) * e1;
                    const unsigned pw = pk4_f8(o0.x, o0.y, o1.x, o1.y);
                    if (bj == 0) w.x = pw; else w.y = pw;
                }
                *(u32x2*)(out + (size_t)row * PITCH + col0) = w;
                if (PAD_PN >= 0 && u.pn == PAD_PN) *(u32x2*)(out + (size_t)row * PITCH + (PAD_PN + 1) * 128 + wc * 32 + 8 * fq) = (u32x2){0u, 0u};
            }
    }
};
template <bool WQ, bool SC, long XQOFF = 0>
struct EpiResBT {
    static constexpr bool PERM = true;
    bf16* XB; float* RS; float mul;
    __device__ __forceinline__ void operator()(const Acc& acc, const Unit& u, int wr, int wc, int fr, int fq) const {
        const int col0 = u.pn * 256 + wc * 32 + 8 * fq;
#pragma unroll
        for (int ai = 0; ai < 2; ++ai)
#pragma unroll
            for (int m = 0; m < 4; ++m) {
                const int row = u.pm * 256 + ai * 128 + wr * 64 + m * 16 + fr; float ss = 0.f;
#pragma unroll
                for (int bj = 0; bj < 2; ++bj) {
                    u32x4* p = (u32x4*)(XB + (size_t)row * D + col0 + bj * 128);
                    const u32x4 b = *p; f32x4 a0 = acc[ai][bj][m][0], a1 = acc[ai][bj][m][1];
                    if constexpr (SC) { a0 = a0 * mul; a1 = a1 * mul; }
                    const float o0 = bf2f(b.x & 0xffffu) + a0[0], o1 = bf2f(b.x >> 16) + a0[1], o2 = bf2f(b.y & 0xffffu) + a0[2], o3 = bf2f(b.y >> 16) + a0[3];
                    const float o4 = bf2f(b.z & 0xffffu) + a1[0], o5 = bf2f(b.z >> 16) + a1[1], o6 = bf2f(b.w & 0xffffu) + a1[2], o7 = bf2f(b.w >> 16) + a1[3];
                    u32x4 w; w.x = pk2(o0, o1); w.y = pk2(o2, o3); w.z = pk2(o4, o5); w.w = pk2(o6, o7); *p = w;
                    const float r0 = bf2f(w.x & 0xffffu), r1 = bf2f(w.x >> 16), r2 = bf2f(w.y & 0xffffu), r3 = bf2f(w.y >> 16), r4 = bf2f(w.z & 0xffffu), r5 = bf2f(w.z >> 16), r6 = bf2f(w.w & 0xffffu), r7 = bf2f(w.w >> 16);
                    ss += ((r0 * r0 + r1 * r1) + (r2 * r2 + r3 * r3)) + ((r4 * r4 + r5 * r5) + (r6 * r6 + r7 * r7));
                    if constexpr (WQ) { u32x2 q8; q8.x = pk4_i8(r0 * I8_XS, r1 * I8_XS, r2 * I8_XS, r3 * I8_XS); q8.y = pk4_i8(r4 * I8_XS, r5 * I8_XS, r6 * I8_XS, r7 * I8_XS); *(u32x2*)((unsigned char*)XB + XQOFF + (size_t)row * D + col0 + bj * 128) = q8; }
                }
                ss = sum_rows4(ss);
                if (fq == 0) RS[(size_t)row * 16 + u.pn * 4 + wc] = ss;
            }
    }
};
typedef EpiResBT<false, false> EpiResB;
struct EpiScale {
    static constexpr bool PERM = true;
    bf16* out; int ldc; const float* scale; const LAS float* sc_lds; float mul;
    __device__ __forceinline__ void operator()(const Acc& acc, const Unit& u, int wr, int wc, int fr, int fq) const {
        const int col0 = u.pn * 256 + wc * 32 + 8 * fq;
#pragma unroll
        for (int ai = 0; ai < 2; ++ai)
#pragma unroll
            for (int m = 0; m < 4; ++m) {
                const int row = u.pm * 256 + ai * 128 + wr * 64 + m * 16 + fr; const float rs = (sc_lds ? sc_lds[u.idx * 256 + ai * 128 + wr * 64 + m * 16 + fr] : scale[row]) * mul;
#pragma unroll
                for (int bj = 0; bj < 2; ++bj) {
                    const f32x4 v0 = acc[ai][bj][m][0] * rs, v1 = acc[ai][bj][m][1] * rs;
                    u32x4 w; w.x = pk2(v0[0], v0[1]); w.y = pk2(v0[2], v0[3]); w.z = pk2(v1[0], v1[1]); w.w = pk2(v1[2], v1[3]);
                    *(u32x4*)(out + (size_t)row * ldc + col0 + bj * 128) = w;
                }
            }
    }
};
template <bool IACC>
struct EpiCmp1T {
    static constexpr bool PERM = true;
    bf16* out; const float* c1; float mul;
    __device__ __forceinline__ void operator()(const Acc& acc, const Unit& u, int wr, int wc, int fr, int fq) const {
        const int col0 = wc * 32 + 8 * fq; const float* cb = c1 + (u.pm >> 4) * 256;
#pragma unroll
        for (int bj = 0; bj < 2; ++bj) {
            const f32x4 b0 = *(const f32x4*)(cb + col0 + bj * 128), b1 = *(const f32x4*)(cb + col0 + bj * 128 + 4);
#pragma unroll
            for (int ai = 0; ai < 2; ++ai)
#pragma unroll
                for (int m = 0; m < 4; ++m) {
                    const int row = u.pm * 256 + ai * 128 + wr * 64 + m * 16 + fr;
                    f32x4 v0, v1;
                    if constexpr (IACC) { v0 = __builtin_convertvector(__builtin_bit_cast(i32x4_, acc[ai][bj][m][0]), f32x4) * mul + b0; v1 = __builtin_convertvector(__builtin_bit_cast(i32x4_, acc[ai][bj][m][1]), f32x4) * mul + b1; }
                    else { v0 = acc[ai][bj][m][0] + b0; v1 = acc[ai][bj][m][1] + b1; }
#pragma unroll
                    for (int i = 0; i < 4; ++i) { v0[i] = gelu_tanh(v0[i]); v1[i] = gelu_tanh(v1[i]); }
                    u32x4 w; w.x = pk2(v0[0], v0[1]); w.y = pk2(v0[2], v0[3]); w.z = pk2(v1[0], v1[1]); w.w = pk2(v1[2], v1[3]);
                    *(u32x4*)(out + (size_t)row * 256 + col0 + bj * 128) = w;
                }
        }
    }
};

template <class Epi, class Sched>
__device__ __forceinline__ void gemm_naive(unsigned char* lds, const Gemm g, const Sched& S, const Epi& E) {
    const int tid = threadIdx.x, wid = tid >> 6, lane = tid & 63, wr = wid >> 2, wc = wid & 3, fr = lane & 15, fq = lane >> 4;
    float* As = (float*)lds;
    float* Bs = As + 16 * 260;
    Unit u;
    for (int it = 0; S.next(it, u); ++it) {
        Acc acc;
#pragma unroll
        for (int a = 0; a < 2; ++a)
#pragma unroll
            for (int b = 0; b < 2; ++b)
#pragma unroll
                for (int m = 0; m < 4; ++m)
#pragma unroll
                    for (int n = 0; n < 2; ++n) acc[a][b][m][n] = (f32x4){0.f, 0.f, 0.f, 0.f};
        const int r = tid >> 1, kc = (tid & 1) * 8;
        const unsigned char* ap = (const unsigned char*)g.A + u.aoff + (size_t)(r >> 7) * g.a_half + (size_t)(r & 127) * g.a_row + kc * 2;
        const unsigned char* bp = (const unsigned char*)g.Bt + u.boff + (size_t)(r >> 7) * g.b_half + (size_t)(r & 127) * g.b_row + kc * 2;
        for (int k0 = 0; k0 < g.K; k0 += 16) {
            const u32x4 va = *(const u32x4*)(ap + (size_t)(k0 >> 6) * g.a_k + (k0 & 63) * 2);
            const u32x4 vb = *(const u32x4*)(bp + (size_t)(k0 >> 6) * g.b_k + (k0 & 63) * 2);
            __syncthreads();
#pragma unroll
            for (int j = 0; j < 4; ++j) {
                As[(kc + 2 * j) * 260 + r] = bf2f(va[j] & 0xffffu); As[(kc + 2 * j + 1) * 260 + r] = bf2f(va[j] >> 16);
                Bs[(kc + 2 * j) * 260 + r] = bf2f(vb[j] & 0xffffu); Bs[(kc + 2 * j + 1) * 260 + r] = bf2f(vb[j] >> 16);
            }
            __syncthreads();
#pragma unroll 1
            for (int kk = 0; kk < 16; ++kk) {
                float a[2][4]; f32x4 b[2][2];
#pragma unroll
                for (int ai = 0; ai < 2; ++ai)
#pragma unroll
                    for (int m = 0; m < 4; ++m) a[ai][m] = As[kk * 260 + ai * 128 + wr * 64 + m * 16 + fr];
#pragma unroll
                for (int bj = 0; bj < 2; ++bj)
#pragma unroll
                    for (int n = 0; n < 2; ++n) b[bj][n] = *(const f32x4*)&Bs[kk * 260 + bj * 128 + wc * 32 + (Epi::PERM ? 8 * fq + 4 * n : 16 * n + 4 * fq)];
#pragma unroll
                for (int ai = 0; ai < 2; ++ai)
#pragma unroll
                    for (int bj = 0; bj < 2; ++bj)
#pragma unroll
                        for (int m = 0; m < 4; ++m)
#pragma unroll
                            for (int n = 0; n < 2; ++n) acc[ai][bj][m][n] += b[bj][n] * a[ai][m];
            }
        }
        E(acc, u, wr, wc, fr, fq);
    }
    __syncthreads();
}

namespace pg8 {
constexpr int BM = 256, BK = 64, HALF = 128, HTB = HALF * BK * 2, STAGE_BYTES = 8 * HTB;
__host__ __device__ __forceinline__ int lds_byte(int r, int c) { const int st = (r >> 4) * 2 + (c >> 5), rr = r & 15, cc = c & 31, ob = rr * 64 + cc * 2; return st * 1024 + (ob ^ (((ob >> 9) & 1) << 5)); }
__host__ __device__ __forceinline__ void stage_rc(int b, int& R, int& C) { const int st = b / 1024, sb = b % 1024, swz = sb ^ (((sb >> 9) & 1) << 5); R = (st >> 1) * 16 + swz / 64; C = (st & 1) * 32 + (swz % 64) / 2; }
typedef int i32x8_t __attribute__((ext_vector_type(8)));
typedef int i32x4_t __attribute__((ext_vector_type(4)));
__device__ __forceinline__ i32x8_t f8cat(bf16x8 lo, bf16x8 hi) { return __builtin_shufflevector(__builtin_bit_cast(i32x4_t, lo), __builtin_bit_cast(i32x4_t, hi), 0, 1, 2, 3, 4, 5, 6, 7); }
__device__ __forceinline__ bf16x8 f8lo(i32x8_t v) { return __builtin_bit_cast(bf16x8, (i32x4_t)__builtin_shufflevector(v, v, 0, 1, 2, 3)); }
__device__ __forceinline__ bf16x8 f8hi(i32x8_t v) { return __builtin_bit_cast(bf16x8, (i32x4_t)__builtin_shufflevector(v, v, 4, 5, 6, 7)); }
__host__ __device__ __forceinline__ int perm32(int rho) { const int n = rho >> 4, i = rho & 15; return 8 * (i >> 2) + 4 * n + (i & 3); }

template <class Epi, class Sched, bool ALIGN_EPI, bool GATHER = false, bool F8 = false, bool I8 = false>
__device__ __forceinline__ void gemm_phase(int wave_s, LAS unsigned char* lds, const Gemm g, const Sched& S, const Epi& E, const LAS int* rmap = nullptr) {
    int tid = tid_now(wave_s); asm volatile("" : "+v"(tid));
    const int wid = wave_s, lane = tid & 63, wr = wid >> 2, wc = wid & 3, fr = lane & 15, fq = lane >> 4;
    const int nt = g.K / BK;
    unsigned voffA[2], voffB[2];
#pragma unroll
    for (int i = 0; i < 2; ++i) { int R, C; stage_rc(tid * 16 + i * 8192, R, C); const int Rb = Epi::PERM ? ((R & ~31) + perm32(R & 31)) : R;
        voffA[i] = (unsigned)R * g.a_row + (unsigned)C * 2u; voffB[i] = (unsigned)Rb * g.b_row + (unsigned)C * 2u; }
    unsigned vc[2][2];
#define PG8_GLOAD(dst, ui_) do { _Pragma("unroll") for (int h_ = 0; h_ < 2; ++h_) _Pragma("unroll") for (int i_ = 0; i_ < 2; ++i_) dst[h_][i_] = ((unsigned)rmap[(ui_) * 256 + h_ * 128 + (int)(voffA[i_] >> (F8 ? 10 : 11))] << (F8 ? 10 : 11)) + (voffA[i_] & (F8 ? 1023u : 2047u)); } while (0)
    const size_t kA = g.a_k, kB = g.b_k, hA = g.a_half, hB = g.b_half;
    const unsigned ldsw = (unsigned)wid * 1024u;
    const int aoff = lds_byte(wr * 64 + fr, fq * 8), boff = lds_byte(wc * 32 + fr, fq * 8) + 4 * HTB;
#define PG8_SA(b, h) (((b) * 2 + (h)) * HTB)
#define PG8_SB(b, h) ((4 + (b) * 2 + (h)) * HTB)
#define PG8_STAGE(bufoff, gbase, voff) do { const char* gb_ = (const char*)(gbase); if constexpr (F8) asm volatile("" : "+s"(gb_)); _Pragma("unroll") for (int _i = 0; _i < 2; ++_i) \
        __builtin_amdgcn_global_load_lds((const unsigned*)(gb_ + (voff)[_i]), (LAS unsigned*)(lds + (bufoff) + ldsw + _i * 8192), 16, 0, 0); } while (0)
#define PG8_STAGE_G(bufoff, gbase, voff) do { const char* gb_ = (const char*)(gbase); asm volatile("" : "+s"(gb_)); _Pragma("unroll") for (int _i = 0; _i < 2; ++_i) \
        __builtin_amdgcn_global_load_lds((const unsigned*)(gb_ + (voff)[_i]), (LAS unsigned*)(lds + (bufoff) + ldsw + _i * 8192), 16, 0, 0); } while (0)
#define PG8_LDA(dst, b, h) do { _Pragma("unroll") for (int m = 0; m < 4; ++m) dst[m] = f8cat(*(const LAS bf16x8*)(lds + PG8_SA(b, h) + aoff + m * 2048), *(const LAS bf16x8*)(lds + PG8_SA(b, h) + aoff + m * 2048 + 1024)); } while (0)
#define PG8_LDB(dst, b, h) do { _Pragma("unroll") for (int n = 0; n < 2; ++n) dst[n] = f8cat(*(const LAS bf16x8*)(lds + ((b) * 2 + (h)) * HTB + boff + n * 2048), *(const LAS bf16x8*)(lds + ((b) * 2 + (h)) * HTB + boff + n * 2048 + 1024)); } while (0)
#define PG8_MMA(ai, bj, At, Bt) do { __builtin_amdgcn_s_setprio(1); _Pragma("unroll") for (int m = 0; m < 4; ++m) _Pragma("unroll") for (int n = 0; n < 2; ++n) { \
        if constexpr (F8 && I8) { i32x4_t c_ = __builtin_bit_cast(i32x4_t, acc[ai][bj][m][n]); \
            c_ = __builtin_amdgcn_mfma_i32_16x16x64_i8(__builtin_bit_cast(i32x4_t, f8lo(Bt[n])), __builtin_bit_cast(i32x4_t, f8lo(At[m])), c_, 0, 0, 0); \
            c_ = __builtin_amdgcn_mfma_i32_16x16x64_i8(__builtin_bit_cast(i32x4_t, f8hi(Bt[n])), __builtin_bit_cast(i32x4_t, f8hi(At[m])), c_, 0, 0, 0); acc[ai][bj][m][n] = __builtin_bit_cast(f32x4, c_); } \
        else if constexpr (F8) acc[ai][bj][m][n] = __builtin_amdgcn_mfma_scale_f32_16x16x128_f8f6f4(Bt[n], At[m], acc[ai][bj][m][n], 0, 0, 0, 0, 0, 0); \
        else { acc[ai][bj][m][n] = __builtin_amdgcn_mfma_f32_16x16x32_bf16(f8lo(Bt[n]), f8lo(At[m]), acc[ai][bj][m][n], 0, 0, 0); acc[ai][bj][m][n] = __builtin_amdgcn_mfma_f32_16x16x32_bf16(f8hi(Bt[n]), f8hi(At[m]), acc[ai][bj][m][n], 0, 0, 0); } } \
        __builtin_amdgcn_s_setprio(0); } while (0)
#define PG8_WAIT_V(n) asm volatile("s_waitcnt vmcnt(" #n ")" ::: "memory")
#define PG8_WAIT_L(n) asm volatile("s_waitcnt lgkmcnt(" #n ")" ::: "memory")
#define PG8_BAR __builtin_amdgcn_s_barrier()
#define PG8_SCHED __builtin_amdgcn_sched_barrier(0)
    Unit cur, nxt; int ui = 0;
    if (!S.next(0, cur)) return;
    Acc acc;
#pragma unroll
    for (int a = 0; a < 2; ++a)
#pragma unroll
        for (int b = 0; b < 2; ++b)
#pragma unroll
            for (int m = 0; m < 4; ++m)
#pragma unroll
                for (int n = 0; n < 2; ++n) acc[a][b][m][n] = (f32x4){0.f, 0.f, 0.f, 0.f};
    i32x8_t At[4], B0[2], B1[2];
    const char* cA = (const char*)g.A + (GATHER ? 0 : cur.aoff); const char* cB = (const char*)g.Bt + cur.boff;
    if constexpr (GATHER) { PG8_GLOAD(vc, 0); }
    PG8_STAGE(PG8_SB(0, 0), cB, voffB); PG8_STAGE(PG8_SB(0, 1), cB + hB, voffB);
    if constexpr (GATHER) { PG8_STAGE_G(PG8_SA(0, 0), cA, vc[0]); PG8_STAGE_G(PG8_SA(0, 1), cA, vc[1]); } else { PG8_STAGE(PG8_SA(0, 0), cA, voffA); PG8_STAGE(PG8_SA(0, 1), cA + hA, voffA); }
    if (wr == 1) PG8_BAR;
    PG8_WAIT_V(2); PG8_BAR;
    PG8_STAGE(PG8_SB(1, 0), cB + kB, voffB); if constexpr (GATHER) PG8_STAGE_G(PG8_SA(1, 0), cA + kA, vc[0]); else PG8_STAGE(PG8_SA(1, 0), cA + kA, voffA); PG8_STAGE(PG8_SB(1, 1), cB + hB + kB, voffB);
    PG8_WAIT_V(6); PG8_BAR;
    for (;;) {
        const bool has_next = S.next(ui + 1, nxt);
        const char* nA = (has_next && !GATHER) ? (const char*)g.A + nxt.aoff : cA; const char* nB = has_next ? (const char*)g.Bt + nxt.boff : cB;
        for (int t = 0; t < nt; t += 2) {
            const bool last = (t == nt - 2);
            const char* a1 = cA + (size_t)(t + 1) * kA;
            const char* a2 = last ? nA : cA + (size_t)(t + 2) * kA; const char* b2 = last ? nB : cB + (size_t)(t + 2) * kB;
            const char* a3 = a2 + kA; const char* b3 = b2 + kB;
            PG8_LDB(B0, 0, 0); PG8_LDB(B1, 0, 1); PG8_SCHED; PG8_LDA(At, 0, 0); if constexpr (GATHER) { PG8_STAGE_G(PG8_SA(1, 1), a1, vc[1]); if (last && has_next) PG8_GLOAD(vc, ui + 1); }     else PG8_STAGE(PG8_SA(1, 1), a1 + hA, voffA);
            PG8_WAIT_V(8); PG8_WAIT_L(0); PG8_BAR; PG8_MMA(0, 0, At, B0); PG8_MMA(0, 1, At, B1); PG8_BAR; PG8_SCHED;
            PG8_LDA(At, 0, 1); PG8_STAGE(PG8_SB(0, 0), b2, voffB); PG8_STAGE(PG8_SB(0, 1), b2 + hB, voffB); if constexpr (GATHER) PG8_STAGE_G(PG8_SA(0, 0), a2, vc[0]); else PG8_STAGE(PG8_SA(0, 0), a2, voffA);
            PG8_WAIT_V(8); PG8_WAIT_L(0); PG8_BAR; PG8_MMA(1, 0, At, B0); PG8_MMA(1, 1, At, B1); PG8_BAR; PG8_SCHED;
            PG8_LDB(B0, 1, 0); PG8_LDB(B1, 1, 1); PG8_SCHED; PG8_LDA(At, 1, 0); if constexpr (GATHER) PG8_STAGE_G(PG8_SA(0, 1), a2, vc[1]); else PG8_STAGE(PG8_SA(0, 1), a2 + hA, voffA);
            PG8_WAIT_V(8); PG8_WAIT_L(0); PG8_BAR; PG8_MMA(0, 0, At, B0); PG8_MMA(0, 1, At, B1); PG8_BAR; PG8_SCHED;
            PG8_LDA(At, 1, 1); PG8_STAGE(PG8_SB(1, 0), b3, voffB); PG8_STAGE(PG8_SB(1, 1), b3 + hB, voffB); if constexpr (GATHER) PG8_STAGE_G(PG8_SA(1, 0), a3, vc[0]); else PG8_STAGE(PG8_SA(1, 0), a3, voffA);
            PG8_WAIT_V(8); PG8_WAIT_L(0); PG8_BAR; PG8_MMA(1, 0, At, B0); PG8_MMA(1, 1, At, B1); PG8_BAR; PG8_SCHED;
        }
        if constexpr (ALIGN_EPI) { if (wr == 0) PG8_BAR; }
        { const int t2_ = lane_after(acc[1][1][3][1][3]); E(acc, cur, wr, wc, t2_ & 15, (t2_ >> 4) & 3); }
        if (!has_next) break;
#pragma unroll
        for (int a = 0; a < 2; ++a)
#pragma unroll
            for (int b = 0; b < 2; ++b)
#pragma unroll
                for (int m = 0; m < 4; ++m)
#pragma unroll
                    for (int n = 0; n < 2; ++n) acc[a][b][m][n] = (f32x4){0.f, 0.f, 0.f, 0.f};
        cur = nxt; cA = nA; cB = nB; ++ui;
        if constexpr (ALIGN_EPI) { if (wr == 1) PG8_BAR; }
    }
    PG8_WAIT_V(0);
    if constexpr (!ALIGN_EPI) { if (wr == 0) PG8_BAR; }
    PG8_BAR;
#undef PG8_GLOAD
#undef PG8_SA
#undef PG8_SB
#undef PG8_STAGE
#undef PG8_STAGE_G
#undef PG8_LDA
#undef PG8_LDB
#undef PG8_MMA
#undef PG8_WAIT_V
#undef PG8_WAIT_L
#undef PG8_BAR
#undef PG8_SCHED
}
}
#ifndef MFMA_MASK
#define MFMA_MASK 0xFFFFu
#endif
template <int PH, class Epi, class Sched>
__device__ __forceinline__ void gemm_run(const Frame& F, const Gemm g, const Sched& S, const Epi& E) {
    if constexpr (((MFMA_MASK >> PH) & 1u) != 0u) pg8::gemm_phase<Epi, Sched, true>(F.wave, (LAS unsigned char*)F.lds, g, S, E);
    else gemm_naive<Epi, Sched>(F.lds, g, S, E);
}

enum { MAP_ID = 0, MAP_GATE = 1, MAP_UP = 2, MAP_IN1 = 3, MAP_GATE8 = 4, MAP_UP8 = 5 };
__device__ __forceinline__ int map_row(int mapk, int n) {
    if (mapk == MAP_GATE) return 8 * (n >> 2) + (n & 3);
    if (mapk == MAP_UP) return 8 * (n >> 2) + 4 + (n & 3);
    if (mapk == MAP_GATE8 || mapk == MAP_UP8) return 256 * (n >> 7) + 128 * ((n >> 2) & 1) + 32 * ((n >> 5) & 3) + 8 * ((n >> 3) & 3) + (mapk == MAP_UP8 ? 4 : 0) + (n & 3);
    if (mapk == MAP_IN1) return n < 1280 ? n : (n < 1304 ? C_GL + (n - 1280) : n - 24);
    return n;
}
struct TrDesc { const float* W; bf16* WT; const float* gain; int K, N, mapk, k0, n0, ld8; float qs; };
__device__ __forceinline__ TrDesc tr_mk(const float* W, int K, int N, bf16* WT, const float* gain, int mapk, int item, int ld8 = 0, float qs = I8_WS) {
    TrDesc d; d.W = W; d.WT = WT; d.gain = gain; d.K = K; d.N = N; d.mapk = mapk; d.ld8 = ld8; d.qs = qs;
    const int nblk = (N + 63) >> 6, kb = item / nblk, nb = item - kb * nblk; d.k0 = 64 * kb; d.n0 = 64 * nb; return d;
}
__device__ __forceinline__ void tr_load(const TrDesc& d, f32x4 (&v)[16], int lane) {
    const int krow = lane >> 4, n = d.n0 + 4 * (lane & 15);
#pragma unroll
    for (int p = 0; p < 16; ++p) v[p] = n < d.N ? *(const f32x4*)(d.W + (size_t)(d.k0 + 4 * p + krow) * d.N + n) : (f32x4){0.f, 0.f, 0.f, 0.f};
}
__device__ __forceinline__ void tr_finish(const TrDesc& d, f32x4 (&v)[16], float* scr, int lane) {
    const int krow = lane >> 4, c4 = lane & 15;
    if (d.gain) {
#pragma unroll
        for (int p = 0; p < 16; ++p) v[p] = v[p] * d.gain[d.k0 + 4 * p + krow];
    }
#pragma unroll
    for (int p = 0; p < 16; ++p) { float* q = scr + (4 * p + krow) * 65 + 4 * c4; q[0] = v[p][0]; q[1] = v[p][1]; q[2] = v[p][2]; q[3] = v[p][3]; }
    LDS_FENCE();
    const int c = lane & 7;
#pragma unroll
    for (int j = 0; j < 8; ++j) {
        const int nl = (lane >> 3) + 8 * j, nn = d.n0 + nl;
        if (nn < d.N) {
            const float* sp = scr + (8 * c) * 65 + nl;
            if (d.ld8 < 0) {
                const float qs = d.qs; u32x2 o; o.x = pk4_i8(sp[0 * 65] * qs, sp[1 * 65] * qs, sp[2 * 65] * qs, sp[3 * 65] * qs); o.y = pk4_i8(sp[4 * 65] * qs, sp[5 * 65] * qs, sp[6 * 65] * qs, sp[7 * 65] * qs);
                *(u32x2*)((unsigned char*)d.WT + (size_t)map_row(d.mapk, nn) * (-d.ld8) + d.k0 + 8 * c) = o;
            } else if (d.ld8) {
                u32x2 o; o.x = pk4_f8(sp[0 * 65] * F8_WS, sp[1 * 65] * F8_WS, sp[2 * 65] * F8_WS, sp[3 * 65] * F8_WS); o.y = pk4_f8(sp[4 * 65] * F8_WS, sp[5 * 65] * F8_WS, sp[6 * 65] * F8_WS, sp[7 * 65] * F8_WS);
                *(u32x2*)((unsigned char*)d.WT + (size_t)map_row(d.mapk, nn) * d.ld8 + d.k0 + 8 * c) = o;
            } else {
                u32x4 o; o.x = pk2(sp[0 * 65], sp[1 * 65]); o.y = pk2(sp[2 * 65], sp[3 * 65]); o.z = pk2(sp[4 * 65], sp[5 * 65]); o.w = pk2(sp[6 * 65], sp[7 * 65]);
                *(u32x4*)(d.WT + (size_t)map_row(d.mapk, nn) * d.K + d.k0 + 8 * c) = o;
            }
        }
    }
    LDS_FENCE();
}
constexpr int I_IN0 = 16 * 44, I_SQ = 16 * 16, I_GU0 = 16 * 44, I_DN0 = 44 * 16, I_IN1 = 16 * 45, I_MG = 16 * 22, I_MD = 22 * 16, I_C1 = 32 * 4, I_C2 = 4 * 1, I_L64 = 8, I_L128 = 16;
constexpr int TR_NITEMS = I_IN0 + I_SQ + 2 * I_GU0 + I_DN0 + I_IN1 + I_SQ + 16 * I_MG + 8 * I_MD + 2 * I_C1 + 2 * I_C2 + 2 * I_L64 + I_L128;
__device__ __forceinline__ TrDesc tr_decode(const Frame& F, int it) {
    int r = it;
    if (r < I_IN0) return tr_mk(F.in[2], D, IN0, wsp<bf16>(F, WT_IN0), F.in[1], MAP_ID, r, -D); r -= I_IN0;
    if (r < I_SQ) return tr_mk(F.in[18], D, D, wsp<bf16>(F, WT_OUT0), nullptr, MAP_ID, r); r -= I_SQ;
    if (r < I_GU0) return tr_mk(F.in[20], D, FFN, wsp<bf16>(F, WT_GU0), F.in[19], MAP_GATE8, r, -D); r -= I_GU0;
    if (r < I_GU0) return tr_mk(F.in[21], D, FFN, wsp<bf16>(F, WT_GU0), F.in[19], MAP_UP8, r, -D); r -= I_GU0;
    if (r < I_DN0) return tr_mk(F.in[22], FFN, D, wsp<bf16>(F, WT_DN0), nullptr, MAP_ID, r, FFN); r -= I_DN0;
    if (r < I_IN1) return tr_mk(F.in[24], D, IN1, wsp<bf16>(F, WT_IN1), F.in[23], MAP_IN1, r, -D); r -= I_IN1;
    if (r < I_SQ) return tr_mk(F.in[32], D, D, wsp<bf16>(F, WT_OUT1), nullptr, MAP_ID, r); r -= I_SQ;
    if (r < 8 * I_MG) { const int e = r / I_MG; return tr_mk(F.in[36] + (size_t)e * D * EXPD, D, EXPD, (bf16*)(F.ws + WT_GU1 + (size_t)e * 2 * EXPD * D), F.in[33], MAP_GATE8, r - e * I_MG, -D); } r -= 8 * I_MG;
    if (r < 8 * I_MG) { const int e = r / I_MG; return tr_mk(F.in[37] + (size_t)e * D * EXPD, D, EXPD, (bf16*)(F.ws + WT_GU1 + (size_t)e * 2 * EXPD * D), F.in[33], MAP_UP8, r - e * I_MG, -D); } r -= 8 * I_MG;
    if (r < 8 * I_MD) { const int e = r / I_MD; return tr_mk(F.in[38] + (size_t)e * EXPD * D, EXPD, D, (bf16*)(F.ws + WT_DN1 + (size_t)e * D * AP8), nullptr, MAP_ID, r - e * I_MD, AP8); } r -= 8 * I_MD;
    if (r < I_C1) return tr_mk(F.in[27], 2048, 256, wsp<bf16>(F, WT_CK1), nullptr, MAP_ID, r, -2048, I8_C1S); r -= I_C1;
    if (r < I_C1) return tr_mk(F.in[29], 2048, 256, wsp<bf16>(F, WT_CV1), nullptr, MAP_ID, r, -2048, I8_C1S); r -= I_C1;
    if (r < I_C2) return tr_mk(F.in[28], 256, 64, wsp<bf16>(F, WT_CK2), nullptr, MAP_ID, r); r -= I_C2;
    if (r < I_C2) return tr_mk(F.in[30], 256, 64, wsp<bf16>(F, WT_CV2), nullptr, MAP_ID, r); r -= I_C2;
    if (r < I_L64) return tr_mk(F.in[9], 64, 512, wsp<bf16>(F, WT_W2), nullptr, MAP_ID, r); r -= I_L64;
    if (r < I_L64) return tr_mk(F.in[11], 64, 512, wsp<bf16>(F, WT_A2), nullptr, MAP_ID, r); r -= I_L64;
    return tr_mk(F.in[12], 128, 512, wsp<bf16>(F, WT_G2), nullptr, MAP_ID, r);
}
__device__ __forceinline__ void tr_range(const Frame& F, int lo, int hi, int gw, int NGW) {
    float* scr = (float*)(F.lds + F.wave * 16640);
    int lane_ = F.lane; asm volatile("" : "+v"(lane_));
    for (int it = lo + gw; it < hi; it += NGW) { TrDesc d = tr_decode(F, it); f32x4 v[16]; tr_load(d, v, lane_); tr_finish(d, v, scr, lane_); }
}
constexpr int CW_YRDY = 3072;
constexpr int CW_TRQ = 2048;
__device__ __forceinline__ void tr_queue(const Frame& F, int lo, int hi) {
    float* scr = (float*)(F.lds + F.wave * 16640);
    int lane_ = F.lane; asm volatile("" : "+v"(lane_));
    unsigned* head = (unsigned*)(F.ws + WS_CTL) + CW_TRQ;
    for (;;) {
        unsigned base = 0;
        if (lane_ == 0) base = __hip_atomic_fetch_add(head, 2u, __ATOMIC_RELAXED, __HIP_MEMORY_SCOPE_AGENT);
        base = __builtin_amdgcn_readfirstlane(base);
        const int it0 = lo + (int)base;
        if (it0 >= hi) break;
        { TrDesc d = tr_decode(F, it0); f32x4 v[16]; tr_load(d, v, lane_); tr_finish(d, v, scr, lane_); }
        if (it0 + 1 < hi) { TrDesc d = tr_decode(F, it0 + 1); f32x4 v[16]; tr_load(d, v, lane_); tr_finish(d, v, scr, lane_); }
    }
}
constexpr int TR_LORA0 = TR_NITEMS - (2 * I_L64 + I_L128);
__device__ __forceinline__ void p0_prologue(const Frame& F) {
    const int gw = F.blk * NWAVES + F.wave, NGW = F.G * NWAVES;
    tr_range(F, 0, I_IN0 + I_SQ, gw, NGW);
    tr_range(F, TR_LORA0, TR_NITEMS, gw, NGW);
    {
        const float* x = F.in[0]; bf16* XB = wsp<bf16>(F, WS_XB); float* rstd0 = wsp<float>(F, M_RSTD0);
        for (int m = gw; m < NTOK; m += NGW) {
            const f32x4* xr = (const f32x4*)(x + (size_t)m * D) + F.lane; f32x4 v[4]; float s = 0.f;
#pragma unroll
            for (int j = 0; j < 4; ++j) { v[j] = xr[64 * j]; s += (v[j].x * v[j].x + v[j].y * v[j].y) + (v[j].z * v[j].z + v[j].w * v[j].w); }
            s = wave_sum(s);
            float amax = 0.f;
#pragma unroll
            for (int j = 0; j < 4; ++j) amax = fmaxf(fmaxf(amax, fmaxf(fabsf(v[j].x), fabsf(v[j].y))), fmaxf(fabsf(v[j].z), fabsf(v[j].w)));
            amax = fmaxf(wave_max(amax), 1e-20f);
            const float qs = 127.0f * rcpf_(amax);
            u32x2* o8 = (u32x2*)(XB + (size_t)m * D) + F.lane;
#pragma unroll
            for (int j = 0; j < 4; ++j) { u32x2 w; w.x = pk2(v[j].x, v[j].y); w.y = pk2(v[j].z, v[j].w); o8[64 * j] = w; }
            unsigned* q4 = (unsigned*)(F.ws + WS_XQI + (size_t)m * D) + F.lane;
#pragma unroll
            for (int j = 0; j < 4; ++j) q4[64 * j] = pk4_i8(v[j].x * qs, v[j].y * qs, v[j].z * qs, v[j].w * qs);
            if (F.lane == 0) rstd0[m] = rsqrtf(s * (1.0f / D) + 1e-6f) * amax * (1.0f / 127.0f);
        }
    }
    const int gt = F.blk * NTHR + F.tid, NGT = F.G * NTHR;
    {
        float* rope = wsp<float>(F, M_ROPE);
        for (int idx = gt; idx < SEQ * 8; idx += NGT) {
            const int t = idx >> 3, i = idx & 7;
            const float invf = (float)pow(500000.0, -(double)i / 8.0);
            const float ang = (float)t * invf;
            rope[t * 16 + i] = cosf(ang); rope[t * 16 + 8 + i] = sinf(ang);
        }
    }
    {
        float* c1 = wsp<float>(F, M_C1);
        for (int idx = gw; idx < 512; idx += NGW) {
            const int which = idx >> 8, n = idx & 255; const float* pos = F.in[25 + which]; const float* W1 = F.in[which ? 29 : 27];
            float sacc = 0.f;
#pragma unroll 8
            for (int k = F.lane; k < 2048; k += 64) sacc += pos[k] * W1[(size_t)k * 256 + n];
            sacc = wave_sum(sacc);
            if (F.lane == 0) c1[idx] = sacc;
        }
    }
    {
        float* wr = wsp<float>(F, M_WR);
        for (int idx = gt; idx < 8 * D; idx += NGT) { const int e = idx >> 10, k = idx & 1023; wr[idx] = F.in[33][k] * F.in[34][k * 8 + e]; }
    }
    {
        bf16* wm = wsp<bf16>(F, WT_SGU);
        for (int idx = gt; idx < 4 * 128 * 128; idx += NGT) { const int t = (idx >> 7) & 127, s = idx & 127; wm[idx] = (bf16)(s <= t ? f2bf(F.in[5][idx]) : 0u); }
    }
    {
        for (int idx = gt; idx < NEXP * D * 8; idx += NGT) *(u32x4*)(F.ws + WT_DN1 + (size_t)(idx >> 3) * AP8 + EXPD + 16 * (idx & 7)) = (u32x4){0u, 0u, 0u, 0u};
    }
    {
        u32x4* z = (u32x4*)(F.ws + WT_IN1 + (size_t)IN1 * D);
        for (int idx = gt; idx < (IN1P - IN1) * D / 16; idx += NGT) z[idx] = (u32x4){0u, 0u, 0u, 0u};
    }
}

constexpr int RW_R = 0, RW_K = 8192, RW_V = 16384, RW_LIN = 24576, RW_LINP = 264, RW_DEC = 41472, RW_KK = 49664, RW_KKA = 57856, RW_KP = 66048, RW_WR = 74240, RW_G = 82432, RW_YO = 90624, RW_SC = 98816, RW_DUMMY = 99328, RW_MU = 103424, RW_LW2 = 105216, RW_LA2 = 114432, RW_LG2 = 123648;
struct RwA { u32x4 cur[4], prev[4]; };
__device__ __forceinline__ void rwkv_loadA(RwA& A, const bf16* PB, int b, int h, int t0, int tid) {
#pragma unroll
    for (int i = 0; i < 4; ++i) {
        const int idx = tid + NTHR * i;
        if (idx < 32 * 56) {
            const int tl = idx / 56, ch = idx - tl * 56;
            const int pc = ch < 8 ? 64 * h + 8 * ch : (ch < 16 ? 512 + 64 * h + 8 * (ch - 8) : (ch < 24 ? 1024 + 64 * h + 8 * (ch - 16) : 1536 + 8 * (ch - 24)));
            const int t = t0 + tl; const bf16* p = PB + ((size_t)b * SEQ + t) * IN0 + 1024 + pc;
            A.cur[i] = *(const u32x4*)p;
            A.prev[i] = t > 0 ? *(const u32x4*)(p - IN0) : (u32x4){0u, 0u, 0u, 0u};
        }
    }
}
__device__ __forceinline__ void rwkv_item(const Frame& F, int b, int h) {
    LAS unsigned char* L = (LAS unsigned char*)F.lds;
    const bf16* PB = wsp<bf16>(F, WS_PB); bf16* Y = wsp<bf16>(F, WS_YB);
    const float* mu = F.in[7]; const float* w0 = F.in[8]; const float* a0 = F.in[10];
    const float* k_k = F.in[13]; const float* k_a = F.in[14]; const float* r_k = F.in[15]; const float* gn_g = F.in[16]; const float* gn_b = F.in[17];
    int tid = F.tid; asm volatile("" : "+v"(tid));
    const int lane = tid & 63, wave = F.wave;
    const int jq = lane & 15, rg = lane >> 4, tl16 = tid >> 4;
    const int hc4 = 64 * h + 4 * jq;
    const f32x4 w0v = *(const f32x4*)(w0 + hc4), a0v = *(const f32x4*)(a0 + hc4), kkv = *(const f32x4*)(k_k + hc4), kav = *(const f32x4*)(k_a + hc4), rkv = *(const f32x4*)(r_k + hc4), gngv = *(const f32x4*)(gn_g + hc4), gnbv = *(const f32x4*)(gn_b + hc4);
    const int mt = wave >> 2, ntl = wave & 3, fr = lane & 15, fq = lane >> 4;
    const int i0 = 8 * wave + rg, i1 = i0 + 4;
    f32x2 s0a = {0.f, 0.f}, s0b = {0.f, 0.f}, s1a = {0.f, 0.f}, s1b = {0.f, 0.f};
    {
        if (tid < 56 * 2) { const int ch = tid >> 1, hf = tid & 1;
            const int pc = ch < 8 ? 64 * h + 8 * ch : (ch < 16 ? 512 + 64 * h + 8 * (ch - 8) : (ch < 24 ? 1024 + 64 * h + 8 * (ch - 16) : 1536 + 8 * (ch - 24)));
            *(LAS f32x4*)(L + RW_MU + ch * 32 + hf * 16) = *(const f32x4*)(mu + pc + 4 * hf); }
        { const int row = tid >> 3, c8 = tid & 7;
          *(LAS u32x4*)(L + RW_LW2 + (row * 72 + c8 * 8) * 2) = *(const u32x4*)(wsp<bf16>(F, WT_W2) + (size_t)(64 * h + row) * 64 + c8 * 8);
          *(LAS u32x4*)(L + RW_LA2 + (row * 72 + c8 * 8) * 2) = *(const u32x4*)(wsp<bf16>(F, WT_A2) + (size_t)(64 * h + row) * 64 + c8 * 8); }
#pragma unroll
        for (int i = 0; i < 2; ++i) { const int id = tid + NTHR * i, row = id >> 4, c16 = id & 15;
          *(LAS u32x4*)(L + RW_LG2 + (row * 136 + c16 * 8) * 2) = *(const u32x4*)(wsp<bf16>(F, WT_G2) + (size_t)(64 * h + row) * 128 + c16 * 8); }
        __syncthreads();
    }
    RwA A; rwkv_loadA(A, PB, b, h, 0, tid);
    for (int t0 = 0; t0 < SEQ; t0 += 32) {
#pragma unroll
        for (int i = 0; i < 4; ++i) {
            const int idx = tid + NTHR * i;
            if (idx < 32 * 56) {
                const int tl = idx / 56, ch = idx - tl * 56;
                const int pc = ch < 8 ? 64 * h + 8 * ch : (ch < 16 ? 512 + 64 * h + 8 * (ch - 8) : (ch < 24 ? 1024 + 64 * h + 8 * (ch - 16) : 1536 + 8 * (ch - 24)));
                const f32x4 m0 = *(const LAS f32x4*)(L + RW_MU + ch * 32), m1 = *(const LAS f32x4*)(L + RW_MU + ch * 32 + 16);
                float xs[8];
#pragma unroll
                for (int j = 0; j < 4; ++j) {
                    const float c0 = bf2f(A.cur[i][j] & 0xffffu), c1 = bf2f(A.cur[i][j] >> 16), p0 = bf2f(A.prev[i][j] & 0xffffu), p1 = bf2f(A.prev[i][j] >> 16);
                    const float mA = j < 2 ? m0[2 * j] : m1[2 * j - 4], mB = j < 2 ? m0[2 * j + 1] : m1[2 * j - 3];
                    xs[2 * j] = c0 + (p0 - c0) * mA; xs[2 * j + 1] = c1 + (p1 - c1) * mB;
                }
                if (ch < 24) {
                    LAS float* dst = (LAS float*)(L + (ch < 8 ? RW_R : (ch < 16 ? RW_K : RW_V))) + tl * 64 + 8 * (ch & 7);
                    *(LAS f32x4*)dst = (f32x4){xs[0], xs[1], xs[2], xs[3]}; *(LAS f32x4*)(dst + 4) = (f32x4){xs[4], xs[5], xs[6], xs[7]};
                } else {
                    const int lc = ch - 24;
                    if (lc < 8) {
#pragma unroll
                        for (int j = 0; j < 8; ++j) xs[j] = 1.0f - 2.0f / (1.0f + __expf(2.0f * xs[j]));
                    } else if (lc >= 16) {
#pragma unroll
                        for (int j = 0; j < 8; ++j) xs[j] = sigmoidf_(xs[j]);
                    }
                    u32x4 w; w.x = pk2(xs[0], xs[1]); w.y = pk2(xs[2], xs[3]); w.z = pk2(xs[4], xs[5]); w.w = pk2(xs[6], xs[7]);
                    *(LAS u32x4*)(L + RW_LIN + (tl * RW_LINP + 8 * lc) * 2) = w;
                }
            }
        }
        __syncthreads();
        {
            const LAS unsigned char* arow = L + RW_LIN + ((16 * mt + fr) * RW_LINP + 8 * fq) * 2;
            f32x4 cw = {0.f, 0.f, 0.f, 0.f}, ca = {0.f, 0.f, 0.f, 0.f}, cg = {0.f, 0.f, 0.f, 0.f};
            const LAS unsigned char* bw = L + RW_LW2 + ((16 * ntl + fr) * 72 + 8 * fq) * 2;
            const LAS unsigned char* ba = L + RW_LA2 + ((16 * ntl + fr) * 72 + 8 * fq) * 2;
            const LAS unsigned char* bg = L + RW_LG2 + ((16 * ntl + fr) * 136 + 8 * fq) * 2;
#pragma unroll
            for (int ks = 0; ks < 2; ++ks) {
                cw = __builtin_amdgcn_mfma_f32_16x16x32_bf16(*(const LAS bf16x8*)(arow + 64 * ks), *(const LAS bf16x8*)(bw + 64 * ks), cw, 0, 0, 0);
                ca = __builtin_amdgcn_mfma_f32_16x16x32_bf16(*(const LAS bf16x8*)(arow + 128 + 64 * ks), *(const LAS bf16x8*)(ba + 64 * ks), ca, 0, 0, 0);
            }
#pragma unroll
            for (int ks = 0; ks < 4; ++ks) cg = __builtin_amdgcn_mfma_f32_16x16x32_bf16(*(const LAS bf16x8*)(arow + 256 + 64 * ks), *(const LAS bf16x8*)(bg + 64 * ks), cg, 0, 0, 0);
#pragma unroll
            for (int r = 0; r < 4; ++r) {
                const int o = (16 * mt + 4 * fq + r) * 64 + 16 * ntl + fr;
                ((LAS float*)(L + RW_DEC))[o] = cw[r]; ((LAS float*)(L + RW_KKA))[o] = ca[r]; ((LAS float*)(L + RW_G))[o] = cg[r];
            }
        }
        __syncthreads();
        {
            const int o4 = (tl16 * 64 + 4 * jq) * 4;
            const f32x4 lw = *(const LAS f32x4*)(L + RW_DEC + o4), la = *(const LAS f32x4*)(L + RW_KKA + o4), kr = *(const LAS f32x4*)(L + RW_K + o4), r = *(const LAS f32x4*)(L + RW_R + o4);
            f32x4 dec, a, kkr, kp;
#pragma unroll
            for (int i = 0; i < 4; ++i) {
                const float nx = -(w0v[i] + lw[i]);
                const float sp = fmaxf(nx, 0.f) + __logf(1.0f + __expf(-fabsf(nx)));
                dec[i] = __expf(-__expf(-sp - 0.5f));
                a[i] = sigmoidf_(a0v[i] + la[i]);
                kkr[i] = kr[i] * kkv[i]; kp[i] = kr[i] * (1.0f + (a[i] - 1.0f) * kav[i]);
            }
            const float n2 = red16((kkr[0] * kkr[0] + kkr[1] * kkr[1]) + (kkr[2] * kkr[2] + kkr[3] * kkr[3]));
            const float inv = 1.0f / fmaxf(sqrtf(n2), 1e-12f);
            const f32x4 kk = kkr * inv, kka = kk * a;
            const float c1 = red16((kka[0] * r[0] + kka[1] * r[1]) + (kka[2] * r[2] + kka[3] * r[3]));
            const float c2 = red16((kp[0] * r[0] + kp[1] * r[1]) + (kp[2] * r[2] + kp[3] * r[3]));
            const float c3 = red16((r[0] * kp[0] * rkv[0] + r[1] * kp[1] * rkv[1]) + (r[2] * kp[2] * rkv[2] + r[3] * kp[3] * rkv[3]));
            *(LAS f32x4*)(L + RW_DEC + o4) = dec; *(LAS f32x4*)(L + RW_KK + o4) = kk; *(LAS f32x4*)(L + RW_KKA + o4) = kka; *(LAS f32x4*)(L + RW_KP + o4) = kp; *(LAS f32x4*)(L + RW_WR + o4) = dec * r;
            if (jq == 0) { LAS float* sc = (LAS float*)(L + RW_SC) + tl16 * 4; sc[0] = c1; sc[1] = c2; sc[2] = c3; }
        }
        __syncthreads();
        if (t0 + 32 < SEQ) rwkv_loadA(A, PB, b, h, t0 + 32, tid);
        {
            const LAS unsigned char* p1 = L + RW_DEC + 16 * jq;
            const LAS unsigned char* p2 = L + RW_V + 4 * i0;
            const LAS unsigned char* p3 = L + RW_SC;
            LAS unsigned char* py = L + (jq == 0 ? RW_YO + 4 * i0 : RW_DUMMY + (tid >> 2) * 32 + (tid & 3) * 4);
            const int ystep = jq == 0 ? 512 : 0;
#define RW_LOAD(B, o) do { B##d = *(const LAS f32x4*)(p1 + (o) * 256); B##k = *(const LAS f32x4*)(p1 + 8192 + (o) * 256); B##a = *(const LAS f32x4*)(p1 + 16384 + (o) * 256); \
                B##p = *(const LAS f32x4*)(p1 + 24576 + (o) * 256); B##w = *(const LAS f32x4*)(p1 + 32768 + (o) * 256); \
                B##v0 = *(const LAS float*)(p2 + (o) * 256); B##v1 = *(const LAS float*)(p2 + 16 + (o) * 256); B##c = *(const LAS f32x2*)(p3 + (o) * 16); } while (0)
#define RW_STEP(B, yo) do { \
                const f32x2 kl = {B##k[0], B##k[1]}, kh = {B##k[2], B##k[3]}, wl = {B##w[0], B##w[1]}, wh = {B##w[2], B##w[3]}; \
                f32x2 ta = s0a * kl; ta = s0b * kh + ta; f32x2 tb = s1a * kl; tb = s1b * kh + tb; f32x2 ua = s0a * wl; ua = s0b * wh + ua; f32x2 ub = s1a * wl; ub = s1b * wh + ub; \
                const float sa0 = red16(ta.x + ta.y), sa1 = red16(tb.x + tb.y), yy0 = red16(ua.x + ua.y), yy1 = red16(ub.x + ub.y); \
                const f32x2 dl = {B##d[0], B##d[1]}, dh = {B##d[2], B##d[3]}, al = {B##a[0], B##a[1]}, ah = {B##a[2], B##a[3]}, pl = {B##p[0], B##p[1]}, ph = {B##p[2], B##p[3]}; \
                s0a = s0a * dl - al * sa0 + pl * B##v0; s0b = s0b * dh - ah * sa0 + ph * B##v0; s1a = s1a * dl - al * sa1 + pl * B##v1; s1b = s1b * dh - ah * sa1 + ph * B##v1; \
                *(LAS float*)(py + (yo)) = yy0 - sa0 * B##c.x + B##v0 * B##c.y; *(LAS float*)(py + (yo) + 16) = yy1 - sa1 * B##c.x + B##v1 * B##c.y; } while (0)
            f32x4 Ad, Ak, Aa, Ap, Aw, Bd, Bk, Ba, Bp, Bw; float Av0, Av1, Bv0, Bv1; f32x2 Ac, Bc;
            RW_LOAD(A, 0);
#pragma unroll 1
            for (int t = 0; t < 32; t += 2) {
                RW_LOAD(B, 1);
                RW_STEP(A, 0);
                py += ystep >> 1;
                if (t + 2 < 32) RW_LOAD(A, 2);
                RW_STEP(B, 0);
                py += ystep >> 1; p1 += 512; p2 += 512; p3 += 32;
            }
#undef RW_LOAD
#undef RW_STEP
        }
        __syncthreads();
        {
            const int o4 = (tl16 * 64 + 4 * jq) * 4;
            const f32x4 y = *(const LAS f32x4*)(L + RW_YO + o4), vv = *(const LAS f32x4*)(L + RW_V + o4), gg = *(const LAS f32x4*)(L + RW_G + o4);
            const float mean = red16((y[0] + y[1]) + (y[2] + y[3])) * (1.0f / 64.0f);
            const f32x4 dd = y - mean;
            const float var = red16((dd[0] * dd[0] + dd[1] * dd[1]) + (dd[2] * dd[2] + dd[3] * dd[3])) * (1.0f / 64.0f);
            const float rs = rsqrtf(var + 64e-5f), c3 = ((const LAS float*)(L + RW_SC))[tl16 * 4 + 2];
            const f32x4 ov = (dd * rs * gngv + gnbv + vv * c3) * gg;
            u32x2 w; w.x = pk2(ov[0], ov[1]); w.y = pk2(ov[2], ov[3]);
            *(u32x2*)(Y + ((size_t)b * SEQ + t0 + tl16) * D + 512 + hc4) = w;
        }
        __syncthreads();
    }
}
namespace rw2 {
constexpr int SETB = 33024, S_DEC = 0, S_KK = 4096, S_KKA = 8192, S_KP = 12288, S_WR = 16384, S_V = 20480, S_G = 24576, S_YO = 28672, S_SC = 32768;
constexpr int STG_R = 66048, STG_K = 70144, LINB = 74240, LINW = 2112, LINP = 264, MU = 82688, LW2 = 84480, LA2 = 93696, LG2 = 102912, DUMMY = 120320;
constexpr int NCH = SEQ / 16;
__device__ __forceinline__ float red8(float v) { v += dpp_f<0xB1>(v); v += dpp_f<0x4E>(v); v += dpp_f<0x141>(v); return v; }
struct RegA { u32x4 cur[4], prev[4]; };
__device__ __forceinline__ int piece_pc(int ch, int h) { return ch < 8 ? 64 * h + 8 * ch : (ch < 16 ? 512 + 64 * h + 8 * (ch - 8) : (ch < 24 ? 1024 + 64 * h + 8 * (ch - 16) : 1536 + 8 * (ch - 24))); }
__device__ __forceinline__ void loadA(RegA& A, const bf16* PB, int b, int h, int t0, int pw, int lane) {
#pragma unroll
    for (int i = 0; i < 4; ++i) {
        const int idx = lane + 64 * i;
        if (idx < 224) {
            const int tl = idx / 56, ch = idx - tl * 56; const int t = t0 + 4 * pw + tl;
            const bf16* p = PB + ((size_t)b * SEQ + t) * IN0 + 1024 + piece_pc(ch, h);
            A.cur[i] = *(const u32x4*)p;
            A.prev[i] = t > 0 ? *(const u32x4*)(p - IN0) : (u32x4){0u, 0u, 0u, 0u};
        }
    }
}
__device__ __forceinline__ void item(const Frame& F, int b, int h) {
    LAS unsigned char* L = (LAS unsigned char*)F.lds;
    const bf16* PB = wsp<bf16>(F, WS_PB); bf16* Y = wsp<bf16>(F, WS_YB);
    int tid = F.tid; asm volatile("" : "+v"(tid));
    const int lane = tid & 63, wave = F.wave;
    {
        const float* mu = F.in[7];
        if (tid < 112) { const int ch = tid >> 1, hf = tid & 1; *(LAS f32x4*)(L + MU + ch * 32 + hf * 16) = *(const f32x4*)(mu + piece_pc(ch, h) + 4 * hf); }
        { const int row = tid >> 3, c8 = tid & 7;
          *(LAS u32x4*)(L + LW2 + (row * 72 + c8 * 8) * 2) = *(const u32x4*)(wsp<bf16>(F, WT_W2) + (size_t)(64 * h + row) * 64 + c8 * 8);
          *(LAS u32x4*)(L + LA2 + (row * 72 + c8 * 8) * 2) = *(const u32x4*)(wsp<bf16>(F, WT_A2) + (size_t)(64 * h + row) * 64 + c8 * 8); }
#pragma unroll
        for (int i = 0; i < 2; ++i) { const int id = tid + NTHR * i, row = id >> 4, c16 = id & 15;
          *(LAS u32x4*)(L + LG2 + (row * 136 + c16 * 8) * 2) = *(const u32x4*)(wsp<bf16>(F, WT_G2) + (size_t)(64 * h + row) * 128 + c16 * 8); }
        __syncthreads();
    }
    if (wave < 4) {
        const int q8 = lane & 7, i0 = 16 * wave + (lane >> 3);
        f32x2 s0[4], s1[4];
#pragma unroll
        for (int j = 0; j < 4; ++j) { s0[j] = (f32x2){0.f, 0.f}; s1[j] = (f32x2){0.f, 0.f}; }
        const int yreal = q8 == 0;
        __syncthreads();
#define RW2_LOAD(B, o) do { \
            B##d0 = *(const LAS f32x4*)(p1 + S_DEC + (o) * 256); B##d1 = *(const LAS f32x4*)(p1 + S_DEC + 16 + (o) * 256); \
            B##k0 = *(const LAS f32x4*)(p1 + S_KK + (o) * 256);  B##k1 = *(const LAS f32x4*)(p1 + S_KK + 16 + (o) * 256); \
            B##a0 = *(const LAS f32x4*)(p1 + S_KKA + (o) * 256); B##a1 = *(const LAS f32x4*)(p1 + S_KKA + 16 + (o) * 256); \
            B##p0 = *(const LAS f32x4*)(p1 + S_KP + (o) * 256);  B##p1 = *(const LAS f32x4*)(p1 + S_KP + 16 + (o) * 256); \
            B##w0 = *(const LAS f32x4*)(p1 + S_WR + (o) * 256);  B##w1 = *(const LAS f32x4*)(p1 + S_WR + 16 + (o) * 256); \
            B##v0 = *(const LAS float*)(p2 + (o) * 256); B##v1 = *(const LAS float*)(p2 + 32 + (o) * 256); B##c = *(const LAS f32x2*)(p3 + (o) * 16); } while (0)
#define RW2_DOT(S, X0, X1) ({ f32x2 t_ = S[0] * (f32x2){X0[0], X0[1]}; t_ = S[1] * (f32x2){X0[2], X0[3]} + t_; t_ = S[2] * (f32x2){X1[0], X1[1]} + t_; t_ = S[3] * (f32x2){X1[2], X1[3]} + t_; t_.x + t_.y; })
#define RW2_UPD(S, SA, V, B) do { \
            S[0] = S[0] * (f32x2){B##d0[0], B##d0[1]} - (f32x2){B##a0[0], B##a0[1]} * SA + (f32x2){B##p0[0], B##p0[1]} * V; \
            S[1] = S[1] * (f32x2){B##d0[2], B##d0[3]} - (f32x2){B##a0[2], B##a0[3]} * SA + (f32x2){B##p0[2], B##p0[3]} * V; \
            S[2] = S[2] * (f32x2){B##d1[0], B##d1[1]} - (f32x2){B##a1[0], B##a1[1]} * SA + (f32x2){B##p1[0], B##p1[1]} * V; \
            S[3] = S[3] * (f32x2){B##d1[2], B##d1[3]} - (f32x2){B##a1[2], B##a1[3]} * SA + (f32x2){B##p1[2], B##p1[3]} * V; } while (0)
#define RW2_STEP(B, yo) do { \
            const float sa0 = red8(RW2_DOT(s0, B##k0, B##k1)), sa1 = red8(RW2_DOT(s1, B##k0, B##k1)), yy0 = red8(RW2_DOT(s0, B##w0, B##w1)), yy1 = red8(RW2_DOT(s1, B##w0, B##w1)); \
            RW2_UPD(s0, sa0, B##v0, B); RW2_UPD(s1, sa1, B##v1, B); \
            *(LAS float*)(py + (yo)) = yy0 - sa0 * B##c.x + B##v0 * B##c.y; *(LAS float*)(py + (yo) + 32) = yy1 - sa1 * B##c.x + B##v1 * B##c.y; } while (0)
#pragma unroll 1
        for (int c = 0; c < NCH; ++c) {
            const LAS unsigned char* sb = L + (c & 1) * SETB;
            const LAS unsigned char* p1 = sb + 32 * q8;
            const LAS unsigned char* p2 = sb + S_V + 4 * i0;
            const LAS unsigned char* p3 = sb + S_SC;
            LAS unsigned char* py = yreal ? (LAS unsigned char*)sb + S_YO + 4 * i0 : L + DUMMY + (tid >> 3) * 64 + (tid & 7) * 4;
            const int ystep = yreal ? 256 : 0;
            f32x4 Ad0, Ad1, Ak0, Ak1, Aa0, Aa1, Ap0, Ap1, Aw0, Aw1, Bd0, Bd1, Bk0, Bk1, Ba0, Ba1, Bp0, Bp1, Bw0, Bw1; float Av0, Av1, Bv0, Bv1; f32x2 Ac, Bc;
            RW2_LOAD(A, 0);
#pragma unroll 1
            for (int t = 0; t < 16; t += 2) {
                RW2_LOAD(B, 1);
                RW2_STEP(A, 0);
                py += ystep;
                if (t + 2 < 16) RW2_LOAD(A, 2);
                RW2_STEP(B, 0);
                py += ystep; p1 += 512; p2 += 512; p3 += 32;
            }
            asm volatile("s_waitcnt lgkmcnt(0)" ::: "memory");
            __syncthreads();
        }
#undef RW2_LOAD
#undef RW2_DOT
#undef RW2_UPD
#undef RW2_STEP
        __syncthreads();
    } else {
        const int pw = wave - 4, jq = lane & 15, tk = lane >> 4, tl = 4 * pw + tk;
        const int hc4 = 64 * h + 4 * jq;
        const f32x4 w0v = *(const f32x4*)(F.in[8] + hc4), a0v = *(const f32x4*)(F.in[10] + hc4), kkv = *(const f32x4*)(F.in[13] + hc4), kav = *(const f32x4*)(F.in[14] + hc4), rkv = *(const f32x4*)(F.in[15] + hc4),
                    gngv = *(const f32x4*)(F.in[16] + hc4), gnbv = *(const f32x4*)(F.in[17] + hc4);
        const int fr = lane & 15, fq = lane >> 4;
        LAS unsigned char* stR = L + STG_R + pw * 1024; LAS unsigned char* stK = L + STG_K + pw * 1024; LAS unsigned char* lin = L + LINB + pw * LINW;
        RegA A; loadA(A, PB, b, h, 0, pw, lane);
#define RW2_PREP(c_) do { \
            LAS unsigned char* sb = L + ((c_) & 1) * SETB; \
            _Pragma("unroll") for (int i = 0; i < 4; ++i) { \
                const int idx = lane + 64 * i; \
                if (idx < 224) { \
                    const int tl_ = idx / 56, ch = idx - tl_ * 56; \
                    const f32x4 m0 = *(const LAS f32x4*)(L + MU + ch * 32), m1 = *(const LAS f32x4*)(L + MU + ch * 32 + 16); \
                    float xs[8]; \
                    _Pragma("unroll") for (int j = 0; j < 4; ++j) { \
                        const float c0 = bf2f(A.cur[i][j] & 0xffffu), c1 = bf2f(A.cur[i][j] >> 16), p0 = bf2f(A.prev[i][j] & 0xffffu), p1 = bf2f(A.prev[i][j] >> 16); \
                        const float mA = j < 2 ? m0[2 * j] : m1[2 * j - 4], mB = j < 2 ? m0[2 * j + 1] : m1[2 * j - 3]; \
                        xs[2 * j] = c0 + (p0 - c0) * mA; xs[2 * j + 1] = c1 + (p1 - c1) * mB; } \
                    if (ch < 24) { \
                        LAS float* dst = ch < 8 ? (LAS float*)stR + tl_ * 64 + 8 * ch : (ch < 16 ? (LAS float*)stK + tl_ * 64 + 8 * (ch - 8) : (LAS float*)(sb + S_V) + (4 * pw + tl_) * 64 + 8 * (ch - 16)); \
                        *(LAS f32x4*)dst = (f32x4){xs[0], xs[1], xs[2], xs[3]}; *(LAS f32x4*)(dst + 4) = (f32x4){xs[4], xs[5], xs[6], xs[7]}; \
                    } else { \
                        const int lc = ch - 24; \
                        if (lc < 8) { _Pragma("unroll") for (int j = 0; j < 8; ++j) xs[j] = 1.0f - 2.0f * rcpf_(1.0f + __expf(2.0f * xs[j])); } \
                        else if (lc >= 16) { _Pragma("unroll") for (int j = 0; j < 8; ++j) xs[j] = sigmoidf_(xs[j]); } \
                        u32x4 w_; w_.x = pk2(xs[0], xs[1]); w_.y = pk2(xs[2], xs[3]); w_.z = pk2(xs[4], xs[5]); w_.w = pk2(xs[6], xs[7]); \
                        *(LAS u32x4*)(lin + (tl_ * LINP + 8 * lc) * 2) = w_; } } } \
            if ((c_) + 1 < NCH) loadA(A, PB, b, h, 16 * ((c_) + 1), pw, lane); \
            LDS_FENCE(); \
            { const LAS unsigned char* arow = lin + ((fr & 3) * LINP + 8 * fq) * 2; \
              _Pragma("unroll") for (int nt = 0; nt < 4; ++nt) { \
                const LAS unsigned char* bw = L + LW2 + ((16 * nt + fr) * 72 + 8 * fq) * 2; const LAS unsigned char* ba = L + LA2 + ((16 * nt + fr) * 72 + 8 * fq) * 2; const LAS unsigned char* bg = L + LG2 + ((16 * nt + fr) * 136 + 8 * fq) * 2; \
                f32x4 cw = {0.f, 0.f, 0.f, 0.f}, ca = {0.f, 0.f, 0.f, 0.f}, cg = {0.f, 0.f, 0.f, 0.f}; \
                _Pragma("unroll") for (int ks = 0; ks < 2; ++ks) { \
                    cw = __builtin_amdgcn_mfma_f32_16x16x32_bf16(*(const LAS bf16x8*)(arow + 64 * ks), *(const LAS bf16x8*)(bw + 64 * ks), cw, 0, 0, 0); \
                    ca = __builtin_amdgcn_mfma_f32_16x16x32_bf16(*(const LAS bf16x8*)(arow + 128 + 64 * ks), *(const LAS bf16x8*)(ba + 64 * ks), ca, 0, 0, 0); } \
                _Pragma("unroll") for (int ks = 0; ks < 4; ++ks) cg = __builtin_amdgcn_mfma_f32_16x16x32_bf16(*(const LAS bf16x8*)(arow + 256 + 64 * ks), *(const LAS bf16x8*)(bg + 64 * ks), cg, 0, 0, 0); \
                if (fq == 0) { _Pragma("unroll") for (int r = 0; r < 4; ++r) { const int o = ((4 * pw + r) * 64 + 16 * nt + fr) * 4; \
                    *(LAS float*)(sb + S_DEC + o) = cw[r]; *(LAS float*)(sb + S_KKA + o) = ca[r]; *(LAS float*)(sb + S_G + o) = cg[r]; } } } } \
            LDS_FENCE(); \
            { const int o4 = (tl * 64 + 4 * jq) * 4, st4 = (tk * 64 + 4 * jq) * 4; \
              const f32x4 lw = *(const LAS f32x4*)(sb + S_DEC + o4), la = *(const LAS f32x4*)(sb + S_KKA + o4), kr = *(const LAS f32x4*)(stK + st4), r = *(const LAS f32x4*)(stR + st4); \
              f32x4 dec, a, kkr, kp; \
              _Pragma("unroll") for (int i = 0; i < 4; ++i) { \
                  const float nx = -(w0v[i] + lw[i]); const float sp = fmaxf(nx, 0.f) + __logf(1.0f + __expf(-fabsf(nx))); \
                  dec[i] = __expf(-__expf(-sp - 0.5f)); a[i] = sigmoidf_(a0v[i] + la[i]); kkr[i] = kr[i] * kkv[i]; kp[i] = kr[i] * (1.0f + (a[i] - 1.0f) * kav[i]); } \
              const float n2 = red16((kkr[0] * kkr[0] + kkr[1] * kkr[1]) + (kkr[2] * kkr[2] + kkr[3] * kkr[3])); \
              const float inv = __builtin_amdgcn_rsqf(fmaxf(n2, 1e-24f)); const f32x4 kk = kkr * inv, kka = kk * a; \
              const float c1 = red16((kka[0] * r[0] + kka[1] * r[1]) + (kka[2] * r[2] + kka[3] * r[3])); \
              const float c2 = red16((kp[0] * r[0] + kp[1] * r[1]) + (kp[2] * r[2] + kp[3] * r[3])); \
              const float c3 = red16((r[0] * kp[0] * rkv[0] + r[1] * kp[1] * rkv[1]) + (r[2] * kp[2] * rkv[2] + r[3] * kp[3] * rkv[3])); \
              *(LAS f32x4*)(sb + S_DEC + o4) = dec; *(LAS f32x4*)(sb + S_KK + o4) = kk; *(LAS f32x4*)(sb + S_KKA + o4) = kka; *(LAS f32x4*)(sb + S_KP + o4) = kp; *(LAS f32x4*)(sb + S_WR + o4) = dec * r; \
              if (jq == 0) { LAS float* sc = (LAS float*)(sb + S_SC) + tl * 4; sc[0] = c1; sc[1] = c2; sc[2] = c3; } } \
            LDS_FENCE(); } while (0)
#define RW2_POST(c_) do { \
            const LAS unsigned char* sb = L + ((c_) & 1) * SETB; const int o4 = (tl * 64 + 4 * jq) * 4; \
            const f32x4 y = *(const LAS f32x4*)(sb + S_YO + o4), vv = *(const LAS f32x4*)(sb + S_V + o4), gg = *(const LAS f32x4*)(sb + S_G + o4); \
            const float mean = red16((y[0] + y[1]) + (y[2] + y[3])) * (1.0f / 64.0f); const f32x4 dd = y - mean; \
            const float var = red16((dd[0] * dd[0] + dd[1] * dd[1]) + (dd[2] * dd[2] + dd[3] * dd[3])) * (1.0f / 64.0f); \
            const float rs = rsqrtf(var + 64e-5f), c3 = ((const LAS float*)(sb + S_SC))[tl * 4 + 2]; \
            const f32x4 ov = (dd * rs * gngv + gnbv + vv * c3) * gg; \
            u32x2 w_; w_.x = pk2(ov[0], ov[1]); w_.y = pk2(ov[2], ov[3]); \
            *(u32x2*)(Y + ((size_t)b * SEQ + 16 * (c_) + tl) * D + 512 + hc4) = w_; \
            LDS_FENCE(); } while (0)
        RW2_PREP(0);
        __syncthreads();
#pragma unroll 1
        for (int c = 0; c < NCH; ++c) {
            if (c >= 1) RW2_POST(c - 1);
            if (c + 1 < NCH) RW2_PREP(c + 1);
            __syncthreads();
        }
        RW2_POST(NCH - 1);
        __syncthreads();
#undef RW2_PREP
#undef RW2_POST
    }
}
}
namespace rw3 {
constexpr int V_ = 0, G_ = 8192, LWC = 16384, XK = 24576, XQ = 29184, YK = 33792, YR = 38400, QH = 43008, KH = 47616, VB = 52224, WCC = 56832, YO = 57344, SC3 = 65536, MU = 65792, RA = 67456;
constexpr int R_ = RA, K_ = RA + 8192, LIN = RA + 16384, LINP = 264, LW_ = RA + 33280, LA_ = RA + 41472;
constexpr int NF = RA, A1B = RA + 2048, B1T = RA + 3072, B2T = RA + 4096, TTT = RA + 5120, A1H = RA + 6144, KHT = RA + 8192, PT = RA + 18432, ZT = RA + 34816, RHT = RA + 38912, BHT = RA + 43008;
constexpr int CST = RA + 49664;
constexpr int XP = 144;
typedef short s16x4 __attribute__((ext_vector_type(4)));
typedef short v4i16_t __attribute__((ext_vector_type(4)));
__device__ __forceinline__ s16x4 vtr(const LAS unsigned char* p) { return __builtin_bit_cast(s16x4, __builtin_amdgcn_ds_read_tr16_b64_v4i16((LAS v4i16_t*)p)); }
template <int Q> __device__ __forceinline__ float quad_bcast(float v) { return __builtin_bit_cast(float, __builtin_amdgcn_update_dpp(0, __builtin_bit_cast(int, v), Q * 0x55, 0xF, 0xF, true)); }
__device__ __forceinline__ float ldbf(const LAS unsigned char* p) { return bf2f(*(const LAS unsigned short*)p); }
struct RegT { u32x2 rc, kc, vc, rp, kp, vp, w, a, g; };
__device__ __forceinline__ void loadT(RegT& R, const bf16* PB, const bf16* LO, int b, int h, int t0, int tid) {
    const int t = t0 + (tid >> 4), c = 64 * h + 4 * (tid & 15);
    const bf16* p = PB + ((size_t)b * SEQ + t) * IN0 + 1024 + c;
    R.rc = *(const u32x2*)p; R.kc = *(const u32x2*)(p + 512); R.vc = *(const u32x2*)(p + 1024);
    if (t > 0) { R.rp = *(const u32x2*)(p - IN0); R.kp = *(const u32x2*)(p - IN0 + 512); R.vp = *(const u32x2*)(p - IN0 + 1024); }
    else { R.rp = (u32x2){0u, 0u}; R.kp = (u32x2){0u, 0u}; R.vp = (u32x2){0u, 0u}; }
    const bf16* q = LO + ((size_t)b * SEQ + t) * 1536 + c;
    R.w = *(const u32x2*)q; R.a = *(const u32x2*)(q + 512); R.g = *(const u32x2*)(q + 1024);
}
__device__ __forceinline__ f32x4 unpk4(u32x2 v) { return (f32x4){bf2f(v.x & 0xffffu), bf2f(v.x >> 16), bf2f(v.y & 0xffffu), bf2f(v.y >> 16)}; }
__device__ __forceinline__ void item(const Frame& F, int b, int h) {
    LAS unsigned char* L = (LAS unsigned char*)F.lds;
    const bf16* PB = wsp<bf16>(F, WS_PB); bf16* Y = wsp<bf16>(F, WS_YB);
    int tid = F.tid; asm volatile("" : "+v"(tid));
    const int wave = F.wave;
    const int hc4 = 64 * h + 4 * (tid & 15);
    if (tid < 7 * 16) {
        const int which = tid >> 4, c4 = (tid & 15) * 4; const int src = which == 0 ? 8 : (which == 1 ? 10 : (which == 2 ? 13 : (which == 3 ? 14 : (which == 4 ? 15 : (which == 5 ? 16 : 17)))));
        *(LAS f32x4*)(L + CST + which * 256 + c4 * 4) = *(const f32x4*)(F.in[src] + 64 * h + c4);
    }
    if (tid < 48) { const int arr = tid >> 4, c4 = (tid & 15) * 4; *(LAS f32x4*)(L + MU + arr * 256 + c4 * 4) = *(const f32x4*)(F.in[7] + arr * 512 + 64 * h + c4); }
    f32x4 ST[4];
#pragma unroll
    for (int m = 0; m < 4; ++m) ST[m] = (f32x4){0.f, 0.f, 0.f, 0.f};
    const bf16* LO = (const bf16*)F.out;
    RegT Tn; loadT(Tn, PB, LO, b, h, 0, tid);
    unsigned idpk[4];
    { const int fr0 = tid & 15, fq0 = (tid & 63) >> 4;
#pragma unroll
      for (int p = 0; p < 4; ++p) { const bool lo_on = fq0 >= 2 && (8 * (fq0 - 2) + 2 * p == fr0), hi_on = fq0 >= 2 && (8 * (fq0 - 2) + 2 * p + 1 == fr0); idpk[p] = (lo_on ? 0x3F80u : 0u) | (hi_on ? 0x3F800000u : 0u); } }
    __syncthreads();
#pragma unroll 1
    for (int t0 = 0; t0 < SEQ; t0 += 32) {
        int tidl = tid; asm volatile("" : "+v"(tidl));
        const int lane = tidl & 63, fr = lane & 15, fq = lane >> 4;
        const int jq = lane & 15, tl = tidl >> 4;
        const int ch2 = tidl >> 8, x = tidl & 255;
        const RegT Tc = Tn;
        if (t0 + 32 < SEQ) loadT(Tn, PB, LO, b, h, t0 + 32, tid);
        const int o4 = (tl * 64 + 4 * jq) * 4, tloc = tl & 15, cb = tl & 16;
        f32x4 kap, qv, kp, rr, lw, vv;
        {
            const f32x4 w0v = *(const LAS f32x4*)(L + CST + 16 * jq), a0v = *(const LAS f32x4*)(L + CST + 256 + 16 * jq), kkv = *(const LAS f32x4*)(L + CST + 512 + 16 * jq), kav = *(const LAS f32x4*)(L + CST + 768 + 16 * jq), rkv = *(const LAS f32x4*)(L + CST + 1024 + 16 * jq);
            const f32x4 lwv = unpk4(Tc.w), la = unpk4(Tc.a);
            const f32x4 mr = *(const LAS f32x4*)(L + MU + 16 * jq), mk = *(const LAS f32x4*)(L + MU + 256 + 16 * jq), mv = *(const LAS f32x4*)(L + MU + 512 + 16 * jq);
            const f32x4 rcur = unpk4(Tc.rc), kcur = unpk4(Tc.kc), vcur = unpk4(Tc.vc);
            rr = rcur + (unpk4(Tc.rp) - rcur) * mr; const f32x4 kr = kcur + (unpk4(Tc.kp) - kcur) * mk; vv = vcur + (unpk4(Tc.vp) - vcur) * mv;
            f32x4 a, kkr;
#pragma unroll
            for (int i = 0; i < 4; ++i) {
                const float nx = -(w0v[i] + lwv[i]);
                lw[i] = -(0.6065306597126334f * 1.4426950408889634f) * rcpf_(1.0f + __expf(nx));
                a[i] = sigmoidf_(a0v[i] + la[i]);
                kkr[i] = kr[i] * kkv[i]; kp[i] = kr[i] * (1.0f + (a[i] - 1.0f) * kav[i]);
            }
            const float n2 = red16((kkr[0] * kkr[0] + kkr[1] * kkr[1]) + (kkr[2] * kkr[2] + kkr[3] * kkr[3]));
            kap = kkr * __builtin_amdgcn_rsqf(fmaxf(n2, 1e-24f)); qv = kap * a;
            const float c3 = red16((rr[0] * kp[0] * rkv[0] + rr[1] * kp[1] * rkv[1]) + (rr[2] * kp[2] * rkv[2] + rr[3] * kp[3] * rkv[3]));
            if (jq == 0) *(LAS float*)(L + SC3 + (t0 & 32) * 4 + tl * 4) = c3;
            *(LAS f32x4*)(L + LWC + o4) = lw;
        }
        __syncthreads();
        {
            f32x4 gs[4], own[4];
            const int G = wave & 3;
#pragma unroll
            for (int gq = 0; gq < 4; ++gq) {
                const f32x4 v0 = *(const LAS f32x4*)(L + LWC + ((cb + 4 * gq) * 64 + 4 * jq) * 4), v1 = *(const LAS f32x4*)(L + LWC + ((cb + 4 * gq + 1) * 64 + 4 * jq) * 4);
                const f32x4 v2 = *(const LAS f32x4*)(L + LWC + ((cb + 4 * gq + 2) * 64 + 4 * jq) * 4), v3 = *(const LAS f32x4*)(L + LWC + ((cb + 4 * gq + 3) * 64 + 4 * jq) * 4);
                gs[gq] = (v0 + v1) + (v2 + v3);
                if (gq == G) { own[0] = v0; own[1] = v0 + v1; own[2] = (v0 + v1) + v2; own[3] = gs[gq]; }
            }
            const f32x4 CL = (gs[0] + gs[1]) + (gs[2] + gs[3]);
            f32x4 cl = {0.f, 0.f, 0.f, 0.f};
            if (G > 0) cl += gs[0];
            if (G > 1) cl += gs[1];
            if (G > 2) cl += gs[2];
            { const int tq_ = tloc & 3; cl += tq_ == 0 ? own[0] : (tq_ == 1 ? own[1] : (tq_ == 2 ? own[2] : own[3])); }
            f32x4 cw, icw, cwm1, wcr;
#pragma unroll
            for (int i = 0; i < 4; ++i) { cw[i] = __builtin_amdgcn_exp2f(cl[i]); icw[i] = __builtin_amdgcn_exp2f(-cl[i]); cwm1[i] = __builtin_amdgcn_exp2f(cl[i] - lw[i]); wcr[i] = __builtin_amdgcn_exp2f(CL[i] - cl[i]); }
            const f32x4 kt = cwm1 * kap, qt = qv * icw, kkt = kp * icw, rt = cw * rr, qh = qv * wcr, kh = kp * wcr;
            const int ob = tl * XP + 8 * jq;
#define RW3_ST4(base, v) do { u32x2 w_; w_.x = pk2(v[0], v[1]); w_.y = pk2(v[2], v[3]); *(LAS u32x2*)(L + (base) + ob) = w_; } while (0)
            RW3_ST4(XK, kkt); RW3_ST4(XQ, qt); RW3_ST4(YK, kt); RW3_ST4(YR, rt); RW3_ST4(QH, qh); RW3_ST4(KH, kh); RW3_ST4(VB, vv);
#undef RW3_ST4
            if (tloc == 15) { f32x4 wc; for (int i = 0; i < 4; ++i) wc[i] = __builtin_amdgcn_exp2f(CL[i]); *(LAS f32x4*)(L + WCC + ((cb >> 4) * 64 + 4 * jq) * 4) = wc; }
        }
        __syncthreads();
        const int gc = wave >> 2, wq = wave & 3;
        {
            const int tile = (wq + gc) & 3;
            const LAS unsigned char* ar = L + (tile == 0 ? YK : ((tile & 1) ? XQ : XK)) + (16 * gc + fr) * XP + 16 * fq;
            const LAS unsigned char* br = L + (tile == 0 ? XK : ((tile >> 1) ? YR : YK)) + (16 * gc + fr) * XP + 16 * fq;
            f32x4 acc = {0.f, 0.f, 0.f, 0.f};
#pragma unroll
            for (int ks = 0; ks < 2; ++ks) acc = __builtin_amdgcn_mfma_f32_16x16x32_bf16(*(const LAS bf16x8*)(ar + 64 * ks), *(const LAS bf16x8*)(br + 64 * ks), acc, 0, 0, 0);
            if (tile == 0) {
#pragma unroll
                for (int r = 0; r < 4; ++r) if (!(fr < 4 * fq + r)) acc[r] = 0.f;
                u32x2 w_; w_.x = pk2(acc[0], acc[1]); w_.y = pk2(acc[2], acc[3]); *(LAS u32x2*)(L + A1B + gc * 512 + fr * 32 + 8 * fq) = w_;
            } else if (tile == 1) {
#pragma unroll
                for (int r = 0; r < 4; ++r) *(LAS float*)(L + NF + gc * 1024 + ((4 * fq + r) * 16 + fr) * 4) = (4 * fq + r < fr) ? acc[r] : 0.f;
            } else {
#pragma unroll
                for (int r = 0; r < 4; ++r) if (!(4 * fq + r <= fr)) acc[r] = 0.f;
                u32x2 w_; w_.x = pk2(acc[0], acc[1]); w_.y = pk2(acc[2], acc[3]); *(LAS u32x2*)(L + (tile == 2 ? B1T : B2T) + gc * 512 + fr * 32 + 8 * fq) = w_;
            }
        }
        LDS_FENCE();
        if (((wq + gc) & 3) == 1 && lane < 16) {
            const int x = lane; const int ch2 = gc;
            const LAS unsigned char* N = L + NF + ch2 * 1024;
            float Tc[16];
#pragma unroll
            for (int sI = 15; sI >= 0; --sI) {
                float acc0 = (sI == x) ? 1.f : 0.f, acc1 = 0.f;
#pragma unroll
                for (int u4 = 0; u4 < 4; ++u4) {
                    if (4 * u4 + 3 > sI) {
                        const f32x4 nv = *(const LAS f32x4*)(N + (sI * 16 + 4 * u4) * 4);
#pragma unroll
                        for (int i = 0; i < 4; ++i) { const int u = 4 * u4 + i; if (u > sI) { if (u & 1) acc1 -= nv[i] * Tc[u]; else acc0 -= nv[i] * Tc[u]; } }
                    }
                }
                Tc[sI] = acc0 + acc1;
            }
            u32x4 w0_, w1_;
#pragma unroll
            for (int i = 0; i < 4; ++i) { w0_[i] = pk2(Tc[2 * i], Tc[2 * i + 1]); w1_[i] = pk2(Tc[8 + 2 * i], Tc[8 + 2 * i + 1]); }
            *(LAS u32x4*)(L + TTT + ch2 * 512 + x * 32) = w0_; *(LAS u32x4*)(L + TTT + ch2 * 512 + x * 32 + 16) = w1_;
        }
        __syncthreads();
        const bf16x8 zero8 = (bf16x8){0, 0, 0, 0, 0, 0, 0, 0};
        const int trow = 8 * (fq & 1) + ((lane & 15) >> 2), tcol = 8 * (lane & 3);
        {
            bf16x8 tf = *(const LAS bf16x8*)(L + TTT + gc * 512 + fr * 32 + 16 * (fq & 1)); if (fq >= 2) tf = zero8;
            const LAS unsigned char* kb = L + YK + (16 * gc + trow) * XP + 32 * wq + tcol;
            const s16x4 lo = vtr(kb), hh = vtr(kb + 4 * XP);
            bf16x8 bv = (bf16x8){lo[0], lo[1], lo[2], lo[3], hh[0], hh[1], hh[2], hh[3]}; if (fq >= 2) bv = zero8;
            const f32x4 kh = __builtin_amdgcn_mfma_f32_16x16x32_bf16(tf, bv, (f32x4){0.f, 0.f, 0.f, 0.f}, 0, 0, 0);
            u32x2 w_; w_.x = pk2(kh[0], kh[1]); w_.y = pk2(kh[2], kh[3]); *(LAS u32x2*)(L + KHT + gc * 3072 + (16 * wq + fr) * 48 + 8 * fq) = w_;
            if (wq == 0) {
                bf16x8 a1 = *(const LAS bf16x8*)(L + A1B + gc * 512 + fr * 32 + 16 * (fq & 1)); if (fq >= 2) a1 = zero8;
                const f32x4 ah = __builtin_amdgcn_mfma_f32_16x16x32_bf16(tf, a1, (f32x4){0.f, 0.f, 0.f, 0.f}, 0, 0, 0);
                u32x2 v_; v_.x = pk2(-ah[0], -ah[1]); v_.y = pk2(-ah[2], -ah[3]); *(LAS u32x2*)(L + A1H + gc * 512 + fr * 32 + 8 * fq) = v_;
            }
        }
        __syncthreads();
        {
            const bf16x8 idp = __builtin_bit_cast(bf16x8, (u32x4){idpk[0], idpk[1], idpk[2], idpk[3]});
            const bf16x8 idn = __builtin_bit_cast(bf16x8, (u32x4){idpk[0] ^ 0x80008000u, idpk[1] ^ 0x80008000u, idpk[2] ^ 0x80008000u, idpk[3] ^ 0x80008000u});
            const bf16x8 kf = *(const LAS bf16x8*)(L + KHT + gc * 3072 + (16 * wq + fr) * 48 + 16 * (fq & 1));
            const bf16x8 b2 = *(const LAS bf16x8*)(L + B2T + gc * 512 + fr * 32 + 16 * (fq & 1));
            const bf16x8 a1h = *(const LAS bf16x8*)(L + A1H + gc * 512 + fr * 32 + 16 * (fq & 1));
            const bf16x8 bhop = *(const LAS bf16x8*)(L + (fq >= 2 ? B1T : B2T) + gc * 512 + fr * 32 + 16 * (fq & 1));
            const LAS unsigned char* qb = L + QH + (16 * gc + trow) * XP + tcol;
            s16x4 qlo[4], qhi[4];
#pragma unroll
            for (int nt = 0; nt < 4; ++nt) { qlo[nt] = vtr(qb + 32 * nt); qhi[nt] = vtr(qb + 32 * nt + 4 * XP); }
            const LAS unsigned char* rb = L + YR + (16 * gc + trow) * XP + 32 * wq + tcol;
            const s16x4 rlo = vtr(rb), rhi = vtr(rb + 4 * XP);
            const LAS unsigned char* zb = L + (fq >= 2 ? KH : QH) + (16 * gc + trow) * XP + 32 * wq + tcol;
            const s16x4 zlo = vtr(zb), zhi = vtr(zb + 4 * XP);
            float wcv[4];
#pragma unroll
            for (int nt = 0; nt < 4; ++nt) wcv[nt] = *(const LAS float*)(L + WCC + (gc * 64 + 16 * nt + fr) * 4);
            const bf16x8 kfn = __builtin_bit_cast(bf16x8, __builtin_bit_cast(u32x4, kf) ^ (u32x4){0x80008000u, 0x80008000u, 0x80008000u, 0x80008000u});
            const bf16x8 af = fq >= 2 ? zero8 : kfn;
            f32x4 pacc[4];
#pragma unroll
            for (int nt = 0; nt < 4; ++nt) {
                bf16x8 bv = (bf16x8){qlo[nt][0], qlo[nt][1], qlo[nt][2], qlo[nt][3], qhi[nt][0], qhi[nt][1], qhi[nt][2], qhi[nt][3]}; if (fq >= 2) bv = zero8;
                pacc[nt] = __builtin_amdgcn_mfma_f32_16x16x32_bf16(af, bv, (f32x4){0.f, 0.f, 0.f, 0.f}, 0, 0, 0);
            }
            const bf16x8 rfrag = (bf16x8){rlo[0], rlo[1], rlo[2], rlo[3], rhi[0], rhi[1], rhi[2], rhi[3]};
            const f32x4 racc = __builtin_amdgcn_mfma_f32_16x16x32_bf16(fq >= 2 ? rfrag : kfn, fq >= 2 ? idp : b2, (f32x4){0.f, 0.f, 0.f, 0.f}, 0, 0, 0);
            const bf16x8 zop = fq >= 2 ? idp : a1h;
            const bf16x8 zbv = (bf16x8){zlo[0], zlo[1], zlo[2], zlo[3], zhi[0], zhi[1], zhi[2], zhi[3]};
            const f32x4 zacc = __builtin_amdgcn_mfma_f32_16x16x32_bf16(zop, zbv, (f32x4){0.f, 0.f, 0.f, 0.f}, 0, 0, 0);
            f32x4 bacc = {0.f, 0.f, 0.f, 0.f};
            if (wq == 0) bacc = __builtin_amdgcn_mfma_f32_16x16x32_bf16(zop, bhop, (f32x4){0.f, 0.f, 0.f, 0.f}, 0, 0, 0);
#pragma unroll
            for (int nt = 0; nt < 4; ++nt) {
                float pv_[4];
#pragma unroll
                for (int r = 0; r < 4; ++r) pv_[r] = pacc[nt][r];
                if (wq == nt) {
#pragma unroll
                    for (int r = 0; r < 4; ++r) if (fr == 4 * fq + r) pv_[r] += wcv[nt]; }
                u32x2 w_; w_.x = pk2(pv_[0], pv_[1]); w_.y = pk2(pv_[2], pv_[3]);
                *(LAS u32x2*)(L + PT + gc * 8192 + ((nt * 2 + (wq >> 1)) * 16 + fr) * 64 + fq * 16 + (wq & 1) * 8) = w_;
            }
            { u32x2 w_; w_.x = pk2(racc[0], racc[1]); w_.y = pk2(racc[2], racc[3]); *(LAS u32x2*)(L + RHT + gc * 2048 + ((wq >> 1) * 16 + fr) * 64 + fq * 16 + (wq & 1) * 8) = w_; }
            { u32x2 w_; w_.x = pk2(zacc[0], zacc[1]); w_.y = pk2(zacc[2], zacc[3]); *(LAS u32x2*)(L + ZT + gc * 2048 + (16 * wq + fr) * 32 + 8 * fq) = w_; }
            if (wq == 0) { u32x2 w_; w_.x = pk2(bacc[0], bacc[1]); w_.y = pk2(bacc[2], bacc[3]); *(LAS u32x2*)(L + BHT + gc * 512 + fr * 32 + 8 * fq) = w_; }
        }
        __syncthreads();
        if (wave < 4) {
            bf16x8 pf[2][4][2], zf[2][4], rf[2][2], bfv[2], vb[2];
#pragma unroll
            for (int gcc = 0; gcc < 2; ++gcc) {
#pragma unroll
                for (int m = 0; m < 4; ++m) {
#pragma unroll
                    for (int ks = 0; ks < 2; ++ks) pf[gcc][m][ks] = *(const LAS bf16x8*)(L + PT + gcc * 8192 + ((m * 2 + ks) * 16 + fr) * 64 + fq * 16);
                    zf[gcc][m] = *(const LAS bf16x8*)(L + ZT + gcc * 2048 + (16 * m + fr) * 32 + 16 * (fq & 1)); if (fq >= 2) zf[gcc][m] = zero8;
                }
#pragma unroll
                for (int ks = 0; ks < 2; ++ks) rf[gcc][ks] = *(const LAS bf16x8*)(L + RHT + gcc * 2048 + (ks * 16 + fr) * 64 + fq * 16);
                bfv[gcc] = *(const LAS bf16x8*)(L + BHT + gcc * 512 + fr * 32 + 16 * (fq & 1)); if (fq >= 2) bfv[gcc] = zero8;
                const LAS unsigned char* vbp = L + VB + (16 * gcc + trow) * XP + 32 * wave + tcol;
                const s16x4 lo = vtr(vbp), hh = vtr(vbp + 4 * XP);
                vb[gcc] = (bf16x8){lo[0], lo[1], lo[2], lo[3], hh[0], hh[1], hh[2], hh[3]}; if (fq >= 2) vb[gcc] = zero8;
            }
            f32x4 zacc[2][4], yacc[2];
#pragma unroll
            for (int gcc = 0; gcc < 2; ++gcc) {
#pragma unroll
                for (int m = 0; m < 4; ++m) zacc[gcc][m] = __builtin_amdgcn_mfma_f32_16x16x32_bf16(zf[gcc][m], vb[gcc], (f32x4){0.f, 0.f, 0.f, 0.f}, 0, 0, 0);
                yacc[gcc] = __builtin_amdgcn_mfma_f32_16x16x32_bf16(bfv[gcc], vb[gcc], (f32x4){0.f, 0.f, 0.f, 0.f}, 0, 0, 0);
            }
#pragma unroll
            for (int gcc = 0; gcc < 2; ++gcc) {
                bf16x8 sb[2];
#pragma unroll
                for (int ks = 0; ks < 2; ++ks) { u32x4 w_; w_.x = pk2(ST[2 * ks][0], ST[2 * ks][1]); w_.y = pk2(ST[2 * ks][2], ST[2 * ks][3]); w_.z = pk2(ST[2 * ks + 1][0], ST[2 * ks + 1][1]); w_.w = pk2(ST[2 * ks + 1][2], ST[2 * ks + 1][3]); sb[ks] = __builtin_bit_cast(bf16x8, w_); }
#pragma unroll
                for (int m = 0; m < 4; ++m) {
                    f32x4 acc = __builtin_amdgcn_mfma_f32_16x16x32_bf16(pf[gcc][m][0], sb[0], zacc[gcc][m], 0, 0, 0);
                    ST[m] = __builtin_amdgcn_mfma_f32_16x16x32_bf16(pf[gcc][m][1], sb[1], acc, 0, 0, 0);
                }
                f32x4 ya = __builtin_amdgcn_mfma_f32_16x16x32_bf16(rf[gcc][0], sb[0], yacc[gcc], 0, 0, 0);
                ya = __builtin_amdgcn_mfma_f32_16x16x32_bf16(rf[gcc][1], sb[1], ya, 0, 0, 0);
#pragma unroll
                for (int r = 0; r < 4; ++r) *(LAS float*)(L + YO + ((16 * gcc + 4 * fq + r) * 64 + 16 * wave + fr) * 4) = ya[r];
            }
        }
        __syncthreads();
        {
            const f32x4 y = *(const LAS f32x4*)(L + YO + o4), gg = unpk4(Tc.g);
            const f32x4 gngv = *(const LAS f32x4*)(L + CST + 1280 + 16 * jq), gnbv = *(const LAS f32x4*)(L + CST + 1536 + 16 * jq);
            const float mean = red16((y[0] + y[1]) + (y[2] + y[3])) * (1.0f / 64.0f);
            const f32x4 dd = y - mean;
            const float var = red16((dd[0] * dd[0] + dd[1] * dd[1]) + (dd[2] * dd[2] + dd[3] * dd[3])) * (1.0f / 64.0f);
            const float rs = rsqrtf(var + 64e-5f), c3 = *(const LAS float*)(L + SC3 + (t0 & 32) * 4 + tl * 4);
            const f32x4 ov = (dd * rs * gngv + gnbv + vv * c3) * gg;
            u32x2 w; w.x = pk2(ov[0], ov[1]); w.y = pk2(ov[2], ov[3]);
            __hip_atomic_store((__attribute__((address_space(1))) unsigned long long*)(unsigned long long*)(Y + ((size_t)b * SEQ + t0 + tl) * D + 512 + hc4), __builtin_bit_cast(unsigned long long, w), __ATOMIC_RELAXED, __HIP_MEMORY_SCOPE_AGENT);
        }
        if (((t0 + 32) & 255) == 0) {
            asm volatile("s_waitcnt vmcnt(0)" ::: "memory");
            __syncthreads();
            if (tid == 0) __hip_atomic_fetch_add((unsigned*)(F.ws + WS_CTL) + CW_YRDY + b * 8 + (t0 >> 8), 1u, __ATOMIC_RELAXED, __HIP_MEMORY_SCOPE_AGENT);
        }
    }
    __syncthreads();
}
}
__device__ __forceinline__ void sgu_item(const Frame& F, int b, int c, int g) {
    float* VN = (float*)F.lds;
    const bf16* PB = wsp<bf16>(F, WS_PB); bf16* Y = wsp<bf16>(F, WS_YB);
    const float* ln_g = F.in[3]; const float* ln_b = F.in[4]; const float* w = F.in[5]; const float* bs = F.in[6];
    const int tid = F.tid, lane = F.lane, wave = F.wave; const size_t row0 = (size_t)b * SEQ + c * 128;
    for (int sI = wave; sI < 128; sI += NWAVES) {
        const bf16* pr = PB + (row0 + sI) * IN0 + 512 + 128 * g;
        const float v0 = bf2f(pr[lane]), v1 = bf2f(pr[lane + 64]);
        const float mean = wave_sum(v0 + v1) * (1.0f / 128.0f); const float d0 = v0 - mean, d1 = v1 - mean;
        const float var = wave_sum(d0 * d0 + d1 * d1) * (1.0f / 128.0f); const float rs = rsqrtf(var + 1e-5f);
        VN[sI * 132 + lane] = d0 * rs * ln_g[128 * g + lane] + ln_b[128 * g + lane];
        VN[sI * 132 + lane + 64] = d1 * rs * ln_g[128 * g + lane + 64] + ln_b[128 * g + lane + 64];
    }
    __syncthreads();
    const int t = tid >> 2, dq = tid & 3;
    f32x4 acc[8];
#pragma unroll
    for (int i = 0; i < 8; ++i) acc[i] = (f32x4){0.f, 0.f, 0.f, 0.f};
    const float* wrow = w + ((size_t)g * 128 + t) * 128;
    for (int sI = 0; sI <= t; ++sI) {
        const float ww = wrow[sI]; const f32x4* vr = (const f32x4*)&VN[sI * 132 + 32 * dq];
#pragma unroll
        for (int i = 0; i < 8; ++i) acc[i] += vr[i] * ww;
    }
    const float bias = bs[g * 128 + t];
    const bf16* ur = PB + (row0 + t) * IN0 + 128 * g + 32 * dq; bf16* yr = Y + (row0 + t) * D + 128 * g + 32 * dq;
#pragma unroll
    for (int i = 0; i < 8; ++i) {
        const u32x2 uu = *(const u32x2*)(ur + 4 * i);
        const float o0 = (acc[i][0] + bias) * bf2f(uu.x & 0xffffu), o1 = (acc[i][1] + bias) * bf2f(uu.x >> 16), o2 = (acc[i][2] + bias) * bf2f(uu.y & 0xffffu), o3 = (acc[i][3] + bias) * bf2f(uu.y >> 16);
        u32x2 wv; wv.x = pk2(o0, o1); wv.y = pk2(o2, o3); *(u32x2*)(yr + 4 * i) = wv;
    }
    __syncthreads();
}
__device__ __forceinline__ void p_lora(const Frame& F) {
    LAS unsigned char* L = (LAS unsigned char*)F.lds;
    constexpr int LINP = 264;
    const bf16* PB = wsp<bf16>(F, WS_PB); bf16* LO = (bf16*)F.out; const float* mu = F.in[7];
    int tid = F.tid; asm volatile("" : "+v"(tid));
    const int lane = tid & 63, wave = F.wave, fr = lane & 15, fq = lane >> 4;
    for (int it = F.blk; it < NTOK / 32; it += F.G) {
        const size_t tok0 = (size_t)it * 32; const int t0 = (int)(tok0 & (SEQ - 1));
#pragma unroll
        for (int i = 0; i < 2; ++i) {
            const int idx = tid + NTHR * i, tl = idx >> 5, lc = idx & 31, pc = 1536 + 8 * lc;
            const bf16* p = PB + (tok0 + tl) * IN0 + 1024 + pc;
            const u32x4 cur = *(const u32x4*)p; const u32x4 prev = (t0 + tl) > 0 ? *(const u32x4*)(p - IN0) : (u32x4){0u, 0u, 0u, 0u};
            const f32x4 m0 = *(const f32x4*)(mu + pc), m1 = *(const f32x4*)(mu + pc + 4);
            float xs[8];
#pragma unroll
            for (int j = 0; j < 4; ++j) {
                const float c0 = bf2f(cur[j] & 0xffffu), c1 = bf2f(cur[j] >> 16), p0 = bf2f(prev[j] & 0xffffu), p1 = bf2f(prev[j] >> 16);
                const float mA = j < 2 ? m0[2 * j] : m1[2 * j - 4], mB = j < 2 ? m0[2 * j + 1] : m1[2 * j - 3];
                xs[2 * j] = c0 + (p0 - c0) * mA; xs[2 * j + 1] = c1 + (p1 - c1) * mB;
            }
            if (lc < 8) {
#pragma unroll
                for (int j = 0; j < 8; ++j) xs[j] = 1.0f - 2.0f * rcpf_(1.0f + __expf(2.0f * xs[j]));
            } else if (lc >= 16) {
#pragma unroll
                for (int j = 0; j < 8; ++j) xs[j] = sigmoidf_(xs[j]);
            }
            u32x4 w; w.x = pk2(xs[0], xs[1]); w.y = pk2(xs[2], xs[3]); w.z = pk2(xs[4], xs[5]); w.w = pk2(xs[6], xs[7]);
            *(LAS u32x4*)(L + (tl * LINP + 8 * lc) * 2) = w;
        }
        __syncthreads();
#pragma unroll
        for (int lr = 0; lr < 3; ++lr) {
            const int KS = lr == 2 ? 4 : 2, wk = lr == 2 ? 128 : 64, lcol = lr == 0 ? 0 : (lr == 1 ? 64 : 128);
            const bf16* wt = wsp<bf16>(F, lr == 0 ? WT_W2 : (lr == 1 ? WT_A2 : WT_G2));
            bf16x8 af[4][4];
#pragma unroll
            for (int nt = 0; nt < 4; ++nt)
#pragma unroll
                for (int ks = 0; ks < 4; ++ks) if (ks < KS) af[nt][ks] = *(const bf16x8*)(wt + (size_t)(64 * wave + 16 * nt + fr) * wk + 32 * ks + 8 * fq);
#pragma unroll
            for (int nt = 0; nt < 4; ++nt) {
                const int n0 = 64 * wave + 16 * nt;
                f32x4 acc0 = {0.f, 0.f, 0.f, 0.f}, acc1 = {0.f, 0.f, 0.f, 0.f};
#pragma unroll
                for (int ks = 0; ks < 4; ++ks) if (ks < KS) {
                    acc0 = __builtin_amdgcn_mfma_f32_16x16x32_bf16(af[nt][ks], *(const LAS bf16x8*)(L + (fr * LINP + lcol + 32 * ks + 8 * fq) * 2), acc0, 0, 0, 0);
                    acc1 = __builtin_amdgcn_mfma_f32_16x16x32_bf16(af[nt][ks], *(const LAS bf16x8*)(L + ((16 + fr) * LINP + lcol + 32 * ks + 8 * fq) * 2), acc1, 0, 0, 0);
                }
                u32x2 w0, w1; w0.x = pk2(acc0[0], acc0[1]); w0.y = pk2(acc0[2], acc0[3]); w1.x = pk2(acc1[0], acc1[1]); w1.y = pk2(acc1[2], acc1[3]);
                *(u32x2*)(LO + (tok0 + fr) * 1536 + lr * 512 + n0 + 4 * fq) = w0;
                *(u32x2*)(LO + (tok0 + 16 + fr) * 1536 + lr * 512 + n0 + 4 * fq) = w1;
            }
        }
        __syncthreads();
    }
}
__device__ __forceinline__ void sgu_item_mfma(const Frame& F, int b, int c, int g) {
    LAS unsigned char* L = (LAS unsigned char*)F.lds;
    constexpr int VNT = 0, VP = 272, OUTB = 34816, OP = 132;
    const bf16* PB = wsp<bf16>(F, WS_PB); bf16* Y = wsp<bf16>(F, WS_YB);
    const float* ln_g = F.in[3]; const float* ln_b = F.in[4]; const float* bs = F.in[6];
    int tid = F.tid; asm volatile("" : "+v"(tid));
    const int lane = tid & 63, wave = F.wave, fr = lane & 15, fq = lane >> 4; const size_t row0 = (size_t)b * SEQ + c * 128;
    {
        const int sI = tid >> 2, dq = tid & 3;
        const bf16* pr = PB + (row0 + sI) * IN0 + 512 + 128 * g + 32 * dq;
        u32x4 raw[4];
#pragma unroll
        for (int i = 0; i < 4; ++i) raw[i] = *(const u32x4*)(pr + 8 * i);
        float v[32]; float sum = 0.f;
#pragma unroll
        for (int i = 0; i < 4; ++i)
#pragma unroll
            for (int j = 0; j < 4; ++j) { v[8 * i + 2 * j] = bf2f(raw[i][j] & 0xffffu); v[8 * i + 2 * j + 1] = bf2f(raw[i][j] >> 16); sum += v[8 * i + 2 * j] + v[8 * i + 2 * j + 1]; }
        sum += dpp_f<0xB1>(sum); sum += dpp_f<0x4E>(sum);
        const float mean = sum * (1.0f / 128.0f); float sq = 0.f;
#pragma unroll
        for (int i = 0; i < 32; ++i) { v[i] -= mean; sq += v[i] * v[i]; }
        sq += dpp_f<0xB1>(sq); sq += dpp_f<0x4E>(sq);
        const float rs = rsqrtf(sq * (1.0f / 128.0f) + 1e-5f);
        const float* lgp = ln_g + 128 * g + 32 * dq; const float* lbp = ln_b + 128 * g + 32 * dq;
#pragma unroll
        for (int i4 = 0; i4 < 8; ++i4) {
            const f32x4 gg = *(const f32x4*)(lgp + 4 * i4), bb = *(const f32x4*)(lbp + 4 * i4);
#pragma unroll
            for (int i = 0; i < 4; ++i) *(LAS unsigned short*)(L + VNT + (32 * dq + 4 * i4 + i) * VP + 2 * sI) = (unsigned short)f2bf(v[4 * i4 + i] * rs * gg[i] + bb[i]);
        }
    }
    __syncthreads();
    {
        const bf16* wm = wsp<bf16>(F, WT_SGU) + ((size_t)g * 128 + 16 * wave + fr) * 128 + 8 * fq;
        f32x4 acc[8];
#pragma unroll
        for (int n = 0; n < 8; ++n) acc[n] = (f32x4){0.f, 0.f, 0.f, 0.f};
        const int nks = (wave >> 1) + 1;
        for (int ks = 0; ks < nks; ++ks) {
            const bf16x8 af = *(const bf16x8*)(wm + 32 * ks);
#pragma unroll
            for (int n = 0; n < 8; ++n) acc[n] = __builtin_amdgcn_mfma_f32_16x16x32_bf16(af, *(const LAS bf16x8*)(L + VNT + (16 * n + fr) * VP + (32 * ks + 8 * fq) * 2), acc[n], 0, 0, 0);
        }
#pragma unroll
        for (int n = 0; n < 8; ++n)
#pragma unroll
            for (int r = 0; r < 4; ++r) *(LAS float*)(L + OUTB + ((16 * wave + 4 * fq + r) * OP + 16 * n + fr) * 4) = acc[n][r];
    }
    __syncthreads();
    {
        const int t = tid >> 2, dq = tid & 3; const float bias = bs[g * 128 + t];
        const bf16* ur = PB + (row0 + t) * IN0 + 128 * g + 32 * dq; bf16* yr = Y + (row0 + t) * D + 128 * g + 32 * dq;
#pragma unroll
        for (int i = 0; i < 4; ++i) {
            const u32x4 uu = *(const u32x4*)(ur + 8 * i);
            const f32x4 a0 = *(const LAS f32x4*)(L + OUTB + (t * OP + 32 * dq + 8 * i) * 4), a1 = *(const LAS f32x4*)(L + OUTB + (t * OP + 32 * dq + 8 * i + 4) * 4);
            u32x4 wv;
            wv.x = pk2((a0[0] + bias) * bf2f(uu.x & 0xffffu), (a0[1] + bias) * bf2f(uu.x >> 16)); wv.y = pk2((a0[2] + bias) * bf2f(uu.y & 0xffffu), (a0[3] + bias) * bf2f(uu.y >> 16));
            wv.z = pk2((a1[0] + bias) * bf2f(uu.z & 0xffffu), (a1[1] + bias) * bf2f(uu.z >> 16)); wv.w = pk2((a1[2] + bias) * bf2f(uu.w & 0xffffu), (a1[3] + bias) * bf2f(uu.w >> 16));
            { typedef __attribute__((address_space(1))) unsigned long long gu64_t; gu64_t* yp = (gu64_t*)(unsigned long long*)(yr + 8 * i);
              __hip_atomic_store(yp, (unsigned long long)wv.x | ((unsigned long long)wv.y << 32), __ATOMIC_RELAXED, __HIP_MEMORY_SCOPE_AGENT);
              __hip_atomic_store(yp + 1, (unsigned long long)wv.z | ((unsigned long long)wv.w << 32), __ATOMIC_RELAXED, __HIP_MEMORY_SCOPE_AGENT); }
        }
    }
    asm volatile("s_waitcnt vmcnt(0)" ::: "memory");
    __syncthreads();
    if (tid == 0) __hip_atomic_fetch_add((unsigned*)(F.ws + WS_CTL) + CW_YRDY + b * 8 + (c >> 1), 1u, __ATOMIC_RELAXED, __HIP_MEMORY_SCOPE_AGENT);
}
__device__ __forceinline__ void p_mix0(const Frame& F) {
    if (F.G >= 256) {
#ifdef RW2_SCAN
        if (F.blk < 128) rw2::item(F, F.blk >> 3, F.blk & 7);
#else
        if (F.blk < 128) rw3::item(F, F.blk >> 3, F.blk & 7);
#endif
        else {
            const int nb = F.G - 128, c = F.blk - 128;
            for (int s = c; s < 1024; s += nb) sgu_item_mfma(F, s >> 6, (s >> 2) & 15, s & 3);
        }
        tr_queue(F, I_IN0 + I_SQ, TR_LORA0);
    } else {
        for (int it = F.blk; it < 128 + 1024; it += F.G) {
            if (it < 128) rwkv_item(F, it >> 3, it & 7);
            else { const int s = it - 128; sgu_item(F, s >> 6, (s >> 2) & 15, s & 3); }
        }
        tr_range(F, I_IN0, TR_LORA0, F.blk * NWAVES + F.wave, F.G * NWAVES);
    }
}

__device__ __forceinline__ void p_nsa_prep(const Frame& F) {
    bf16* PB = wsp<bf16>(F, WS_PB); bf16* QR = wsp<bf16>(F, WS_QROT); bf16* Y = wsp<bf16>(F, WS_YB); const float* rope = wsp<float>(F, M_ROPE);
    const bool split = F.G >= 64;
    const int ncmp = split ? 32 : 0;
    const int gt = (F.blk - ncmp) * NTHR + F.tid, NGT = (F.G - ncmp) * NTHR;
    if (!split || F.blk >= 32) {
    auto rot_piece = [&](u32x4 mine, int p, int t) -> u32x4 {
        u32x4 oth;
#pragma unroll
        for (int i = 0; i < 4; ++i) oth[i] = (unsigned)__builtin_amdgcn_update_dpp(0, (int)mine[i], 0xB1, 0xF, 0xF, true);
        const f32x4* cs = (const f32x4*)(rope + t * 16); const f32x4 c0 = cs[0], c1 = cs[1], s0 = cs[2], s1 = cs[3];
        u32x4 o;
#pragma unroll
        for (int i = 0; i < 4; ++i) {
            const float ma = bf2f(mine[i] & 0xffffu), mb = bf2f(mine[i] >> 16), oa = bf2f(oth[i] & 0xffffu), ob = bf2f(oth[i] >> 16);
            const float ca = i < 2 ? c0[2 * i] : c1[2 * i - 4], cb = i < 2 ? c0[2 * i + 1] : c1[2 * i - 3], sa = i < 2 ? s0[2 * i] : s1[2 * i - 4], sb = i < 2 ? s0[2 * i + 1] : s1[2 * i - 3];
            const float ra = p == 0 ? ma * ca - oa * sa : oa * sa + ma * ca, rb = p == 0 ? mb * cb - ob * sb : ob * sb + mb * cb;
            o[i] = pk2(ra, rb);
        }
        return o;
    };
    for (int idx = gt; idx < NTOK * 64; idx += 4 * NGT) {
        u32x4 v[4];
#pragma unroll
        for (int k = 0; k < 4; ++k) { const int id = idx + k * NGT < NTOK * 64 ? idx + k * NGT : idx; v[k] = *(const u32x4*)(PB + (size_t)(id >> 6) * IN1P + C_Q + 8 * (id & 63)); }
#pragma unroll
        for (int k = 0; k < 4; ++k) {
            const int idk = idx + k * NGT; const bool ok = idk < NTOK * 64; const int id = ok ? idk : idx; const int row = id >> 6, p = id & 7;
            u32x4 o = v[k];
            const u32x4 r = rot_piece(v[k], p & 1, row & (SEQ - 1));
            if (p < 2) o = r;
            if (ok) *(u32x4*)(QR + (size_t)row * 512 + 8 * (id & 63)) = o;
        }
    }
    for (int idx = gt; idx < NTOK * 8; idx += NGT) {
        const int row = idx >> 3, j4 = (idx >> 1) & 3, p = idx & 1;
        bf16* ptr = PB + (size_t)row * IN1P + (j4 < 2 ? C_KS + 64 * j4 : C_KW + 64 * (j4 - 2)) + 8 * p;
        const u32x4 mine = *(const u32x4*)ptr;
        *(u32x4*)ptr = rot_piece(mine, p, row & (SEQ - 1));
    }
    const float* cw = F.in[31];
    for (int idx = gt; idx < NTOK * 64; idx += 2 * NGT) {
        u32x4 cgv[2][3], hdv[2][3], bgv[2]; int rowv[2], c0v[2]; bool okv[2];
#pragma unroll
        for (int k = 0; k < 2; ++k) {
            const int idk = idx + k * NGT; okv[k] = idk < NTOK * 64; const int id = okv[k] ? idk : idx;
            const int row = id >> 6, c0 = (id & 63) * 8, t = row & (SEQ - 1); rowv[k] = row; c0v[k] = c0;
#pragma unroll
            for (int wq = 0; wq < 3; ++wq) {
                const int tt = t - 2 + wq;
                if (tt >= 0) { const size_t ro = (size_t)(row - 2 + wq) * IN1P; cgv[k][wq] = *(const u32x4*)(PB + ro + C_CG + c0); hdv[k][wq] = *(const u32x4*)(PB + ro + C_HD + c0); }
                else { cgv[k][wq] = (u32x4){0u, 0u, 0u, 0u}; hdv[k][wq] = (u32x4){0u, 0u, 0u, 0u}; }
            }
            bgv[k] = *(const u32x4*)(PB + (size_t)row * IN1P + C_BG + c0);
        }
#pragma unroll
        for (int k = 0; k < 2; ++k) {
            const int c0 = c0v[k];
            float y[8];
#pragma unroll
            for (int i = 0; i < 8; ++i) y[i] = 0.f;
#pragma unroll
            for (int wq = 0; wq < 3; ++wq) {
                const u32x4 cg = cgv[k][wq], hd = hdv[k][wq];
                const f32x4 w0 = *(const f32x4*)(cw + wq * 512 + c0), w1 = *(const f32x4*)(cw + wq * 512 + c0 + 4);
#pragma unroll
                for (int i = 0; i < 4; ++i) {
                    const float z0 = bf2f(cg[i] & 0xffffu) * bf2f(hd[i] & 0xffffu), z1 = bf2f(cg[i] >> 16) * bf2f(hd[i] >> 16);
                    y[2 * i] += z0 * (i < 2 ? w0[2 * i] : w1[2 * i - 4]); y[2 * i + 1] += z1 * (i < 2 ? w0[2 * i + 1] : w1[2 * i - 3]);
                }
            }
            const u32x4 bg = bgv[k];
            u32x4 o;
#pragma unroll
            for (int i = 0; i < 4; ++i) o[i] = pk2(y[2 * i] * bf2f(bg[i] & 0xffffu), y[2 * i + 1] * bf2f(bg[i] >> 16));
            if (okv[k]) *(u32x4*)(Y + (size_t)rowv[k] * D + 512 + c0) = o;
        }
    }
    }
    if (!split || F.blk < 32) {
        Gemm g; g.A = (const bf16*)(F.ws + WS_KVQ); g.Bt = wsp<bf16>(F, WT_CK1); g.K = 1024; g.a_row = 16 * 64; g.a_half = (NTOK + 64) * 64; g.a_k = 128; g.b_row = 2048; g.b_half = 128 * 2048; g.b_k = 128;
        CmpOrder S; S.G = split ? 32 : F.G; S.c = F.blk;
        EpiCmp1T<true> E{wsp<bf16>(F, M_HID), wsp<float>(F, M_C1), 1.0f / (I8_KVS * I8_C1S)};
        pg8::gemm_phase<EpiCmp1T<true>, CmpOrder, true, false, true, true>(F.wave, (LAS unsigned char*)F.lds, g, S, E);
        asm volatile("s_waitcnt vmcnt(0)" ::: "memory");
        __threadfence_block();
        __syncthreads();
        Unit u;
        for (int i = 0; S.next(i, u); ++i) {
            const int which = u.pm >> 4, wid = F.wave, fr = F.lane & 15, fq = F.lane >> 4;
            const bf16* hid = wsp<bf16>(F, M_HID) + ((size_t)u.pm * 256 + 32 * wid) * 256;
            const bf16* w2 = wsp<bf16>(F, which ? WT_CV2 : WT_CK2);
            bf16* out = wsp<bf16>(F, which ? M_VCMP : M_KCMP) + ((size_t)(u.pm & 15) * 256 + 32 * wid) * 64;
            f32x4 acc[2][4];
#pragma unroll
            for (int m = 0; m < 2; ++m)
#pragma unroll
                for (int n = 0; n < 4; ++n) acc[m][n] = (f32x4){0.f, 0.f, 0.f, 0.f};
#pragma unroll 2
            for (int ks = 0; ks < 8; ++ks) {
                bf16x8 af[2], bfr[4];
#pragma unroll
                for (int m = 0; m < 2; ++m) af[m] = *(const bf16x8*)(hid + (size_t)(16 * m + fr) * 256 + 32 * ks + 8 * fq);
#pragma unroll
                for (int n = 0; n < 4; ++n) bfr[n] = *(const bf16x8*)(w2 + (size_t)(16 * n + fr) * 256 + 32 * ks + 8 * fq);
#pragma unroll
                for (int m = 0; m < 2; ++m)
#pragma unroll
                    for (int n = 0; n < 4; ++n) acc[m][n] = __builtin_amdgcn_mfma_f32_16x16x32_bf16(af[m], bfr[n], acc[m][n], 0, 0, 0);
            }
#pragma unroll
            for (int m = 0; m < 2; ++m)
#pragma unroll
                for (int n = 0; n < 4; ++n)
#pragma unroll
                    for (int r = 0; r < 4; ++r) out[(size_t)(16 * m + 4 * fq + r) * 64 + 16 * n + fr] = (bf16)(((32 * wid + 16 * m + 4 * fq + r) & 127) == 127 ? 0u : f2bf(acc[m][n][r]));
        }
    }
}
__device__ __forceinline__ void p_cmp2(const Frame& F) {
    const bf16* HID = wsp<bf16>(F, M_HID); const int gt = F.blk * NTHR + F.tid, NGT = F.G * NTHR;
    for (int idx = gt; idx < 2 * 4096 * 64; idx += NGT) {
        const int which = idx >> 18, r = (idx >> 6) & 4095, d = idx & 63;
        const bf16* hr = HID + ((size_t)which * 4096 + r) * 256; const bf16* w = wsp<bf16>(F, which ? WT_CV2 : WT_CK2) + d * 256;
        float s = 0.f;
        for (int k = 0; k < 256; k += 8) {
            const u32x4 a = *(const u32x4*)(hr + k), bq = *(const u32x4*)(w + k);
#pragma unroll
            for (int i = 0; i < 4; ++i) s += bf2f(a[i] & 0xffffu) * bf2f(bq[i] & 0xffffu) + bf2f(a[i] >> 16) * bf2f(bq[i] >> 16);
        }
        wsp<bf16>(F, which ? M_VCMP : M_KCMP)[(size_t)r * 64 + d] = (bf16)f2bf(s);
    }
}
constexpr float NEGBIG = -1e30f;
__device__ __forceinline__ void score64(const bf16* krow, const float* q4, float* scdst, bool valid) {
    float dot[4] = {0.f, 0.f, 0.f, 0.f};
#pragma unroll 1
    for (int hf = 0; hf < 4; ++hf) {
        float kf[16];
#pragma unroll
        for (int i = 0; i < 2; ++i) { const u32x4 a = *(const u32x4*)(krow + 16 * hf + 8 * i);
#pragma unroll
            for (int j = 0; j < 4; ++j) { kf[8 * i + 2 * j] = bf2f(a[j] & 0xffffu); kf[8 * i + 2 * j + 1] = bf2f(a[j] >> 16); } }
#pragma unroll
        for (int g = 0; g < 4; ++g) {
#pragma unroll
            for (int d4 = 0; d4 < 4; ++d4) { const f32x4 qv = *(const f32x4*)&q4[g * 64 + 16 * hf + 4 * d4]; dot[g] += kf[4 * d4] * qv.x + kf[4 * d4 + 1] * qv.y + kf[4 * d4 + 2] * qv.z + kf[4 * d4 + 3] * qv.w; }
        }
    }
#pragma unroll
    for (int g = 0; g < 4; ++g) scdst[g * 512] = valid ? dot[g] * 0.125f : NEGBIG;
}
__device__ __forceinline__ void softmax_rows(float* sc, int nblk, int lane) {
#pragma unroll
    for (int g = 0; g < 4; ++g) {
        float m = NEGBIG;
        for (int r = 0; r < nblk; ++r) m = fmaxf(m, sc[g * 512 + 64 * r + lane]);
        m = wave_max(m);
        float sum = 0.f;
        for (int r = 0; r < nblk; ++r) { const float sv = sc[g * 512 + 64 * r + lane]; const float e = sv > -1e29f ? __expf(sv - m) : 0.f; sc[g * 512 + 64 * r + lane] = e; sum += e; }
        sum = wave_sum(sum);
        const float inv = 1.0f / fmaxf(sum, 1e-30f);
        for (int r = 0; r < nblk; ++r) sc[g * 512 + 64 * r + lane] *= inv;
    }
}
__device__ __forceinline__ void p_attn_naive(const Frame& F) {
    float* wl = (float*)F.lds + F.wave * 2688;
    float* qn = wl, *qr = wl + 256, *sc = wl + 512;
    const bf16* PB = wsp<bf16>(F, WS_PB); const bf16* QR = wsp<bf16>(F, WS_QROT); bf16* Y = wsp<bf16>(F, WS_YB);
    const bf16* KC = wsp<bf16>(F, M_KCMP); const bf16* VC = wsp<bf16>(F, M_VCMP);
    const int lane = F.lane; const int gw = F.blk * NWAVES + F.wave, NGW = F.G * NWAVES;
    for (int item = gw; item < NTOK * 2; item += NGW) {
        const int bh = item >> 11, t = item & (SEQ - 1), b = bh >> 1, hkv = bh & 1; const size_t row = (size_t)b * SEQ + t;
        LDS_FENCE();
#pragma unroll
        for (int g = 0; g < 4; ++g) { qn[g * 64 + lane] = bf2f(PB[row * IN1P + C_Q + (hkv * 4 + g) * 64 + lane]); qr[g * 64 + lane] = bf2f(QR[row * 512 + (hkv * 4 + g) * 64 + lane]); }
        LDS_FENCE();
        float oc[4], os[4], ow[4];
        const int nv = t >= 31 ? ((t - 31) >> 4) + 1 : 0;
#pragma unroll
        for (int r = 0; r < 2; ++r) { const int n = lane + 64 * r; score64(KC + ((size_t)bh * 128 + n) * 64, qn, sc + n, n < nv); }
        LDS_FENCE();
        softmax_rows(sc, 2, lane);
        LDS_FENCE();
#pragma unroll
        for (int g = 0; g < 4; ++g) oc[g] = 0.f;
        for (int n = 0; n < nv; ++n) { const float v = bf2f(VC[((size_t)bh * 128 + n) * 64 + lane]);
#pragma unroll
            for (int g = 0; g < 4; ++g) oc[g] += sc[g * 512 + n] * v; }
        const int cur = t >> 6;
        float val = -3e38f;
        if (lane < 32) {
            float imp = 0.f;
#pragma unroll
            for (int dn = -1; dn <= 3; ++dn) { const int n = 4 * lane + dn; if (n >= 0 && n <= 126) imp += (sc[n] + sc[512 + n]) + (sc[1024 + n] + sc[1536 + n]); }
            const bool forced = lane == 0 || lane == cur || lane == cur - 1;
            val = (lane * 64 <= t) ? imp + (forced ? 1e6f : 0.f) : NEGBIG;
        }
        unsigned selmask = 0u;
        for (int it = 0; it < 8; ++it) {
            float best = val; int bj = lane;
#pragma unroll
            for (int o = 32; o >= 1; o >>= 1) { const float ov = __shfl_xor(best, o); const int oj = __shfl_xor(bj, o); if (ov > best || (ov == best && oj < bj)) { best = ov; bj = oj; } }
            if (best > -1e29f) selmask |= 1u << bj;
            if (lane == bj) val = -3e38f;
        }
        LDS_FENCE();
        int nsl = 0;
        for (unsigned mm = selmask; mm; mm &= mm - 1) { const int j = __ffs(mm) - 1; const int key = j * 64 + lane;
            score64(PB + ((size_t)b * SEQ + key) * IN1P + C_KS + hkv * 64, qr, sc + nsl * 64 + lane, key <= t); ++nsl; }
        LDS_FENCE();
        softmax_rows(sc, nsl, lane);
        LDS_FENCE();
#pragma unroll
        for (int g = 0; g < 4; ++g) os[g] = 0.f;
        { int sl = 0;
          for (unsigned mm = selmask; mm; mm &= mm - 1) { const int j = __ffs(mm) - 1;
              for (int kk = 0; kk < 64; ++kk) { const int key = j * 64 + kk; if (key > t) break;
                  const float v = bf2f(PB[((size_t)b * SEQ + key) * IN1P + C_VS + hkv * 64 + lane]);
#pragma unroll
                  for (int g = 0; g < 4; ++g) os[g] += sc[g * 512 + sl * 64 + kk] * v; }
              ++sl; } }
        LDS_FENCE();
#pragma unroll 1
        for (int kb = 0; kb < 8; ++kb) { const int key = t - 511 + 64 * kb + lane; const int keyc = key < 0 ? 0 : key;
            score64(PB + ((size_t)b * SEQ + keyc) * IN1P + C_KW + hkv * 64, qr, sc + kb * 64 + lane, key >= 0); }
        LDS_FENCE();
        softmax_rows(sc, 8, lane);
        LDS_FENCE();
#pragma unroll
        for (int g = 0; g < 4; ++g) ow[g] = 0.f;
        for (int p = (t >= 511 ? 0 : 511 - t); p < 512; ++p) { const int key = t - 511 + p;
            const float v = bf2f(PB[((size_t)b * SEQ + key) * IN1P + C_VW + hkv * 64 + lane]);
#pragma unroll
            for (int g = 0; g < 4; ++g) ow[g] += sc[g * 512 + p] * v; }
#pragma unroll
        for (int g = 0; g < 4; ++g) {
            const bf16* gl = PB + row * IN1P + C_GL + (hkv * 4 + g) * 3;
            const float o = sigmoidf_(bf2f(gl[0])) * oc[g] + sigmoidf_(bf2f(gl[1])) * os[g] + sigmoidf_(bf2f(gl[2])) * ow[g];
            Y[row * D + (hkv * 4 + g) * 64 + lane] = (bf16)f2bf(o);
        }
    }
}

namespace nsa {
typedef float f32x16 __attribute__((ext_vector_type(16)));
typedef short s16x4 __attribute__((ext_vector_type(4)));
typedef short v4i16_t __attribute__((ext_vector_type(4)));
typedef __bf16 bf16x2_t __attribute__((ext_vector_type(2)));
typedef LAS const char* lds_cptr;
constexpr int L_KV = 0, L_OV = 32768, L_IMP = 40960, L_WSF = 73728, L_SEL = 77824;
constexpr float C2 = 0.125f * 1.4426950408889634f, NEG = -1e30f;
__device__ __forceinline__ int crow(int r, int hi) { return (r & 3) + 8 * (r >> 2) + 4 * hi; }
__device__ __forceinline__ float max3f(float a_, float b_, float c_) { float r_; asm("v_max3_f32 %0, %1, %2, %3" : "=v"(r_) : "v"(a_), "v"(b_), "v"(c_)); return r_; }
__device__ __forceinline__ unsigned cvtpk(float lo, float hi) { f32x2 v = {lo, hi}; bf16x2_t b = __builtin_convertvector(v, bf16x2_t); return __builtin_bit_cast(unsigned, b); }
__device__ __forceinline__ s16x4 vtr(lds_cptr p) { return __builtin_bit_cast(s16x4, __builtin_amdgcn_ds_read_tr16_b64_v4i16((LAS v4i16_t*)p)); }
__device__ __forceinline__ void qkt(f32x16& p0, f32x16& p1, lds_cptr Kslot, const bf16x8* q, int r32, int hi) {
    lds_cptr kb = Kslot + hi * 1024 + r32 * 16;
    p0 = f32x16{}; p1 = f32x16{};
#pragma unroll
    for (int d0 = 0; d0 < 4; ++d0) {
        const bf16x8 b0 = *(const LAS bf16x8*)(kb + d0 * 2048), b1 = *(const LAS bf16x8*)(kb + d0 * 2048 + 512);
        p0 = __builtin_amdgcn_mfma_f32_32x32x16_bf16(b0, q[d0], p0, 0, 0, 0);
        p1 = __builtin_amdgcn_mfma_f32_32x32x16_bf16(b1, q[d0], p1, 0, 0, 0);
    }
}
__device__ __forceinline__ void pv32(f32x16& o, lds_cptr vp, const bf16x8* pa) {
#pragma unroll
    for (int ks = 0; ks < 4; ++ks) {
        const s16x4 lo = vtr(vp + ks * 1024), hh = vtr(vp + ks * 1024 + 512);
        const bf16x8 bv = (bf16x8){lo[0], lo[1], lo[2], lo[3], hh[0], hh[1], hh[2], hh[3]};
        o = __builtin_amdgcn_mfma_f32_32x32x16_bf16(pa[ks], bv, o, 0, 0, 0);
    }
}

struct Item { int b, hkv, bh, qb; };

template <int KIND>
__device__ __forceinline__ void branch(const Frame& F, const Item& it, LAS char* L, const bf16x8* q, const bf16* kbase, const bf16* vbase, int pitch, int blk0, int nsteps,
                                       float gate, unsigned selm, unsigned (&otp)[16]) {
    int tid = F.tid; asm volatile("" : "+v"(tid));
    const int lane = tid & 63, wid = F.wave, g = wid >> 1, qh = wid & 1;
    int r32 = lane & 31, hi = lane >> 5; asm volatile("" : "+v"(r32), "+v"(hi));
    const int ql = 32 * qh + r32, tq = it.qb * 64 + ql;
    LAS float* wsf = (LAS float*)(L + L_WSF) + wid * 128;
    float m2 = -1e20f, l = 0.f; f32x16 o0 = f32x16{}, o1 = f32x16{}, oe = f32x16{};
    const int nv = KIND == 0 ? (tq >= 31 ? ((tq - 31) >> 4) + 1 : 0) : 0;
    const size_t koff = (size_t)(tid & 63) * pitch + (tid >> 6) * 8, voff = (size_t)(16 * (wid & 3) + (lane >> 2)) * pitch + (wid >> 2) * 32 + (lane & 3) * 8;
    const int vlane = ((lane >> 4) & 1) * 32 + (lane & 3) * 8 + (4 * hi + ((lane & 15) >> 2)) * 64;
#define NSA_LOAD(KR, VR, blk_) do { KR = *(const u32x4*)(kbase + (size_t)(blk_) * 64 * pitch + koff); VR = *(const u32x4*)(vbase + (size_t)(blk_) * 64 * pitch + voff); } while (0)
#define NSA_STEP(KR, VR, s_) do { \
        const int blk = blk0 + (s_); LAS char* buf = L + L_KV + ((s_) & 1) * 16384; \
        *(LAS u32x4*)(buf + (tid >> 6) * 1024 + (tid & 63) * 16) = KR; *(LAS u32x4*)(buf + 8192 + wid * 1024 + lane * 16) = VR; \
        __syncthreads(); \
        if ((s_) + 1 < nsteps) NSA_LOAD(KR, VR, blk + 1); \
        const bool mine = KIND == 1 ? ((selm >> blk) & 1u) != 0u : true; \
        if (KIND != 1 || __any(mine)) { \
        f32x16 p0, p1; qkt(p0, p1, (lds_cptr)buf, q, r32, hi); \
        if (KIND == 0) { \
            const int kb0 = blk * 64 + 4 * hi; \
            _Pragma("unroll") for (int r = 0; r < 16; ++r) { const int key = kb0 + (r & 3) + 8 * (r >> 2); if (key >= nv) p0[r] = NEG; if (key + 32 >= nv) p1[r] = NEG; } \
        } else { \
            if (blk == it.qb) { _Pragma("unroll") for (int r = 0; r < 16; ++r) { const int kl = 4 * hi + (r & 3) + 8 * (r >> 2); if (kl > ql) p0[r] = NEG; if (kl + 32 > ql) p1[r] = NEG; } } \
            if (KIND == 2 && blk + 8 == it.qb) { _Pragma("unroll") for (int r = 0; r < 16; ++r) { const int kl = 4 * hi + (r & 3) + 8 * (r >> 2); if (kl <= ql) p0[r] = NEG; if (kl + 32 <= ql) p1[r] = NEG; } } \
        } \
        float rm = max3f(p0[0], p1[0], p0[1]); \
        _Pragma("unroll") for (int r = 1; r < 15; ++r) rm = max3f(rm, p1[r], p0[r + 1]); \
        rm = fmaxf(rm, p1[15]); \
        if (KIND == 1) rm = mine ? rm : NEG; \
        { auto rr_ = __builtin_amdgcn_permlane32_swap(__float_as_uint(rm), __float_as_uint(rm), false, false); rm = fmaxf(__uint_as_float(rr_[0]), __uint_as_float(rr_[1])); } \
        const float rm2 = rm * C2; \
        if (__any(rm2 > m2 + 8.0f)) { \
            const float mn = fmaxf(m2, rm2); const float alpha = __builtin_amdgcn_exp2f(m2 - mn); l *= alpha; m2 = mn; \
            LDS_FENCE(); \
            if (hi == 0) wsf[r32] = alpha; \
            LDS_FENCE(); \
            _Pragma("unroll") for (int r = 0; r < 16; ++r) { const float a_ = wsf[crow(r, hi)]; o0[r] *= a_; o1[r] *= a_; if (KIND == 0) oe[r] *= a_; } \
            LDS_FENCE(); \
        } \
        const float meff = (KIND == 1 && !mine) ? 1e30f : m2; \
        f32x2 sum2 = {0.f, 0.f}; \
        _Pragma("unroll") for (int r = 0; r < 16; r += 2) { \
            f32x2 a2 = (f32x2){p0[r], p0[r + 1]} * C2 - meff, b2 = (f32x2){p1[r], p1[r + 1]} * C2 - meff; \
            a2.x = __builtin_amdgcn_exp2f(a2.x); a2.y = __builtin_amdgcn_exp2f(a2.y); b2.x = __builtin_amdgcn_exp2f(b2.x); b2.y = __builtin_amdgcn_exp2f(b2.y); \
            p0[r] = a2.x; p0[r + 1] = a2.y; p1[r] = b2.x; p1[r + 1] = b2.y; sum2 += a2 + b2; } \
        l += sum2.x + sum2.y; \
        bf16x8 pa[4]; \
        _Pragma("unroll") for (int ks = 0; ks < 2; ++ks) { \
            u32x4 w0, w1; \
            _Pragma("unroll") for (int i = 0; i < 4; ++i) { w0[i] = cvtpk(p0[8 * ks + 2 * i], p0[8 * ks + 2 * i + 1]); w1[i] = cvtpk(p1[8 * ks + 2 * i], p1[8 * ks + 2 * i + 1]); } \
            pa[ks] = __builtin_bit_cast(bf16x8, w0); pa[2 + ks] = __builtin_bit_cast(bf16x8, w1); \
        } \
        lds_cptr vp = (lds_cptr)buf + 8192 + vlane; \
        pv32(o0, vp, pa); pv32(o1, vp + 4096, pa); \
        if (KIND == 0) pv32(oe, (lds_cptr)L + L_OV + blk * 4096 + vlane, pa); \
        } } while (0)
    u32x4 kA, vA;
    NSA_LOAD(kA, vA, blk0);
#pragma unroll 1
    for (int s = 0; s < nsteps; ++s) { NSA_STEP(kA, vA, s); }
#undef NSA_LOAD
#undef NSA_STEP
    float lt; { auto rr_ = __builtin_amdgcn_permlane32_swap(__float_as_uint(l), __float_as_uint(l), false, false); lt = __uint_as_float(rr_[0]) + __uint_as_float(rr_[1]); }
    const float inv = lt > 0.f ? 1.0f / lt : 0.f;
    LDS_FENCE();
    if (hi == 0) { wsf[r32] = gate * inv; wsf[32 + r32] = inv; }
    LDS_FENCE();
#pragma unroll
    for (int r = 0; r < 16; ++r) {
        const float a = wsf[crow(r, hi)]; otp[r] = cvtpk(bf2f(otp[r] & 0xffffu) + o0[r] * a, bf2f(otp[r] >> 16) + o1[r] * a);
        if (KIND == 0) ((LAS float*)(L + L_IMP))[(g * 64 + 32 * qh + crow(r, hi)) * 32 + r32] = oe[r] * wsf[32 + crow(r, hi)];
    }
    LDS_FENCE();
    __syncthreads();
}

__device__ __forceinline__ void attn_item(const Frame& F, const Item& it, LAS char* L) {
    const int tid = F.tid, lane = F.lane, wid = F.wave, g = wid >> 1, qh = wid & 1;
    int r32 = lane & 31, hi = lane >> 5; asm volatile("" : "+v"(r32), "+v"(hi));
    const bf16* PB = wsp<bf16>(F, WS_PB); const bf16* QR = wsp<bf16>(F, WS_QROT); bf16* Y = wsp<bf16>(F, WS_YB);
    const int head = it.hkv * 4 + g; const size_t rowq = (size_t)it.b * SEQ + it.qb * 64 + 32 * qh + r32;
    bf16x8 qn[4];
#pragma unroll
    for (int d0 = 0; d0 < 4; ++d0) qn[d0] = *(const bf16x8*)(PB + rowq * IN1P + C_Q + head * 64 + hi * 8 + d0 * 16);
    const bf16* glp = PB + rowq * IN1P + C_GL + head * 3;
    const float g0 = sigmoidf_(bf2f(glp[0])), g1 = sigmoidf_(bf2f(glp[1])), g2 = sigmoidf_(bf2f(glp[2]));
    unsigned otp[16];
#pragma unroll
    for (int r = 0; r < 16; ++r) otp[r] = 0u;
    branch<0>(F, it, L, qn, wsp<bf16>(F, M_KCMP) + (size_t)it.bh * 128 * 64, wsp<bf16>(F, M_VCMP) + (size_t)it.bh * 128 * 64, 64, 0, 2, g0, 0u, otp);
    {
        const int ql = tid >> 3, part = tid & 7;
        const LAS float* imp = (const LAS float*)(L + L_IMP) + ql * 32 + 4 * part;
        const f32x4 a = *(const LAS f32x4*)imp, b2 = *(const LAS f32x4*)(imp + 2048), c = *(const LAS f32x4*)(imp + 4096), d = *(const LAS f32x4*)(imp + 6144);
        float v[4];
#pragma unroll
        for (int i = 0; i < 4; ++i) { const int j = 4 * part + i; const bool forced = j == 0 || j == it.qb || j == it.qb - 1; v[i] = j <= it.qb ? ((a[i] + b2[i]) + (c[i] + d[i])) + (forced ? 1e6f : 0.f) : NEG; }
        unsigned mask = 0u;
#pragma unroll 1
        for (int k = 0; k < 8; ++k) {
            float best = v[0]; int bi = 4 * part;
#pragma unroll
            for (int i = 1; i < 4; ++i) if (v[i] > best) { best = v[i]; bi = 4 * part + i; }
#define NSA_MRG(CTRL) do { const float ov = __builtin_bit_cast(float, __builtin_amdgcn_update_dpp(0, __builtin_bit_cast(int, best), CTRL, 0xF, 0xF, true)); const int oj = __builtin_amdgcn_update_dpp(0, bi, CTRL, 0xF, 0xF, true); \
            if (ov > best || (ov == best && oj < bi)) { best = ov; bi = oj; } } while (0)
            NSA_MRG(0xB1); NSA_MRG(0x4E); NSA_MRG(0x141);
#undef NSA_MRG
            if (best > -1e29f) mask |= 1u << bi;
#pragma unroll
            for (int i = 0; i < 4; ++i) if (4 * part + i == bi) v[i] = -3e38f;
        }
        if (part == 0) ((LAS unsigned*)(L + L_SEL))[ql] = mask;
    }
    __syncthreads();
    const unsigned selm = ((const LAS unsigned*)(L + L_SEL))[32 * qh + r32];
    bf16x8 qr[4];
#pragma unroll
    for (int d0 = 0; d0 < 4; ++d0) qr[d0] = *(const bf16x8*)(QR + rowq * 512 + head * 64 + hi * 8 + d0 * 16);
    const bf16* rowb = PB + (size_t)it.b * SEQ * IN1P + it.hkv * 64;
    branch<1>(F, it, L, qr, rowb + C_KS, rowb + C_VS, IN1P, 0, it.qb + 1, g1, selm, otp);
    const int jlo = it.qb >= 8 ? it.qb - 8 : 0;
    branch<2>(F, it, L, qr, rowb + C_KW, rowb + C_VW, IN1P, jlo, it.qb - jlo + 1, g2, 0u, otp);
    bf16* yb = Y + ((size_t)it.b * SEQ + it.qb * 64 + 32 * qh) * D + head * 64 + r32;
#pragma unroll
    for (int r = 0; r < 16; ++r) { yb[(size_t)crow(r, hi) * D] = (bf16)(otp[r] & 0xffffu); yb[(size_t)crow(r, hi) * D + 32] = (bf16)(otp[r] >> 16); }
}
__device__ __forceinline__ void p_attn(const Frame& F) {
    LAS char* L = (LAS char*)F.lds;
    for (int idx = F.tid; idx < 4096; idx += NTHR) {
        const int bk = idx >> 11, nin = (idx >> 5) & 63, j = idx & 31, n = 64 * bk + nin;
        const bool ov = (n >= 4 * j - 1) && (n <= 4 * j + 3) && (n <= 126);
        *(LAS bf16*)(L + L_OV + bk * 4096 + nin * 64 + j * 2) = (bf16)(ov ? 0x3F80u : 0u);
    }
    __syncthreads();
    const int vcu = (F.G % 8 == 0) ? (F.blk % 8) * (F.G / 8) + F.blk / 8 : F.blk;
    for (int qi = vcu; qi < 256; qi += F.G) {
        const int bh = qi >> 3, sft = qi & 7;
#pragma unroll 1
        for (int k = 0; k < 4; ++k) {
            Item it; it.bh = bh; it.b = bh >> 1; it.hkv = bh & 1; it.qb = k == 0 ? sft : (k == 1 ? 15 - sft : (k == 2 ? 16 + sft : 31 - sft));
            attn_item(F, it, L);
        }
    }
}
}

__device__ __forceinline__ void p_route_a(const Frame& F) {
    LAS unsigned char* L = (LAS unsigned char*)F.lds;
    LAS int* hist = (LAS int*)(L + 32768);
    {
        const f32x4* src = (const f32x4*)wsp<float>(F, M_WR);
#pragma unroll
        for (int i = 0; i < 4; ++i) *(LAS f32x4*)(L + (F.tid + NTHR * i) * 16) = src[F.tid + NTHR * i];
        if (F.tid < 8) hist[F.tid] = 0;
    }
    __syncthreads();
    const bf16* XB = wsp<bf16>(F, WS_XB); const float* RS = wsp<float>(F, M_RS); const float* rb = F.in[35];
    int* TOPE = wsp<int>(F, M_TOPE); float* TOPG = wsp<float>(F, M_TOPG); float* RSTD3 = wsp<float>(F, M_RSTD3);
    const int chunk = (NTOK + F.G - 1) / F.G, cs = F.blk * chunk, ce = min(NTOK, cs + chunk); const int lane = F.lane;
    const int sub = lane >> 4, l16 = lane & 15;
    for (int tok0 = cs + 4 * F.wave; tok0 < ce; tok0 += 4 * NWAVES) {
        const int tok = tok0 + sub; const bool ok = tok < ce; const int tk = ok ? tok : cs;
        u32x4 xr[8];
#pragma unroll
        for (int r = 0; r < 8; ++r) xr[r] = *(const u32x4*)(XB + (size_t)tk * D + 128 * r + 8 * l16);
        const float rstd = rsqrtf(red16(RS[(size_t)tk * 16 + l16]) * (1.0f / D) + 1e-6f);
        float lg[8];
#pragma unroll
        for (int e = 0; e < 8; ++e) lg[e] = 0.f;
#pragma unroll
        for (int r = 0; r < 8; ++r) {
            const int k0 = 128 * r + 8 * l16;
            float x[8];
#pragma unroll
            for (int j = 0; j < 4; ++j) { x[2 * j] = bf2f(xr[r][j] & 0xffffu); x[2 * j + 1] = bf2f(xr[r][j] >> 16); }
#pragma unroll
            for (int e = 0; e < 8; ++e) {
                const f32x4 w0 = *(const LAS f32x4*)(L + (e * D + k0) * 4), w1 = *(const LAS f32x4*)(L + (e * D + k0 + 4) * 4);
                lg[e] += (x[0] * w0.x + x[1] * w0.y) + (x[2] * w0.z + x[3] * w0.w) + (x[4] * w1.x + x[5] * w1.y) + (x[6] * w1.z + x[7] * w1.w);
            }
        }
#pragma unroll
        for (int e = 0; e < 8; ++e) lg[e] = red16(lg[e]) * rstd + rb[e];
        if (ok) {
#pragma unroll
            for (int r = 0; r < 8; ++r) {
                u32x2 q8;
                q8.x = pk4_i8(bf2f(xr[r][0] & 0xffffu) * I8_XS1, bf2f(xr[r][0] >> 16) * I8_XS1, bf2f(xr[r][1] & 0xffffu) * I8_XS1, bf2f(xr[r][1] >> 16) * I8_XS1);
                q8.y = pk4_i8(bf2f(xr[r][2] & 0xffffu) * I8_XS1, bf2f(xr[r][2] >> 16) * I8_XS1, bf2f(xr[r][3] & 0xffffu) * I8_XS1, bf2f(xr[r][3] >> 16) * I8_XS1);
                *(u32x2*)(F.ws + WS_XQ + (size_t)tk * D + 128 * r + 8 * l16) = q8;
            }
        }
        float v1 = lg[0]; int e1 = 0;
#pragma unroll
        for (int e = 1; e < 8; ++e) if (lg[e] > v1) { v1 = lg[e]; e1 = e; }
        float v2 = -3e38f; int e2 = 0;
#pragma unroll
        for (int e = 0; e < 8; ++e) if (e != e1 && lg[e] > v2) { v2 = lg[e]; e2 = e; }
        if (l16 == 0 && ok) {
            const float g1 = rcpf_(1.0f + __expf(v2 - v1));
            TOPE[tok * 2] = e1; TOPE[tok * 2 + 1] = e2; TOPG[tok * 2] = g1; TOPG[tok * 2 + 1] = 1.0f - g1; RSTD3[tok] = rstd;
            atomicAdd((int*)&hist[e1], 1); atomicAdd((int*)&hist[e2], 1);
        }
    }
    __syncthreads();
    if (F.tid < 8) wsp<int>(F, M_BLKCNT)[F.blk * 8 + F.tid] = hist[F.tid];
    __syncthreads();
}
__device__ __forceinline__ void p_route_b(const Frame& F) {
    int* L = (int*)F.lds;
    const int* BC = wsp<int>(F, M_BLKCNT); const int* TOPE = wsp<int>(F, M_TOPE); int* SLOTOF = wsp<int>(F, M_SLOTOF);
    const int chunk = (NTOK + F.G - 1) / F.G, cs = F.blk * chunk, ce = min(NTOK, cs + chunk), np = (ce > cs ? (ce - cs) * 2 : 0);
    {
        const int e = F.tid & 7, part = F.tid >> 3; int tot = 0, pre = 0;
        for (int bb = part; bb < F.G; bb += 64) { const int c = BC[bb * 8 + e]; if (bb < F.blk) pre += c; tot += c; }
        L[4096 + F.tid] = tot; L[4096 + 512 + F.tid] = pre;
        __syncthreads();
        if (F.tid < 8) { int t2 = 0, p2 = 0; for (int q = 0; q < 64; ++q) { t2 += L[4096 + q * 8 + F.tid]; p2 += L[4096 + 512 + q * 8 + F.tid]; } L[F.tid] = t2; L[8 + F.tid] = p2; }
    }
    __syncthreads();
    if (F.tid == 0) { int ps = 0; for (int e = 0; e < 8; ++e) { L[16 + e] = ps; if (F.blk == 0) wsp<int>(F, M_EXPINF)[e] = ps >> 8; ps += ((L[e] + 255) >> 8) << 8; } if (F.blk == 0) wsp<int>(F, M_EXPINF)[8] = ps >> 8; }
    __syncthreads();
    for (int p = F.tid; p < np; p += NTHR) L[32 + 1024 + p] = TOPE[cs * 2 + p];
    __syncthreads();
    if (F.tid < 8) { int cnt = L[16 + F.tid] + L[8 + F.tid]; for (int p = 0; p < np; ++p) { if (L[32 + 1024 + p] == F.tid) { L[32 + p] = cnt; ++cnt; } } }
    __syncthreads();
    for (int p = F.tid; p < np; p += NTHR) SLOTOF[cs * 2 + p] = L[32 + p];

    int* STOK = wsp<int>(F, M_SLOTTOK);
    for (int p = F.tid; p < np; p += NTHR) {
        const int tok = cs + (p >> 1), slot = L[32 + p];
        STOK[slot] = tok; wsp<float>(F, M_SRSTD)[slot] = wsp<float>(F, M_RSTD3)[tok]; wsp<float>(F, M_SGATE)[slot] = wsp<float>(F, M_TOPG)[cs * 2 + p];
    }
    if (F.blk == 0) {
        for (int e = 0; e < 8; ++e) { const int s0 = L[16 + e] + L[e], s1 = L[16 + e] + (((L[e] + 255) >> 8) << 8); for (int sI = s0 + F.tid; sI < s1; sI += NTHR) STOK[sI] = 0; }
    }
    __syncthreads();
}
__device__ __forceinline__ void p_final(const Frame& F) {
    const bf16* YP = wsp<bf16>(F, WS_XS); const int* SLOTOF = wsp<int>(F, M_SLOTOF); const float* fn = F.in[39];
    const int gw = F.blk * NWAVES + F.wave, NGW = F.G * NWAVES, lane = F.lane;
    for (int tok = gw; tok < NTOK; tok += NGW) {
        const int s1 = SLOTOF[tok * 2], s2 = SLOTOF[tok * 2 + 1];
        f32x4 v[4]; float ss = 0.f;
#pragma unroll
        for (int j = 0; j < 4; ++j) {
            { const u32x2 hb = *((const u32x2*)(wsp<bf16>(F, WS_XB) + (size_t)tok * D) + lane + 64 * j); v[j] = (f32x4){bf2f(hb.x & 0xffffu), bf2f(hb.x >> 16), bf2f(hb.y & 0xffffu), bf2f(hb.y >> 16)}; }
            const u32x2 a = *((const u32x2*)(YP + (size_t)s1 * D) + lane + 64 * j), bq = *((const u32x2*)(YP + (size_t)s2 * D) + lane + 64 * j);
            v[j].x += bf2f(a.x & 0xffffu) + bf2f(bq.x & 0xffffu); v[j].y += bf2f(a.x >> 16) + bf2f(bq.x >> 16); v[j].z += bf2f(a.y & 0xffffu) + bf2f(bq.y & 0xffffu); v[j].w += bf2f(a.y >> 16) + bf2f(bq.y >> 16);
            ss += (v[j].x * v[j].x + v[j].y * v[j].y) + (v[j].z * v[j].z + v[j].w * v[j].w);
        }
        const float rstd = rsqrtf(wave_sum(ss) * (1.0f / D) + 1e-6f);
#pragma unroll
        for (int j = 0; j < 4; ++j) { const f32x4 g = *((const f32x4*)fn + lane + 64 * j); *((f32x4*)(F.out + (size_t)tok * D) + lane + 64 * j) = v[j] * rstd * g; }
    }
}

#define XB_TMO      128
#define XB_XCNT(j)  (256  + 64 * (j))
#define XB_XSUB(j)  (1280 + 64 * (j))
#define XB_XGEN(j)  (2304 + 64 * (j))
#define XB_TOP      3328
#define XB_TOPGEN   3392
#define XCD_BAR_WORDS 3456
#define XB_SPIN_CAP (1u << 18)
constexpr int CW_BAR = 4096;
constexpr int LDS_BARST = LDS_BYTES - 64;
__device__ __forceinline__ unsigned xb_ld(unsigned* p)              { return __hip_atomic_load(p, __ATOMIC_RELAXED, __HIP_MEMORY_SCOPE_AGENT); }
__device__ __forceinline__ unsigned xb_add(unsigned* p, unsigned v) { return __hip_atomic_fetch_add(p, v, __ATOMIC_RELAXED, __HIP_MEMORY_SCOPE_AGENT); }
__device__ __forceinline__ unsigned xb_xcc_id() { return (unsigned)__builtin_amdgcn_s_getreg((3 << 11) | 20) & 0xFu; }
#define XB_SPIN(cond, bar) do { unsigned _sp = 0; while (cond) { __builtin_amdgcn_s_sleep(1); \
    if ((++_sp & 255u) == 0u) { if (xb_ld(&(bar)[XB_TMO])) break; if (_sp > XB_SPIN_CAP) { atomicAdd(&(bar)[XB_TMO], 1u); break; } } } } while (0)
struct XcdBarrier { unsigned* bar; unsigned x; volatile LAS unsigned* st; int wave; };
__device__ __forceinline__ XcdBarrier xcd_barrier_post(unsigned* bar, volatile LAS unsigned* st, int wave) {
    XcdBarrier b; b.bar = bar; b.x = xb_xcc_id(); b.st = st; b.wave = wave;
    if (tid_now(wave) == 0) (void)xb_add(&bar[XB_XCNT(b.x)], 1u);
    return b;
}
__device__ __forceinline__ void xcd_barrier_complete(unsigned* bar, unsigned x, unsigned& nloc, unsigned& nx) {
    const unsigned G = gridDim.x * gridDim.y * gridDim.z;
    unsigned sum, cnt, mine, sp = 0u;
    for (;;) {
        sum = 0u; cnt = 0u; mine = 0u;
#pragma unroll
        for (unsigned j = 0; j < 16; ++j) { const unsigned c = xb_ld(&bar[XB_XCNT(j)]); sum += c; cnt += (c > 0u) ? 1u : 0u; mine = (j == x) ? c : mine; }
        if (sum == G) break;
        __builtin_amdgcn_s_sleep(1);
        if ((++sp & 255u) == 0u) { if (xb_ld(&bar[XB_TMO])) break; if (sp > XB_SPIN_CAP) { atomicAdd(&bar[XB_TMO], 1u); break; } }
    }
    nloc = mine > 0u ? mine : 1u; nx = cnt > 0u ? cnt : 1u;
}
__device__ __forceinline__ void xcd_barrier(const XcdBarrier& b) {
    asm volatile("s_waitcnt vmcnt(0)" ::: "memory");
    __syncthreads();
    if (tid_now(b.wave) == 0) {
        unsigned* bar = b.bar;
        __builtin_amdgcn_s_waitcnt(0);
        unsigned nloc = b.st[0], nx = b.st[1];
        if (nloc == 0u) { xcd_barrier_complete(bar, b.x, nloc, nx); b.st[0] = nloc; b.st[1] = nx; }
        const unsigned old = xb_add(&bar[XB_XSUB(b.x)], 1u);
        const unsigned gen = old / nloc;
        if (old + 1u == (gen + 1u) * nloc) {
            __builtin_amdgcn_fence(__ATOMIC_RELEASE, "agent");
            asm volatile("s_waitcnt vmcnt(0)" ::: "memory");
            const unsigned og = xb_add(&bar[XB_TOP], 1u);
            const unsigned tg = og / nx;
            if (og + 1u == (tg + 1u) * nx) xb_add(&bar[XB_TOPGEN], 1u);
            else XB_SPIN(xb_ld(&bar[XB_TOPGEN]) == tg, bar);
            __builtin_amdgcn_fence(__ATOMIC_ACQUIRE, "agent");
            xb_add(&bar[XB_XGEN(b.x)], 1u);
            asm volatile("s_waitcnt vmcnt(0)" ::: "memory");
        } else {
            XB_SPIN(xb_ld(&bar[XB_XGEN(b.x)]) == gen, bar);
            __builtin_amdgcn_fence(__ATOMIC_ACQUIRE, "agent");
            asm volatile("s_waitcnt vmcnt(0)" ::: "memory");
        }
    }
    __syncthreads();
}

constexpr int N_PHASES = 16;
#ifndef MK_ONE_LAUNCH
#define MK_ONE_LAUNCH 1
#endif
__global__ void __launch_bounds__(NTHR, 2) mk_fwd(Args args) {
    extern __shared__ __attribute__((aligned(16))) unsigned char lds[];
    Frame F; F.lds = lds; F.ws = args.ws; F.in = args.in; F.out = args.out;
    F.tid = threadIdx.x; F.lane = F.tid & 63; F.wave = __builtin_amdgcn_readfirstlane(F.tid >> 6); F.G = gridDim.x; F.blk = blockIdx.x;
    const int lo = args.ph_lo, hi = args.ph_hi;
    XcdBarrier bar; bar.bar = (unsigned*)(args.ws + WS_CTL) + CW_BAR + args.li * XCD_BAR_WORDS; bar.x = 0; bar.st = nullptr; bar.wave = F.wave;
    {
        if (F.tid < 16) ((LAS unsigned*)lds)[LDS_BARST / 4 + F.tid] = 0u;
        __syncthreads();
        bar = xcd_barrier_post((unsigned*)(args.ws + WS_CTL) + CW_BAR + args.li * XCD_BAR_WORDS, (volatile LAS unsigned*)((LAS unsigned char*)lds + LDS_BARST), F.wave);
    }
#ifndef REPEAT_MASK
#define REPEAT_MASK 0u
#endif
#define NREP(k) ((((REPEAT_MASK) >> (k)) & 1u) ? 2 : 1)
#define PH_ENTER() do { int t_ = tid_now(F.wave); asm volatile("" : "+v"(t_)); F.tid = t_; F.lane = t_ & 63; } while (0)
#define SEAM(k) do { if (IN(k) && IN((k) + 1)) xcd_barrier(bar); } while (0)
#if defined(SKIP_PH)
#define IN(k) ((k) != SKIP_PH && lo <= (k) && (k) < hi)
#elif defined(ONLY_PH)
#define IN(k) ((k) == ONLY_PH && lo <= (k) && (k) < hi)
#else
#define IN(k) (lo <= (k) && (k) < hi)
#endif
    PH_ENTER();
    for (int rep_ = 0; rep_ < NREP(0); ++rep_) if (IN(0)) p0_prologue(F);
    SEAM(0);
    PH_ENTER();
    for (int rep_ = 0; rep_ < NREP(1); ++rep_) if (IN(1)) {
        Gemm g = std_gemm((const bf16*)(F.ws + WS_XQI), (const bf16*)(F.ws + WT_IN0), D / 2); StdOrder S; S.init(NTOK / 256, IN0 / 256, F.G, F.blk, 256L * D, 256L * D);
        EpiBf16T<true> E{wsp<bf16>(F, WS_PB), IN0, wsp<float>(F, M_RSTD0), nullptr, 4, fill_rs_lds(F.lds, S, nullptr, wsp<float>(F, M_RSTD0), F.tid), 1.0f / I8_WS};
        pg8::gemm_phase<EpiBf16T<true>, StdOrder, true, false, true, true>(F.wave, (LAS unsigned char*)F.lds, g, S, E);
    }
    SEAM(1);
    PH_ENTER();
    for (int rep_ = 0; rep_ < NREP(2); ++rep_) if (IN(2)) { p_lora(F); xcd_barrier(bar); p_mix0(F); }
    if (F.G != 256) SEAM(2);
    PH_ENTER();
    for (int rep_ = 0; rep_ < NREP(3); ++rep_) if (IN(3)) {
        Gemm g = std_gemm(wsp<bf16>(F, WS_YB), wsp<bf16>(F, WT_OUT0), D);
        EpiResBT<true, false, (long)WS_XQ0 - (long)WS_XB> E{wsp<bf16>(F, WS_XB), wsp<float>(F, M_RS), 1.0f};
        if (F.G == 256) {
            __syncthreads();
            GatedOrder S; S.cnt = (unsigned*)(F.ws + WS_CTL) + CW_YRDY; S.a_tile = 256L * D * 2; S.b_tile = 256L * D * 2;
            if (F.blk < 128) { S.n = 1; S.e0 = 0; S.rb = F.blk >> 3; S.rj = 6 + ((F.blk & 7) >> 2); S.rpn = F.blk & 3; }
            else { S.n = 3; S.e0 = F.blk - 128; S.rb = 0; S.rj = 0; S.rpn = 0; }
            pg8::gemm_phase<EpiResBT<true, false, (long)WS_XQ0 - (long)WS_XB>, GatedOrder, true>(F.wave, (LAS unsigned char*)F.lds, g, S, E);
        } else {
            StdOrder S; S.init(NTOK / 256, D / 256, F.G, F.blk, 256L * D * 2, 256L * D * 2);
            gemm_run<3, EpiResBT<true, false, (long)WS_XQ0 - (long)WS_XB>, StdOrder>(F, g, S, E);
        }
    }
    SEAM(3);
    PH_ENTER();
    for (int rep_ = 0; rep_ < NREP(4); ++rep_) if (IN(4)) {
        Gemm g = std_gemm((const bf16*)(F.ws + WS_XQ0), (const bf16*)(F.ws + WT_GU0), D / 2); StdOrder S; S.init(NTOK / 256, 2 * FFN / 256, F.G, F.blk, 256L * D, 256L * D);
        EpiGU8<FFN, -1, true> E{F.ws + WS_PB, fill_rs_lds(F.lds, S, wsp<float>(F, M_RS), nullptr, F.tid), 1.0f / (I8_XS * I8_WS)};
        pg8::gemm_phase<EpiGU8<FFN, -1, true>, StdOrder, true, false, true, true>(F.wave, (LAS unsigned char*)F.lds, g, S, E);
    }
    SEAM(4);
    PH_ENTER();
    for (int rep_ = 0; rep_ < NREP(5); ++rep_) if (IN(5)) {
        Gemm g = std_gemm((const bf16*)(F.ws + WS_PB), (const bf16*)(F.ws + WT_DN0), FFN / 2); StdOrder S; S.init(NTOK / 256, D / 256, F.G, F.blk, 256L * FFN, 256L * FFN);
        EpiResBT<true, true, (long)WS_XQI - (long)WS_XB> E{wsp<bf16>(F, WS_XB), wsp<float>(F, M_RS), 1.0f / (F8_HS * F8_WS)};
        pg8::gemm_phase<EpiResBT<true, true, (long)WS_XQI - (long)WS_XB>, StdOrder, true, false, true>(F.wave, (LAS unsigned char*)F.lds, g, S, E);
    }
    SEAM(5);
    PH_ENTER();
    for (int rep_ = 0; rep_ < NREP(6); ++rep_) if (IN(6)) {
        Gemm g = std_gemm((const bf16*)(F.ws + WS_XQI), (const bf16*)(F.ws + WT_IN1), D / 2); StdOrder S; S.init(NTOK / 256, IN1P / 256, F.G, F.blk, 256L * D, 256L * D);
        EpiBf16T<true, true> E{wsp<bf16>(F, WS_PB), IN1P, nullptr, wsp<float>(F, M_RS), 0, fill_rs_lds(F.lds, S, wsp<float>(F, M_RS), nullptr, F.tid), 1.0f / (I8_XS * I8_WS)};
        pg8::gemm_phase<EpiBf16T<true, true>, StdOrder, true, false, true, true>(F.wave, (LAS unsigned char*)F.lds, g, S, E);
    }
    SEAM(6);
    PH_ENTER();
    for (int rep_ = 0; rep_ < NREP(7); ++rep_) if (IN(7)) p_nsa_prep(F);
    SEAM(7);
    PH_ENTER();
    for (int rep_ = 0; rep_ < NREP(9); ++rep_) if (IN(9)) {
#ifdef ATTN_NAIVE
        p_attn_naive(F);
#else
        nsa::p_attn(F);
#endif
    }
    SEAM(9);
    PH_ENTER();
    for (int rep_ = 0; rep_ < NREP(10); ++rep_) if (IN(10)) {
        Gemm g = std_gemm(wsp<bf16>(F, WS_YB), wsp<bf16>(F, WT_OUT1), D); StdOrder S; S.init(NTOK / 256, D / 256, F.G, F.blk, 256L * D * 2, 256L * D * 2);
        EpiResB E{wsp<bf16>(F, WS_XB), wsp<float>(F, M_RS), 1.0f};
        gemm_run<10, EpiResB, StdOrder>(F, g, S, E);
    }
    SEAM(10);
    PH_ENTER();
    for (int rep_ = 0; rep_ < NREP(11); ++rep_) if (IN(11)) p_route_a(F);
    SEAM(11);
    PH_ENTER();
    for (int rep_ = 0; rep_ < NREP(12); ++rep_) if (IN(12)) p_route_b(F);
    SEAM(12);
    PH_ENTER();
    for (int rep_ = 0; rep_ < NREP(13); ++rep_) if (IN(13)) {
        Gemm g = std_gemm((const bf16*)(F.ws + WS_XQ), (const bf16*)(F.ws + WT_GU1), D / 2); MoeOrder S; S.init(wsp<int>(F, M_EXPINF), 2 * EXPD / 256, F.G, F.blk, 256L * D, 256L * D, 2L * EXPD * D);
        EpiGU8<AP8, EXPD / 128 - 1, true> E{F.ws + WS_ACTM, fill_rs_lds(F.lds, S, nullptr, wsp<float>(F, M_SRSTD), F.tid, 131072 + 14336), 1.0f / (I8_XS1 * I8_WS)};
        LAS int* rmap = (LAS int*)((LAS unsigned char*)F.lds + 131072);
        { Unit u; const int* STOK = wsp<int>(F, M_SLOTTOK);
          for (int i = F.wave; i < 14 && S.next(i, u); i += NWAVES) {
#pragma unroll
              for (int rr = 0; rr < 4; ++rr) rmap[i * 256 + F.lane + 64 * rr] = STOK[u.pm * 256 + F.lane + 64 * rr]; }
          __syncthreads(); }
        pg8::gemm_phase<EpiGU8<AP8, EXPD / 128 - 1, true>, MoeOrder, true, true, true, true>(F.wave, (LAS unsigned char*)F.lds, g, S, E, rmap);
    }
    SEAM(13);
    PH_ENTER();
    for (int rep_ = 0; rep_ < NREP(14); ++rep_) if (IN(14)) {
        Gemm g = std_gemm((const bf16*)(F.ws + WS_ACTM), (const bf16*)(F.ws + WT_DN1), AP8 / 2); MoeOrder S; S.init(wsp<int>(F, M_EXPINF), D / 256, F.G, F.blk, 256L * AP8, 256L * AP8, (long)D * AP8);
        EpiScale E{wsp<bf16>(F, WS_XS), D, wsp<float>(F, M_SGATE), fill_rs_lds(F.lds, S, nullptr, wsp<float>(F, M_SGATE), F.tid), 1.0f / (F8_HS * F8_WS)};
        pg8::gemm_phase<EpiScale, MoeOrder, true, false, true>(F.wave, (LAS unsigned char*)F.lds, g, S, E);
    }
    SEAM(14);
    PH_ENTER();
    for (int rep_ = 0; rep_ < NREP(15); ++rep_) if (IN(15)) p_final(F);
#undef IN
}

extern "C" void kernel_launch(void* const* d_in, const int* in_sizes, int n_in, void* d_out, int out_size, void* d_ws, size_t ws_size, hipStream_t stream) {
    static int grid = 0;
    if (grid == 0) {
        if (n_in != 40 || out_size != NTOK * D || ws_size < WS_END) { fprintf(stderr, "kernel_launch: unexpected shapes (n_in %d out %d ws %zu)\n", n_in, out_size, ws_size); grid = -1; return; }
        int dev = 0, cus = 0, per_cu = 0;
        if (hipGetDevice(&dev) != hipSuccess || hipDeviceGetAttribute(&cus, hipDeviceAttributeMultiprocessorCount, dev) != hipSuccess) { grid = -1; return; }
        if (hipFuncSetAttribute((const void*)mk_fwd, hipFuncAttributeMaxDynamicSharedMemorySize, LDS_BYTES) != hipSuccess) { fprintf(stderr, "kernel_launch: hipFuncSetAttribute failed\n"); grid = -1; return; }
        if (hipOccupancyMaxActiveBlocksPerMultiprocessor(&per_cu, (const void*)mk_fwd, NTHR, LDS_BYTES) != hipSuccess || per_cu < 1) per_cu = 1;
        (void)hipGetLastError();
        grid = cus;
        if (grid > 1024) grid = 1024;
    }
    if (grid < 0) return;
    (void)hipMemsetAsync((char*)d_ws + WS_CTL, 0, CTL_ZERO_BYTES, stream);
    Args a{};
    for (int i = 0; i < 40; ++i) a.in[i] = (const float*)d_in[i];
    a.out = (float*)d_out; a.ws = (unsigned char*)d_ws;
#if defined(PROBE_PH)
    { const int cuts[5] = {0, PROBE_PH, PROBE_PH + 1, PROBE_PH + 1, N_PHASES}; const int los[4] = {0, PROBE_PH, PROBE_PH, PROBE_PH + 1};
      for (int li = 0; li < 4; ++li) { a.ph_lo = los[li]; a.ph_hi = (li == 0) ? PROBE_PH : (li == 3 ? N_PHASES : PROBE_PH + 1); a.li = li; (void)cuts; if (a.ph_hi > a.ph_lo) hipLaunchKernelGGL(mk_fwd, dim3(grid), dim3(NTHR), LDS_BYTES, stream, a); } }
#elif MK_ONE_LAUNCH
    a.ph_lo = 0; a.ph_hi = N_PHASES;
    hipLaunchKernelGGL(mk_fwd, dim3(grid), dim3(NTHR), LDS_BYTES, stream, a);
#else
    for (int ph = 0; ph < N_PHASES; ++ph) {
        a.ph_lo = ph; a.ph_hi = ph + 1;
        hipLaunchKernelGGL(mk_fwd, dim3(grid), dim3(NTHR), LDS_BYTES, stream, a);
    }
#endif
}
```
